# Optimizing an MI355X kernel written in HIP

```python
import math
import jax, jax.numpy as jnp
from jax import lax
import numpy as np


D_MODEL = 1024
BATCH = 4
SEQ = 8192
DEPTH = 4

RMS_EPS = 1e-6
Q_BLOCK = 128
NEG_INF = -1e30

T5_BUCKETS = 32
T5_MAX_EXACT = T5_BUCKETS // 2
T5_MAX_DISTANCE = 1024

DIFF_HEADS = 4
DIFF_HEAD_DIM = 64
DIFF_QK_WIDTH = DIFF_HEADS * 2 * DIFF_HEAD_DIM
DIFF_V_WIDTH = DIFF_HEADS * 2 * DIFF_HEAD_DIM

MOBA_HEADS = 4
MOBA_HEAD_DIM = 128
MOBA_BLOCK = 256
MOBA_TOPK = 3
MOBA_Q_CHUNK = 32
MOBA_WIDTH = MOBA_HEADS * MOBA_HEAD_DIM

MLA_HEADS = 8
MLA_Q_RANK = 256
MLA_KV_RANK = 128
MLA_NOPE_DIM = 64
MLA_ROPE_DIM = 32
MLA_V_DIM = 64
MLA_WIDTH = MLA_HEADS * MLA_V_DIM
ROPE_THETA = 10000.0

N_BRANCH = 3
BRANCH_WIDTH = 512
N_BIAS_HEADS = DIFF_HEADS + MOBA_HEADS
D_FF = 4 * D_MODEL

IN_SPLITS = (DIFF_QK_WIDTH, DIFF_QK_WIDTH, DIFF_V_WIDTH,
             MOBA_WIDTH, MOBA_WIDTH, MOBA_WIDTH,
             MLA_Q_RANK, MLA_KV_RANK, MLA_ROPE_DIM,
             N_BRANCH * D_MODEL)
IN_OFFSETS = tuple(sum(IN_SPLITS[:i + 1]) for i in range(len(IN_SPLITS) - 1))
D_IN = sum(IN_SPLITS)

kernel_name = 'hybrid_diff_moba_mla_gated_trunk'


def _rms_norm(x, w):
    xf = x.astype(jnp.float32)
    y = xf * lax.rsqrt(jnp.mean(xf * xf, axis=-1, keepdims=True) + RMS_EPS)
    return (y * w.astype(jnp.float32)).astype(x.dtype)


def _t5_bucket(rel):
    n = jnp.maximum(rel, 0)
    nf = jnp.maximum(n, 1).astype(jnp.float32)
    large = T5_MAX_EXACT + (jnp.log(nf / T5_MAX_EXACT)
                            / math.log(T5_MAX_DISTANCE / T5_MAX_EXACT)
                            * (T5_BUCKETS - T5_MAX_EXACT)).astype(jnp.int32)
    large = jnp.minimum(large, T5_BUCKETS - 1)
    return jnp.where(n < T5_MAX_EXACT, n, large)


def _rope(x, positions):
    d = x.shape[-1]
    half = d // 2
    inv_freq = ROPE_THETA ** (-jnp.arange(half, dtype=jnp.float32) * 2.0 / d)
    ang = positions.astype(jnp.float32)[:, :, None, None] * inv_freq
    cos, sin = jnp.cos(ang), jnp.sin(ang)
    xf = x.astype(jnp.float32)
    x1, x2 = xf[..., :half], xf[..., half:]
    return jnp.concatenate([x1 * cos - x2 * sin, x2 * cos + x1 * sin], axis=-1).astype(x.dtype)


def _diff_attention(q1, q2, k1, k2, v, lam, bias_table):
    B, S, H, dh = q1.shape
    scale = 1.0 / math.sqrt(dh)
    k_pos = jnp.arange(S)
    table = bias_table.astype(jnp.float32)

    def block(c):
        start = c * Q_BLOCK
        q_pos = start + jnp.arange(Q_BLOCK)
        rel = q_pos[:, None] - k_pos[None, :]
        bias = jnp.transpose(table[_t5_bucket(rel)], (2, 0, 1))
        visible = rel >= 0

        def probs(q, k):
            qb = lax.dynamic_slice_in_dim(q, start, Q_BLOCK, axis=1)
            s = jnp.einsum('bqhd,bkhd->bhqk', qb, k).astype(jnp.float32) * scale + bias
            return jax.nn.softmax(jnp.where(visible, s, NEG_INF), axis=-1)

        w = probs(q1, k1) - lam * probs(q2, k2)
        return jnp.einsum('bhqk,bkhd->bqhd', w.astype(v.dtype), v)

    out = lax.map(block, jnp.arange(S // Q_BLOCK))
    return jnp.transpose(out, (1, 0, 2, 3, 4)).reshape(B, S, H, v.shape[-1])


def _moba_attention(q, k, v, bias_table):
    B, S, H, d = q.shape
    scale = 1.0 / math.sqrt(d)
    n_blk = -(-S // MOBA_BLOCK)
    s_pad = n_blk * MOBA_BLOCK
    topk = min(MOBA_TOPK, n_blk)
    pad = ((0, 0), (0, s_pad - S), (0, 0), (0, 0))
    kbh = jnp.transpose(jnp.pad(k, pad).reshape(B, n_blk, MOBA_BLOCK, H, d), (0, 3, 1, 2, 4))
    vbh = jnp.transpose(jnp.pad(v, pad).reshape(B, n_blk, MOBA_BLOCK, H, d), (0, 3, 1, 2, 4))
    k_mean = jnp.mean(kbh.astype(jnp.float32), axis=3)
    blk_ids = jnp.arange(n_blk)
    offs = jnp.arange(MOBA_BLOCK)
    table = bias_table.astype(jnp.float32)
    table_t = table.T
    bi = jnp.arange(B)[:, None, None, None]
    hi = jnp.arange(H)[None, :, None, None]
    hi5 = jnp.arange(H)[None, :, None, None, None]

    def chunk(c):
        start = c * MOBA_Q_CHUNK
        own = start // MOBA_BLOCK
        q_pos = start + jnp.arange(MOBA_Q_CHUNK)
        qbt = jnp.transpose(lax.dynamic_slice_in_dim(q, start, MOBA_Q_CHUNK, axis=1), (0, 2, 1, 3))
        gate = jnp.einsum('bhqd,bhnd->bhqn', qbt.astype(jnp.float32), k_mean)
        gate = jnp.where(blk_ids < own, gate, NEG_INF)
        _, idx = lax.top_k(gate, topk)
        valid = idx < own
        k_sel = kbh[bi, hi, idx]
        v_sel = vbh[bi, hi, idx]
        s_sel = jnp.einsum('bhqd,bhqnld->bhqnl', qbt, k_sel).astype(jnp.float32) * scale
        sel_pos = idx[..., None] * MOBA_BLOCK + offs
        rel_sel = q_pos[None, None, :, None, None] - sel_pos
        s_sel = jnp.where(valid[..., None], s_sel + table_t[hi5, _t5_bucket(rel_sel)], NEG_INF)
        k_own = lax.dynamic_index_in_dim(kbh, own, axis=2, keepdims=False)
        v_own = lax.dynamic_index_in_dim(vbh, own, axis=2, keepdims=False)
        rel_own = q_pos[:, None] - (own * MOBA_BLOCK + offs)[None, :]
        bias_own = jnp.transpose(table[_t5_bucket(rel_own)], (2, 0, 1))
        s_own = jnp.einsum('bhqd,bhld->bhql', qbt, k_own).astype(jnp.float32) * scale + bias_own
        s_own = jnp.where(rel_own >= 0, s_own, NEG_INF)
        n_sel = topk * MOBA_BLOCK
        s = jnp.concatenate([s_sel.reshape(B, H, MOBA_Q_CHUNK, n_sel), s_own], axis=-1)
        p = jax.nn.softmax(s, axis=-1).astype(v.dtype)
        p_sel = p[..., :n_sel].reshape(B, H, MOBA_Q_CHUNK, topk, MOBA_BLOCK)
        p_own = p[..., n_sel:]
        return (jnp.einsum('bhqnl,bhqnld->bqhd', p_sel, v_sel)
                + jnp.einsum('bhql,bhld->bqhd', p_own, v_own))

    out = lax.map(chunk, jnp.arange(S // MOBA_Q_CHUNK))
    return jnp.transpose(out, (1, 0, 2, 3, 4)).reshape(B, S, H, d)


def _dense_causal_attention(q, k, v, scale):
    B, S, H, _ = q.shape
    k_pos = jnp.arange(S)

    def block(c):
        start = c * Q_BLOCK
        qb = lax.dynamic_slice_in_dim(q, start, Q_BLOCK, axis=1)
        s = jnp.einsum('bqhd,bkhd->bhqk', qb, k).astype(jnp.float32) * scale
        rel = (start + jnp.arange(Q_BLOCK))[:, None] - k_pos[None, :]
        p = jax.nn.softmax(jnp.where(rel >= 0, s, NEG_INF), axis=-1).astype(v.dtype)
        return jnp.einsum('bhqk,bkhd->bqhd', p, v)

    out = lax.map(block, jnp.arange(S // Q_BLOCK))
    return jnp.transpose(out, (1, 0, 2, 3, 4)).reshape(B, S, H, v.shape[-1])


def setup_inputs(seed: int = 0) -> dict:
    key = jax.random.key(seed)
    ks = jax.random.split(key, 20)

    def nrm(k, shape, scale):
        return jax.random.normal(k, shape, jnp.float32) * scale

    x = nrm(ks[0], (BATCH, SEQ, D_MODEL), 1.0)
    offsets = jax.random.randint(ks[1], (BATCH, 1), 0, 4096, dtype=jnp.int32)
    positions = offsets + jnp.arange(SEQ, dtype=jnp.int32)[None, :]
    return {
        'x': x,
        'positions': positions,
        'rel_bias': nrm(ks[2], (T5_BUCKETS, N_BIAS_HEADS), 0.5),
        'norm_mix_pre': 1.0 + nrm(ks[3], (DEPTH, D_MODEL), 0.05),
        'norm_mix_post': 1.0 + nrm(ks[4], (DEPTH, D_MODEL), 0.05),
        'norm_mlp_pre': 1.0 + nrm(ks[5], (DEPTH, D_MODEL), 0.05),
        'norm_mlp_post': 1.0 + nrm(ks[6], (DEPTH, D_MODEL), 0.05),
        'w_in': nrm(ks[7], (DEPTH, D_MODEL, D_IN), D_MODEL ** -0.5),
        'diff_lambda': nrm(ks[8], (DEPTH, 4, DIFF_HEAD_DIM), 0.1),
        'diff_subln': 1.0 + nrm(ks[9], (DEPTH, 2 * DIFF_HEAD_DIM), 0.05),
        'mla_q_norm': 1.0 + nrm(ks[10], (DEPTH, MLA_Q_RANK), 0.05),
        'mla_w_uq': nrm(ks[11], (DEPTH, MLA_Q_RANK, MLA_HEADS * (MLA_NOPE_DIM + MLA_ROPE_DIM)), MLA_Q_RANK ** -0.5),
        'mla_kv_norm': 1.0 + nrm(ks[12], (DEPTH, MLA_KV_RANK), 0.05),
        'mla_w_ukv': nrm(ks[13], (DEPTH, MLA_KV_RANK, MLA_HEADS * (MLA_NOPE_DIM + MLA_V_DIM)), MLA_KV_RANK ** -0.5),
        'w_branch': nrm(ks[14], (DEPTH, N_BRANCH, BRANCH_WIDTH, D_MODEL), BRANCH_WIDTH ** -0.5),
        'w_out': nrm(ks[15], (DEPTH, D_MODEL, D_MODEL), D_MODEL ** -0.5),
        'w_up': nrm(ks[16], (DEPTH, D_MODEL, D_FF), D_MODEL ** -0.5),
        'w_down': nrm(ks[17], (DEPTH, D_FF, D_MODEL), D_FF ** -0.5),
    }


def reference(x, positions, rel_bias, norm_mix_pre, norm_mix_post, norm_mlp_pre, norm_mlp_post,
              w_in, diff_lambda, diff_subln, mla_q_norm, mla_w_uq, mla_kv_norm, mla_w_ukv,
              w_branch, w_out, w_up, w_down):
    B, S, _ = x.shape
    for l in range(DEPTH):
        lam_init = 0.8 - 0.6 * math.exp(-0.3 * l)
        h = _rms_norm(x, norm_mix_pre[l])
        proj = jnp.einsum('bsd,de->bse', h, w_in[l])
        dq, dk, dv, mq, mk, mv, c_q, c_kv, k_pe, g = jnp.split(proj, IN_OFFSETS, axis=-1)

        dq = dq.reshape(B, S, DIFF_HEADS, 2, DIFF_HEAD_DIM)
        dk = dk.reshape(B, S, DIFF_HEADS, 2, DIFF_HEAD_DIM)
        dv = dv.reshape(B, S, DIFF_HEADS, 2 * DIFF_HEAD_DIM)
        lam_vecs = diff_lambda[l].astype(jnp.float32)
        lam = (jnp.exp(jnp.sum(lam_vecs[0] * lam_vecs[1]))
               - jnp.exp(jnp.sum(lam_vecs[2] * lam_vecs[3])) + lam_init)
        oa = _diff_attention(dq[..., 0, :], dq[..., 1, :], dk[..., 0, :], dk[..., 1, :], dv,
                             lam, rel_bias[:, :DIFF_HEADS])
        oa = (_rms_norm(oa, diff_subln[l]) * (1.0 - lam_init)).reshape(B, S, DIFF_V_WIDTH)

        ob = _moba_attention(mq.reshape(B, S, MOBA_HEADS, MOBA_HEAD_DIM),
                             mk.reshape(B, S, MOBA_HEADS, MOBA_HEAD_DIM),
                             mv.reshape(B, S, MOBA_HEADS, MOBA_HEAD_DIM),
                             rel_bias[:, DIFF_HEADS:]).reshape(B, S, MOBA_WIDTH)

        q = jnp.einsum('bsr,re->bse', _rms_norm(c_q, mla_q_norm[l]), mla_w_uq[l])
        q = q.reshape(B, S, MLA_HEADS, MLA_NOPE_DIM + MLA_ROPE_DIM)
        q = jnp.concatenate([q[..., :MLA_NOPE_DIM], _rope(q[..., MLA_NOPE_DIM:], positions)], axis=-1)
        kv = jnp.einsum('bsr,re->bse', _rms_norm(c_kv, mla_kv_norm[l]), mla_w_ukv[l])
        kv = kv.reshape(B, S, MLA_HEADS, MLA_NOPE_DIM + MLA_V_DIM)
        k_rope = jnp.broadcast_to(_rope(k_pe[:, :, None, :], positions), (B, S, MLA_HEADS, MLA_ROPE_DIM))
        k = jnp.concatenate([kv[..., :MLA_NOPE_DIM], k_rope], axis=-1)
        oc = _dense_causal_attention(q, k, kv[..., MLA_NOPE_DIM:],
                                     1.0 / math.sqrt(MLA_NOPE_DIM + MLA_ROPE_DIM)).reshape(B, S, MLA_WIDTH)

        branches = jnp.stack([oa, ob, oc], axis=2)
        br = jnp.einsum('bsgc,gcd->bsgd', branches, w_branch[l])
        gates = jax.nn.sigmoid(g.reshape(B, S, N_BRANCH, D_MODEL))
        mixed = jnp.einsum('bsd,de->bse', jnp.sum(gates * br, axis=2), w_out[l])
        x = x + _rms_norm(mixed, norm_mix_post[l])

        h = _rms_norm(x, norm_mlp_pre[l])
        u = jnp.square(jax.nn.relu(jnp.einsum('bsd,df->bsf', h, w_up[l])))
        x = x + _rms_norm(jnp.einsum('bsf,fd->bsd', u, w_down[l]), norm_mlp_post[l])
    return x
```

```cpp
#include <hip/hip_runtime.h>
#include <cstdio>
#include <cstdint>
__device__ __forceinline__ int opaque_tid(int wave_s) { int l; asm volatile("v_mbcnt_lo_u32_b32 %0, -1, 0\n\tv_mbcnt_hi_u32_b32 %0, -1, %0" : "=v"(l)); return wave_s * 64 + l; }
__device__ __forceinline__ int opaque_s(int v) { asm volatile("" : "+s"(v)); return v; }
namespace pg8 {
#define PG8_LAS __attribute__((address_space(3)))
typedef unsigned short bf16_t;
typedef short bf16x8 __attribute__((ext_vector_type(8)));
typedef float f32x4 __attribute__((ext_vector_type(4)));
typedef unsigned u32x4 __attribute__((ext_vector_type(4)));
constexpr int BM = 256, BK = 64, HALF = 128, HTB = HALF * BK * 2  , STAGE_BYTES = 8 * HTB, NXCD = 8, WGM = 8;

__host__ __device__ __forceinline__ int lds_byte(int r, int c) { const int st = (r >> 4) * 2 + (c >> 5), rr = r & 15, cc = c & 31, ob = rr * 64 + cc * 2; return st * 1024 + (ob ^ (((ob >> 9) & 1) << 5)); }
__host__ __device__ __forceinline__ void stage_rc(int b, int& R, int& C) { const int st = b / 1024, sb = b % 1024, swz = sb ^ (((sb >> 9) & 1) << 5); R = (st >> 1) * 16 + swz / 64; C = (st & 1) * 32 + (swz % 64) / 2; }
__host__ __device__ __forceinline__ int perm32(int rho) { const int n = rho >> 4, i = rho & 15; return 8 * (i >> 2) + 4 * n + (i & 3); }

struct Unit { int pm, pn; };
struct Gemm { const bf16_t* A; const bf16_t* Bt; int M, N, K, lda; };

struct StaticOrder {
    int nM, nN, nwg, G, c;
    __host__ __device__ void init(int M, int N, int G_, int c_) { nM = M / BM; nN = N / BM; nwg = nM * nN; G = G_; c = c_; }
    __host__ __device__ bool next(int i, Unit& u) const {
        const long L = (long)i * G + c; if (L >= nwg) return false;
        int wgid = (int)L; { const int q = nwg / NXCD, r = nwg % NXCD, xcd = wgid % NXCD, off = wgid / NXCD; wgid = (xcd < r ? xcd * (q + 1) : r * (q + 1) + (xcd - r) * q) + off; }
        const int nig = WGM * nN, gid = wgid / nig, fm = gid * WGM, gsz = (nM - fm) < WGM ? (nM - fm) : WGM;
        u.pm = fm + ((wgid % nig) % gsz); u.pn = (wgid % nig) / gsz; return true;
    }
    __device__ __forceinline__ void a_ready(const Unit&) const {}
    __device__ __forceinline__ void done(const Unit&) const {}
};

typedef float f32x2c __attribute__((ext_vector_type(2))); typedef __bf16 bf16x2c __attribute__((ext_vector_type(2)));
__device__ __forceinline__ unsigned cvt_pk_bf16(float lo, float hi) { f32x2c v = {lo, hi}; bf16x2c b = __builtin_convertvector(v, bf16x2c); return __builtin_bit_cast(unsigned, b); }
__device__ __forceinline__ float bf_lo(unsigned w) { return __builtin_bit_cast(float, w << 16); }
__device__ __forceinline__ float bf_hi(unsigned w) { return __builtin_bit_cast(float, w & 0xffff0000u); }
__device__ __forceinline__ float act_sigmoid(float v) { return __builtin_amdgcn_rcpf(1.f + __builtin_amdgcn_exp2f(-1.4426950408889634f * v)); }
__device__ __forceinline__ float act_relu2(float v) { const float r = fmaxf(v, 0.f); return r * r; }

template <int ACT  > struct EpiBf16 {
    static constexpr bool PERM = true, AFTER_DRAIN = false;
    bf16_t* O; int ldc; int split_cols; size_t split_stride; int pn2; bf16_t* O2; int ldc2; const float* rs;
    __device__ __forceinline__ void operator()(const f32x4 (&acc)[2][2][4][2], const Unit& u, int wr, int wc, int fr, int fq) const {
        const int row0 = u.pm * BM + wr * 64 + fr; int colt = u.pn * BM; bf16_t* base = O; int ldc = this->ldc;
        if (pn2 && u.pn >= pn2) { base = O2; ldc = ldc2; colt = (u.pn - pn2) * BM; }
        if (split_cols) { const int t = colt / split_cols; base += (size_t)t * split_stride; colt -= t * split_cols; }
        const int col0 = colt + wc * 32 + 8 * fq;
#pragma unroll
        for (int ai = 0; ai < 2; ++ai)
#pragma unroll
            for (int m = 0; m < 4; ++m) { bf16_t* rowp = base + (size_t)(row0 + ai * HALF + m * 16) * ldc + col0; const float rsc = rs ? rs[row0 + ai * HALF + m * 16] : 1.f;
#pragma unroll
                for (int bj = 0; bj < 2; ++bj) { f32x4 v0 = acc[ai][bj][m][0] * rsc, v1 = acc[ai][bj][m][1] * rsc;
                    if (ACT == 2) { v0 = (f32x4){act_sigmoid(v0[0]), act_sigmoid(v0[1]), act_sigmoid(v0[2]), act_sigmoid(v0[3])}; v1 = (f32x4){act_sigmoid(v1[0]), act_sigmoid(v1[1]), act_sigmoid(v1[2]), act_sigmoid(v1[3])}; }
                    if (ACT == 3) { v0 = (f32x4){act_relu2(v0[0]), act_relu2(v0[1]), act_relu2(v0[2]), act_relu2(v0[3])}; v1 = (f32x4){act_relu2(v1[0]), act_relu2(v1[1]), act_relu2(v1[2]), act_relu2(v1[3])}; }
                    u32x4 w; w.x = cvt_pk_bf16(v0[0], v0[1]); w.y = cvt_pk_bf16(v0[2], v0[3]); w.z = cvt_pk_bf16(v1[0], v1[1]); w.w = cvt_pk_bf16(v1[2], v1[3]);
                    *(u32x4*)(rowp + bj * HALF) = w; } }
    }
};

struct EpiF32 {
    static constexpr bool PERM = true, AFTER_DRAIN = false;
    float* O; int ldc;
    __device__ __forceinline__ void operator()(const f32x4 (&acc)[2][2][4][2], const Unit& u, int wr, int wc, int fr, int fq) const {
        const int row0 = u.pm * BM + wr * 64 + fr; const int col0 = u.pn * BM + wc * 32 + 8 * fq;
#pragma unroll
        for (int ai = 0; ai < 2; ++ai)
#pragma unroll
            for (int m = 0; m < 4; ++m) { float* rowp = O + (size_t)(row0 + ai * HALF + m * 16) * ldc + col0;
#pragma unroll
                for (int bj = 0; bj < 2; ++bj) { *(f32x4*)(rowp + bj * HALF) = acc[ai][bj][m][0]; *(f32x4*)(rowp + bj * HALF + 4) = acc[ai][bj][m][1]; } }
    }
};

struct EpiBranch {
    static constexpr bool PERM = true, AFTER_DRAIN = false;
    const bf16_t* S; bf16_t* Mo;
    __device__ __forceinline__ void operator()(const f32x4 (&acc)[2][2][4][2], const Unit& u, int wr, int wc, int fr, int fq) const {
        const int g = u.pm >> 7, pm = u.pm & 127, pn = u.pn & 3;
        const int row0 = pm * BM + wr * 64 + fr; const int col0 = pn * BM + wc * 32 + 8 * fq;
#pragma unroll
        for (int ai = 0; ai < 2; ++ai)
#pragma unroll
            for (int m = 0; m < 4; ++m) { const size_t row = (size_t)(row0 + ai * HALF + m * 16);
#pragma unroll
                for (int bj = 0; bj < 2; ++bj) { const int col = col0 + bj * HALF;
                    const u32x4 sv = *(const u32x4*)(S + row * 3072 + g * 1024 + col);
                    const f32x4 v0 = acc[ai][bj][m][0], v1 = acc[ai][bj][m][1];
                    float r0 = bf_lo(sv.x) * v0[0], r1 = bf_hi(sv.x) * v0[1], r2 = bf_lo(sv.y) * v0[2], r3 = bf_hi(sv.y) * v0[3];
                    float r4 = bf_lo(sv.z) * v1[0], r5 = bf_hi(sv.z) * v1[1], r6 = bf_lo(sv.w) * v1[2], r7 = bf_hi(sv.w) * v1[3];
                    u32x4* dst = (u32x4*)(Mo + row * 1024 + col);
                    if (g > 0) { const u32x4 pv = *dst; r0 += bf_lo(pv.x); r1 += bf_hi(pv.x); r2 += bf_lo(pv.y); r3 += bf_hi(pv.y); r4 += bf_lo(pv.z); r5 += bf_hi(pv.z); r6 += bf_lo(pv.w); r7 += bf_hi(pv.w); }
                    u32x4 w; w.x = cvt_pk_bf16(r0, r1); w.y = cvt_pk_bf16(r2, r3); w.z = cvt_pk_bf16(r4, r5); w.w = cvt_pk_bf16(r6, r7);
                    *dst = w; } }
    }
};
struct BranchOrder {
    StaticOrder S0;
    __device__ void init(int M, int G_, int c_) { S0.init(M, 1024, G_, c_); }
    __device__ bool next(int i, Unit& u) const { Unit t; if (!S0.next(i / 3, t)) return false; const int g = i % 3; u.pm = g * 128 + t.pm; u.pn = g * 4 + t.pn; return true; }
    __device__ __forceinline__ void a_ready(const Unit&) const {}
    __device__ __forceinline__ void done(const Unit&) const {}
};

template <class Epi, class Sched, bool ALIGN_EPI = false, bool SP2 = false>
__device__ __forceinline__ void gemm_phase(PG8_LAS unsigned char* lds, const Gemm g, const Sched& S, const Epi& E, int wave_s) {
    const int tid = opaque_tid(wave_s), wid = __builtin_amdgcn_readfirstlane(tid >> 6), lane = tid & 63, wr = wid >> 2, wc = wid & 3, fr = lane & 15, fq = lane >> 4;
    const int K = g.K, nt = K / BK;
    unsigned voffA[2], voffB[2];
#pragma unroll
    for (int i = 0; i < 2; ++i) { int R, C; stage_rc(tid * 16 + i * 8192, R, C); const int Rb = Epi::PERM ? ((R & ~31) + perm32(R & 31)) : R;
        voffA[i] = (unsigned)(R * g.lda + C) * 2u; voffB[i] = (unsigned)(Rb * K + C) * 2u; }
    const size_t kstep = (size_t)(BK * 2);
    const size_t hstep = (size_t)HALF * K * 2;
    const size_t tstep = 2 * hstep; const size_t hstepA = (size_t)HALF * g.lda * 2, tstepA = 2 * hstepA;
    const unsigned ldsw = (unsigned)wid * 1024u;
    const int aoff = lds_byte(wr * 64 + fr, fq * 8), boff = lds_byte(wc * 32 + fr, fq * 8);
#define PG8_SA(b, h) (((b) * 2 + (h)) * HTB)
#define PG8_SB(b, h) ((4 + (b) * 2 + (h)) * HTB)
#define PG8_STAGE(bufoff, gbase, voff) do { _Pragma("unroll") for (int _i = 0; _i < 2; ++_i) \
        __builtin_amdgcn_global_load_lds((const unsigned*)((const char*)(gbase) + (voff)[_i]), (PG8_LAS unsigned*)(lds + (bufoff) + ldsw + _i * 8192), 16, 0, 0); } while (0)
#define PG8_LDA(dst, b, h) do { _Pragma("unroll") for (int m = 0; m < 4; ++m) _Pragma("unroll") for (int k = 0; k < 2; ++k) dst[m][k] = *(const PG8_LAS bf16x8*)(lds + PG8_SA(b, h) + aoff + m * 2048 + k * 1024); } while (0)
#define PG8_LDB(dst, b, h) do { _Pragma("unroll") for (int n = 0; n < 2; ++n) _Pragma("unroll") for (int k = 0; k < 2; ++k) dst[n][k] = *(const PG8_LAS bf16x8*)(lds + PG8_SB(b, h) + boff + n * 2048 + k * 1024); } while (0)
#define PG8_MMA(ai, bj, At, Bt) do { __builtin_amdgcn_s_setprio(1); _Pragma("unroll") for (int m = 0; m < 4; ++m) _Pragma("unroll") for (int n = 0; n < 2; ++n) _Pragma("unroll") for (int k = 0; k < 2; ++k) \
        acc[ai][bj][m][n] = __builtin_amdgcn_mfma_f32_16x16x32_bf16(Bt[n][k], At[m][k], acc[ai][bj][m][n], 0, 0, 0); __builtin_amdgcn_s_setprio(0); } while (0)
#define PG8_WAIT_V(n) asm volatile("s_waitcnt vmcnt(" #n ")" ::: "memory")
#define PG8_WAIT_L(n) asm volatile("s_waitcnt lgkmcnt(" #n ")" ::: "memory")
#define PG8_BAR __builtin_amdgcn_s_barrier()
#define PG8_SCHED __builtin_amdgcn_sched_barrier(0)
    Unit cur, nxt; int ui = 0;
    if (!S.next(0, cur)) return;
    f32x4 acc[2][2][4][2];
#pragma unroll
    for (int a = 0; a < 2; ++a)
#pragma unroll
        for (int b = 0; b < 2; ++b)
#pragma unroll
            for (int m = 0; m < 4; ++m)
#pragma unroll
                for (int n = 0; n < 2; ++n) acc[a][b][m][n] = (f32x4){0.f, 0.f, 0.f, 0.f};
    bf16x8 At[4][2], B0[2][2], B1[2][2];
    const char* cA = (const char*)g.A + (size_t)cur.pm * tstepA; const char* cB = (const char*)g.Bt + (size_t)cur.pn * tstep;
    S.a_ready(cur);
    if constexpr (SP2) {
        PG8_STAGE(PG8_SB(0, 0), cB, voffB); PG8_STAGE(PG8_SB(0, 1), cB + hstep, voffB); PG8_STAGE(PG8_SA(0, 0), cA, voffA); PG8_STAGE(PG8_SA(0, 1), cA + hstepA, voffA);
        if (wr == 1) PG8_BAR;
        PG8_WAIT_V(2); PG8_BAR;
        PG8_STAGE(PG8_SB(1, 0), cB + kstep, voffB); PG8_STAGE(PG8_SA(1, 0), cA + kstep, voffA); PG8_STAGE(PG8_SB(1, 1), cB + hstep + kstep, voffB);
        PG8_WAIT_V(6); PG8_BAR;
    } else {
        PG8_STAGE(PG8_SB(0, 0), cB, voffB); PG8_STAGE(PG8_SA(0, 0), cA, voffA); PG8_STAGE(PG8_SB(0, 1), cB + hstep, voffB); PG8_STAGE(PG8_SA(0, 1), cA + hstepA, voffA);
        if (wr == 1) PG8_BAR;
        PG8_WAIT_V(4); PG8_BAR;
        PG8_STAGE(PG8_SB(1, 0), cB + kstep, voffB); PG8_STAGE(PG8_SA(1, 0), cA + kstep, voffA); PG8_STAGE(PG8_SB(1, 1), cB + hstep + kstep, voffB);
        PG8_WAIT_V(6); PG8_BAR;
    }
    for (;;) {
        const bool has_next = S.next(ui + 1, nxt);
        const char* nA = has_next ? (const char*)g.A + (size_t)nxt.pm * tstepA : cA; const char* nB = has_next ? (const char*)g.Bt + (size_t)nxt.pn * tstep : cB;
        for (int t = 0; t < nt; t += 2) {
            const bool last = (t == nt - 2);
            const char* a1 = cA + (size_t)(t + 1) * kstep;
            const char* a2 = last ? nA : cA + (size_t)(t + 2) * kstep; const char* b2 = last ? nB : cB + (size_t)(t + 2) * kstep;
            const char* a3 = a2 + kstep; const char* b3 = b2 + kstep;
            if (last && has_next) S.a_ready(nxt);
            if constexpr (SP2) {
            PG8_LDB(B0, 0, 0); PG8_LDB(B1, 0, 1); PG8_SCHED; PG8_LDA(At, 0, 0); PG8_STAGE(PG8_SA(1, 1), a1 + hstepA, voffA);
            PG8_WAIT_V(8); PG8_WAIT_L(0); PG8_BAR; PG8_MMA(0, 0, At, B0); PG8_MMA(0, 1, At, B1); PG8_BAR; PG8_SCHED;
            PG8_LDA(At, 0, 1); PG8_STAGE(PG8_SB(0, 0), b2, voffB); PG8_STAGE(PG8_SB(0, 1), b2 + hstep, voffB); PG8_STAGE(PG8_SA(0, 0), a2, voffA);
            PG8_WAIT_V(8); PG8_WAIT_L(0); PG8_BAR; PG8_MMA(1, 0, At, B0); PG8_MMA(1, 1, At, B1); PG8_BAR; PG8_SCHED;
            PG8_LDB(B0, 1, 0); PG8_LDB(B1, 1, 1); PG8_SCHED; PG8_LDA(At, 1, 0); PG8_STAGE(PG8_SA(0, 1), a2 + hstepA, voffA);
            PG8_WAIT_V(8); PG8_WAIT_L(0); PG8_BAR; PG8_MMA(0, 0, At, B0); PG8_MMA(0, 1, At, B1); PG8_BAR; PG8_SCHED;
            PG8_LDA(At, 1, 1); PG8_STAGE(PG8_SB(1, 0), b3, voffB); PG8_STAGE(PG8_SB(1, 1), b3 + hstep, voffB); PG8_STAGE(PG8_SA(1, 0), a3, voffA);
            PG8_WAIT_V(8); PG8_WAIT_L(0); PG8_BAR; PG8_MMA(1, 0, At, B0); PG8_MMA(1, 1, At, B1); PG8_BAR; PG8_SCHED;
            } else {
            PG8_LDB(B0, 0, 0); PG8_SCHED; PG8_LDA(At, 0, 0); PG8_STAGE(PG8_SA(1, 1), a1 + hstepA, voffA);
            PG8_WAIT_L(8); PG8_BAR; PG8_WAIT_L(0); PG8_MMA(0, 0, At, B0); PG8_BAR; PG8_SCHED;
            PG8_LDB(B1, 0, 1); PG8_STAGE(PG8_SB(0, 0), b2, voffB);
            PG8_BAR; PG8_WAIT_L(0); PG8_MMA(0, 1, At, B1); PG8_BAR;
            PG8_LDA(At, 0, 1); PG8_STAGE(PG8_SA(0, 0), a2, voffA);
            PG8_BAR; PG8_WAIT_L(0); PG8_MMA(1, 0, At, B0); PG8_BAR; PG8_SCHED;
            PG8_STAGE(PG8_SB(0, 1), b2 + hstep, voffB);
            PG8_WAIT_V(6); PG8_BAR; PG8_MMA(1, 1, At, B1); PG8_BAR;
            PG8_LDB(B0, 1, 0); PG8_SCHED; PG8_LDA(At, 1, 0); PG8_STAGE(PG8_SA(0, 1), a2 + hstepA, voffA);
            PG8_WAIT_L(8); PG8_BAR; PG8_WAIT_L(0); PG8_MMA(0, 0, At, B0); PG8_BAR; PG8_SCHED;
            PG8_LDB(B1, 1, 1); PG8_STAGE(PG8_SB(1, 0), b3, voffB);
            PG8_BAR; PG8_WAIT_L(0); PG8_MMA(0, 1, At, B1); PG8_BAR;
            PG8_LDA(At, 1, 1); PG8_STAGE(PG8_SA(1, 0), a3, voffA);
            PG8_BAR; PG8_WAIT_L(0); PG8_MMA(1, 0, At, B0); PG8_BAR; PG8_SCHED;
            PG8_STAGE(PG8_SB(1, 1), b3 + hstep, voffB);
            PG8_WAIT_V(6); PG8_BAR; PG8_MMA(1, 1, At, B1); PG8_BAR;
            }
        }
        if constexpr (ALIGN_EPI) { if (wr == 0) PG8_BAR; }
        if constexpr (!Epi::AFTER_DRAIN) { E(acc, cur, wr, wc, fr, fq); S.done(cur); }
        if (!has_next) break;
#pragma unroll
        for (int a = 0; a < 2; ++a)
#pragma unroll
            for (int b = 0; b < 2; ++b)
#pragma unroll
                for (int m = 0; m < 4; ++m)
#pragma unroll
                    for (int n = 0; n < 2; ++n) acc[a][b][m][n] = (f32x4){0.f, 0.f, 0.f, 0.f};
        cur = nxt; cA = nA; cB = nB; ++ui;
        if constexpr (ALIGN_EPI) { if (wr == 1) PG8_BAR; }
    }
    PG8_WAIT_V(0);
    if constexpr (!ALIGN_EPI) { if (wr == 0) PG8_BAR; }
    PG8_BAR;
    if constexpr (Epi::AFTER_DRAIN) { E.fused(acc, cur, wr, wc, fr, fq, lds, wid, lane); S.done(cur); }
#undef PG8_SA
#undef PG8_SB
#undef PG8_STAGE
#undef PG8_LDA
#undef PG8_LDB
#undef PG8_MMA
#undef PG8_WAIT_V
#undef PG8_WAIT_L
#undef PG8_BAR
#undef PG8_SCHED
}
}

constexpr int NB = 4, SEQ = 8192, DM = 1024, T = NB * SEQ, DEPTH = 4, DIN = 6560, DFF = 4096;
constexpr float RMS_EPS = 1e-6f;
#define N_LAUNCH 1
constexpr int NWAVES = 8;
#ifndef ATM
#define ATM 7
#endif
constexpr size_t MiB = 1u << 20;
constexpr size_t WS_CTL = 0, CTL_ZERO_BYTES = 65536;
constexpr size_t WS_RS = 768 * 1024;
constexpr size_t WS_KMEAN = 512 * 1024;
constexpr size_t WS_W1T = 1 * MiB, WS_WGT = 8 * MiB, WS_WQKV = 14 * MiB  , WS_WBT = 16 * MiB, WS_WOT = 19 * MiB, WS_WUPT = 21 * MiB, WS_WDNT = 29 * MiB;
constexpr size_t WS_H = 37 * MiB;
constexpr size_t WS_OA = 101 * MiB, WS_OB = 133 * MiB, WS_OC = 165 * MiB, WS_DK = 197 * MiB, WS_DV = 229 * MiB, WS_MK = 261 * MiB, WS_MV = 293 * MiB;
constexpr size_t WS_Q = 325 * MiB, WS_KV = 373 * MiB, WS_KR = 437 * MiB, WS_O12 = 439 * MiB;
constexpr size_t WS_ROPE = 503 * MiB, WS_END = 507 * MiB;
constexpr size_t WS_S = 197 * MiB;
constexpr size_t WS_Y = 197 * MiB;
constexpr size_t WS_U = 101 * MiB;
constexpr size_t WS_D = 373 * MiB;
constexpr size_t SLOT = (size_t)T * 512;
constexpr int CW_BAR = 4096;
constexpr int CW_QUEUE = 8192;

constexpr int RING_OFF = 0, RING_BYTES = 131072;
constexpr int MISC_OFF = RING_BYTES + 320;
constexpr int LDS_BYTES = 147456;
constexpr int A_KOFF = 0, A_VOFF = 34816, A_TAB = 96256, A_WSCR = 100352, A_KMEAN = 102400, A_SLOT = 118784;

#define GAS __attribute__((address_space(1)))
#define LAS __attribute__((address_space(3)))
typedef unsigned short bf16;
typedef unsigned v4u __attribute__((ext_vector_type(4)));
typedef unsigned v2u __attribute__((ext_vector_type(2)));
typedef float f32x4 __attribute__((ext_vector_type(4)));
typedef float f32x2_t __attribute__((ext_vector_type(2)));
typedef float f32x16 __attribute__((ext_vector_type(16)));
typedef short bf16x8 __attribute__((ext_vector_type(8)));
typedef short s16x4 __attribute__((ext_vector_type(4)));
typedef short v4i16_t __attribute__((ext_vector_type(4)));
typedef __bf16 bf16x2_t __attribute__((ext_vector_type(2)));
typedef GAS unsigned gu32;
#define RLX_AGENT __ATOMIC_RELAXED, __HIP_MEMORY_SCOPE_AGENT
#define LDS_WAIT() asm volatile("s_waitcnt lgkmcnt(0)" ::: "memory")
#define VM_WAIT() asm volatile("s_waitcnt vmcnt(0)" ::: "memory")
__device__ __forceinline__ unsigned f2bf(float f) { unsigned u = __builtin_bit_cast(unsigned, f); return (u + 0x7fffu + ((u >> 16) & 1u)) >> 16; }
__device__ __forceinline__ unsigned pk2(float lo, float hi) { return f2bf(lo) | (f2bf(hi) << 16); }
__device__ __forceinline__ unsigned cvtpk_s(float lo, float hi) { f32x2_t v = {lo, hi}; bf16x2_t b = __builtin_convertvector(v, bf16x2_t); return __builtin_bit_cast(unsigned, b); }
__device__ __forceinline__ float bflo(unsigned w) { return __builtin_bit_cast(float, w << 16); }
__device__ __forceinline__ float bfhi(unsigned w) { return __builtin_bit_cast(float, w & 0xffff0000u); }
__device__ __forceinline__ float bf2f(short s) { return __builtin_bit_cast(float, ((unsigned)(unsigned short)s) << 16); }

#define XB_TMO      128
#define XB_XCNT(j)  (256  + 64 * (j))
#define XB_XSUB(j)  (1280 + 64 * (j))
#define XB_XGEN(j)  (2304 + 64 * (j))
#define XB_TOP      3328
#define XB_TOPGEN   3392
#define XCD_BAR_WORDS 3456
#define XB_SPIN_CAP (1u << 20)

__device__ __forceinline__ unsigned xb_ld(unsigned* p)              { return __hip_atomic_load(p, __ATOMIC_RELAXED, __HIP_MEMORY_SCOPE_AGENT); }
__device__ __forceinline__ unsigned xb_add(unsigned* p, unsigned v) { return __hip_atomic_fetch_add(p, v, __ATOMIC_RELAXED, __HIP_MEMORY_SCOPE_AGENT); }
__device__ __forceinline__ unsigned xb_xcc_id() { return (unsigned)__builtin_amdgcn_s_getreg((3 << 11) | 20) & 0xFu; }
#define XB_SPIN(cond, bar) do { unsigned _sp = 0; while (cond) { __builtin_amdgcn_s_sleep(1); \
    if ((++_sp & 255u) == 0u) { if (xb_ld(&(bar)[XB_TMO])) break; if (_sp > XB_SPIN_CAP) { atomicAdd(&(bar)[XB_TMO], 1u); break; } } } } while (0)

struct XcdBarrier {
    unsigned* bar; unsigned x;
    volatile LAS unsigned* st;
};
__device__ __forceinline__ XcdBarrier xcd_barrier_post(unsigned* bar, volatile LAS unsigned* st) {
    XcdBarrier b; b.bar = bar; b.x = xb_xcc_id(); b.st = st;
    if (threadIdx.x == 0) (void)xb_add(&bar[XB_XCNT(b.x)], 1u);
    return b;
}
__device__ __forceinline__ void xcd_barrier_complete(unsigned* bar, unsigned x, unsigned& nloc, unsigned& nx) {
    const unsigned G = gridDim.x * gridDim.y * gridDim.z;
    unsigned sum, cnt, mine, sp = 0u;
    for (;;) {
        sum = 0u; cnt = 0u; mine = 0u;
#pragma unroll
        for (unsigned j = 0; j < 16; ++j) { const unsigned c = xb_ld(&bar[XB_XCNT(j)]); sum += c; cnt += (c > 0u) ? 1u : 0u; mine = (j == x) ? c : mine; }
        if (sum == G) break;
        __builtin_amdgcn_s_sleep(1);
        if ((++sp & 255u) == 0u) { if (xb_ld(&bar[XB_TMO])) break; if (sp > XB_SPIN_CAP) { atomicAdd(&bar[XB_TMO], 1u); break; } }
    }
    nloc = mine > 0u ? mine : 1u; nx = cnt > 0u ? cnt : 1u;
}
__device__ __forceinline__ void xcd_barrier(const XcdBarrier& b, int tid_) {
    asm volatile("s_waitcnt vmcnt(0)" ::: "memory");
    __syncthreads();
    if (tid_ == 0) {
        unsigned* bar = b.bar;
        __builtin_amdgcn_s_waitcnt(0);
        unsigned nloc = b.st[0], nx = b.st[1];
        if (nloc == 0u) { xcd_barrier_complete(bar, b.x, nloc, nx); b.st[0] = nloc; b.st[1] = nx; }
        const unsigned old = xb_add(&bar[XB_XSUB(b.x)], 1u);
        const unsigned gen = old / nloc;
        if (old + 1u == (gen + 1u) * nloc) {
            __builtin_amdgcn_fence(__ATOMIC_RELEASE, "agent");
            asm volatile("s_waitcnt vmcnt(0)" ::: "memory");
            const unsigned og = xb_add(&bar[XB_TOP], 1u);
            const unsigned tg = og / nx;
            if (og + 1u == (tg + 1u) * nx) xb_add(&bar[XB_TOPGEN], 1u);
            else XB_SPIN(xb_ld(&bar[XB_TOPGEN]) == tg, bar);
            __builtin_amdgcn_fence(__ATOMIC_ACQUIRE, "agent");
            xb_add(&bar[XB_XGEN(b.x)], 1u);
            asm volatile("s_waitcnt vmcnt(0)" ::: "memory");
        } else {
            XB_SPIN(xb_ld(&bar[XB_XGEN(b.x)]) == gen, bar);
            __builtin_amdgcn_fence(__ATOMIC_ACQUIRE, "agent");
            asm volatile("s_waitcnt vmcnt(0)" ::: "memory");
        }
    }
    __syncthreads();
}

__device__ __forceinline__ float shfl_xor_l(float v, int o, int lane) { return __builtin_bit_cast(float, __builtin_amdgcn_ds_bpermute((lane ^ o) << 2, __builtin_bit_cast(int, v))); }
__device__ __forceinline__ float wave_sum(float v, int lane) {
#pragma unroll
    for (int o = 1; o < 64; o <<= 1) v += shfl_xor_l(v, o, lane);
    return v;
}
__device__ __forceinline__ void tr_item(const float* W, int ldw, int k0, int n0, bf16* WT, int drow0, int Kd, int kd0, const float* ksc, LAS float* scr, int lane) {
    f32x4 v_[8]; float sc_[8];
#pragma unroll
    for (int i = 0; i < 8; ++i) { const int kk = 8 * i + (lane >> 3); v_[i] = *(const f32x4*)(W + (size_t)(k0 + kk) * ldw + n0 + 4 * (lane & 7)); sc_[i] = ksc ? ksc[k0 + kk] : 1.f; }
#pragma unroll
    for (int i = 0; i < 8; ++i) { const int kk = 8 * i + (lane >> 3); LAS float* d_ = scr + kk * 33 + 4 * (lane & 7);
        d_[0] = v_[i].x * sc_[i]; d_[1] = v_[i].y * sc_[i]; d_[2] = v_[i].z * sc_[i]; d_[3] = v_[i].w * sc_[i]; }
    LDS_WAIT(); asm volatile("" ::: "memory");
    const int c = lane & 7;
#pragma unroll
    for (int j = 0; j < 4; ++j) { const int n = (lane >> 3) + 8 * j; const LAS float* s = scr + (8 * c) * 33 + n;
        v4u o; o.x = pk2(s[0 * 33], s[1 * 33]); o.y = pk2(s[2 * 33], s[3 * 33]); o.z = pk2(s[4 * 33], s[5 * 33]); o.w = pk2(s[6 * 33], s[7 * 33]);
        *(v4u*)(WT + (size_t)(drow0 + n) * Kd + kd0 + k0 + 8 * c) = o; }
    LDS_WAIT(); asm volatile("" ::: "memory");
}
__device__ __forceinline__ void zero_item(bf16* WT, int drow0, int Kd, int k0, int lane) {
    const int c = lane & 7;
#pragma unroll
    for (int j = 0; j < 4; ++j) { const int n = (lane >> 3) + 8 * j; *(v4u*)(WT + (size_t)(drow0 + n) * Kd + k0 + 8 * c) = (v4u){0u, 0u, 0u, 0u}; }
}
__device__ __forceinline__ bool seg_item(int& r, const float* W, int ldw, int K, int n_src0, int n_count, bf16* WT, int drow0, int Kd, int kd0, const float* ksc, LAS float* scr, int lane) {
    const int nb = n_count / 32, cnt = (K / 64) * nb;
    if (r >= cnt) { r -= cnt; return false; }
    const int kb = r / nb, b = r % nb;
    tr_item(W, ldw, 64 * kb, n_src0 + 32 * b, WT, drow0 + 32 * b, Kd, kd0, ksc, scr, lane);
    return true;
}
struct LayerW { const float *w_in, *uq, *ukv, *wb, *wo, *wup, *wdn, *n_mix, *n_mlp; };
__device__ __forceinline__ void convert_weights(const LayerW& L, unsigned char* ws, LAS float* scr, int gw, int NGW, int lane) {
    bf16* W1T = (bf16*)(ws + WS_W1T); bf16* WGT = (bf16*)(ws + WS_WGT); bf16* WQKV = (bf16*)(ws + WS_WQKV);
    bf16* WBT = (bf16*)(ws + WS_WBT); bf16* WOT = (bf16*)(ws + WS_WOT); bf16* WUPT = (bf16*)(ws + WS_WUPT); bf16* WDNT = (bf16*)(ws + WS_WDNT);
    constexpr int N_TR = 16 * (16 * 6 + 13) + 16 * 96 + 4 * 24 + 2 * 32 + 3 * 8 * 32 + 16 * 32 + 16 * 128 + 64 * 32;
    constexpr int N_Z1 = 16 * 3, N_Z2 = 2 * 24, N_Z3 = 4 * 32;
    for (int it = gw; it < N_TR + N_Z1 + N_Z2 + N_Z3; it += NGW) {
        int r = it;
        if (seg_item(r, L.w_in, DIN, 1024, 0,    512, W1T, 0,    1024, 0, L.n_mix, scr, lane)) continue;
        if (seg_item(r, L.w_in, DIN, 1024, 1536, 512, W1T, 512,  1024, 0, L.n_mix, scr, lane)) continue;
        if (seg_item(r, L.w_in, DIN, 1024, 3072, 416, W1T, 1024, 1024, 0, L.n_mix, scr, lane)) continue;
        if (seg_item(r, L.w_in, DIN, 1024, 512,  512, W1T, 1536, 1024, 0, L.n_mix, scr, lane)) continue;
        if (seg_item(r, L.w_in, DIN, 1024, 1024, 512, W1T, 2048, 1024, 0, L.n_mix, scr, lane)) continue;
        if (seg_item(r, L.w_in, DIN, 1024, 2048, 512, W1T, 2560, 1024, 0, L.n_mix, scr, lane)) continue;
        if (seg_item(r, L.w_in, DIN, 1024, 2560, 512, W1T, 3072, 1024, 0, L.n_mix, scr, lane)) continue;
        if (seg_item(r, L.w_in, DIN, 1024, 3488, 3072, WGT, 0,   1024, 0, L.n_mix, scr, lane)) continue;
        if (seg_item(r, L.uq,  768,  256, 0, 768,  WQKV, 0,   384, 0,   nullptr, scr, lane)) continue;
        if (seg_item(r, L.ukv, 1024, 128, 0, 1024, WQKV, 768, 384, 256, nullptr, scr, lane)) continue;
        if (seg_item(r, L.wb,                     1024, 512, 0, 1024, WBT, 0,    512, 0, nullptr, scr, lane)) continue;
        if (seg_item(r, L.wb + (size_t)512 * 1024, 1024, 512, 0, 1024, WBT, 1024, 512, 0, nullptr, scr, lane)) continue;
        if (seg_item(r, L.wb + (size_t)1024 * 1024, 1024, 512, 0, 1024, WBT, 2048, 512, 0, nullptr, scr, lane)) continue;
        if (seg_item(r, L.wo,  1024, 1024, 0, 1024, WOT,  0, 1024, 0, nullptr, scr, lane)) continue;
        if (seg_item(r, L.wup, 4096, 1024, 0, 4096, WUPT, 0, 1024, 0, L.n_mlp, scr, lane)) continue;
        if (seg_item(r, L.wdn, 1024, 4096, 0, 1024, WDNT, 0, 4096, 0, nullptr, scr, lane)) continue;
        if (r < N_Z1) { zero_item(W1T, 1440 + 32 * (r % 3), 1024, 64 * (r / 3), lane); continue; } r -= N_Z1;
        if (r < N_Z2) { zero_item(WQKV, 32 * (r % 24), 384, 256 + 64 * (r / 24), lane); continue; } r -= N_Z2;
        { const int kb = r / 32; zero_item(WQKV, 768 + 32 * (r % 32), 384, 64 * kb, lane); }
    }
}
__device__ __forceinline__ void norm_row_bf16(const float* xrow, const float* w, bf16* orow, int lane) {
    const f32x4* xr = (const f32x4*)xrow + lane; const f32x4* wr = (const f32x4*)w + lane;
    f32x4 v[4]; float s = 0.f;
#pragma unroll
    for (int j = 0; j < 4; ++j) { v[j] = xr[64 * j]; s += (v[j].x * v[j].x + v[j].y * v[j].y) + (v[j].z * v[j].z + v[j].w * v[j].w); }
    const float rstd = 1.f / sqrtf(wave_sum(s, lane) * (1.f / 1024.f) + RMS_EPS);
    v2u* o8 = (v2u*)orow + lane;
#pragma unroll
    for (int j = 0; j < 4; ++j) { const f32x4 ww = wr[64 * j]; v2u o; o.x = pk2(v[j].x * rstd * ww.x, v[j].y * rstd * ww.y); o.y = pk2(v[j].z * rstd * ww.z, v[j].w * rstd * ww.w); o8[64 * j] = o; }
}
__device__ __forceinline__ void resid_row(const float* yrow, const float* xold, float* xout, const float* wpost, const float* wnext, bf16* hout, int lane) {
    const f32x4* yr = (const f32x4*)yrow + lane; const f32x4* xr = (const f32x4*)xold + lane; const f32x4* wp = (const f32x4*)wpost + lane;
    f32x4 y[4], x[4]; float s = 0.f;
#pragma unroll
    for (int j = 0; j < 4; ++j) { y[j] = yr[64 * j]; x[j] = xr[64 * j]; s += (y[j].x * y[j].x + y[j].y * y[j].y) + (y[j].z * y[j].z + y[j].w * y[j].w); }
    const float r1 = 1.f / sqrtf(wave_sum(s, lane) * (1.f / 1024.f) + RMS_EPS);
    float s2 = 0.f; f32x4* xo = (f32x4*)xout + lane;
#pragma unroll
    for (int j = 0; j < 4; ++j) { const f32x4 ww = wp[64 * j]; x[j] = x[j] + y[j] * r1 * ww; xo[64 * j] = x[j]; s2 += (x[j].x * x[j].x + x[j].y * x[j].y) + (x[j].z * x[j].z + x[j].w * x[j].w); }
    if (wnext) {
        const float r2 = 1.f / sqrtf(wave_sum(s2, lane) * (1.f / 1024.f) + RMS_EPS);
        const f32x4* wn = (const f32x4*)wnext + lane; v2u* o8 = (v2u*)hout + lane;
#pragma unroll
        for (int j = 0; j < 4; ++j) { const f32x4 ww = wn[64 * j]; v2u o; o.x = pk2(x[j].x * r2 * ww.x, x[j].y * r2 * ww.y); o.y = pk2(x[j].z * r2 * ww.z, x[j].w * r2 * ww.w); o8[64 * j] = o; }
    }
}
__device__ __forceinline__ void cast_row_rs(const float* xrow, bf16* orow, float* rs, int lane) {
    const f32x4* xr = (const f32x4*)xrow + lane; f32x4 v[4]; float s = 0.f;
#pragma unroll
    for (int j = 0; j < 4; ++j) { v[j] = xr[64 * j]; s += (v[j].x * v[j].x + v[j].y * v[j].y) + (v[j].z * v[j].z + v[j].w * v[j].w); }
    const float rstd = 1.f / sqrtf(wave_sum(s, lane) * (1.f / 1024.f) + RMS_EPS);
    v2u* o8 = (v2u*)orow + lane;
#pragma unroll
    for (int j = 0; j < 4; ++j) { v2u o; o.x = pk2(v[j].x, v[j].y); o.y = pk2(v[j].z, v[j].w); o8[64 * j] = o; }
    if (lane == 0) *rs = rstd;
}
template <int NR>
__device__ __forceinline__ void cast_rows_rs(const float* xrow0, bf16* orow0, float* rs0, int lane) {
    f32x4 v[NR][4]; float s[NR];
#pragma unroll
    for (int r = 0; r < NR; ++r)
#pragma unroll
        for (int j = 0; j < 4; ++j) v[r][j] = ((const f32x4*)(xrow0 + (size_t)r * DM) + lane)[64 * j];
#pragma unroll
    for (int r = 0; r < NR; ++r) { s[r] = 0.f;
#pragma unroll
        for (int j = 0; j < 4; ++j) s[r] += (v[r][j].x * v[r][j].x + v[r][j].y * v[r][j].y) + (v[r][j].z * v[r][j].z + v[r][j].w * v[r][j].w); }
#pragma unroll
    for (int o = 1; o < 64; o <<= 1) { float t[NR];
#pragma unroll
        for (int r = 0; r < NR; ++r) t[r] = shfl_xor_l(s[r], o, lane);
#pragma unroll
        for (int r = 0; r < NR; ++r) s[r] += t[r]; }
#pragma unroll
    for (int r = 0; r < NR; ++r) { v2u* o8 = (v2u*)(orow0 + (size_t)r * DM) + lane;
#pragma unroll
        for (int j = 0; j < 4; ++j) { v2u o; o.x = pk2(v[r][j].x, v[r][j].y); o.y = pk2(v[r][j].z, v[r][j].w); o8[64 * j] = o; }
        if (lane == 0) rs0[r] = 1.f / sqrtf(s[r] * (1.f / 1024.f) + RMS_EPS); }
}
template <bool XIN_F32, bool XOUT_F32>
__device__ __forceinline__ void resid_row2(const bf16* yrow, const void* xold_, void* xout_, const float* wpost, float* rsout, int lane) {
    const f32x4* wp = (const f32x4*)wpost + lane;
    f32x4 y[2][4], x[2][4]; float s[2] = {0.f, 0.f};
#pragma unroll
    for (int r = 0; r < 2; ++r) { const v2u* yr = (const v2u*)(yrow + r * DM) + lane;
#pragma unroll
        for (int j = 0; j < 4; ++j) { const v2u yw = yr[64 * j]; y[r][j] = (f32x4){bflo(yw.x), bfhi(yw.x), bflo(yw.y), bfhi(yw.y)};
            if constexpr (XIN_F32) x[r][j] = ((const f32x4*)((const float*)xold_ + r * DM) + lane)[64 * j];
            else { const v2u xw = ((const v2u*)((const bf16*)xold_ + r * DM) + lane)[64 * j]; x[r][j] = (f32x4){bflo(xw.x), bfhi(xw.x), bflo(xw.y), bfhi(xw.y)}; } } }
#pragma unroll
    for (int r = 0; r < 2; ++r)
#pragma unroll
        for (int j = 0; j < 4; ++j) s[r] += (y[r][j].x * y[r][j].x + y[r][j].y * y[r][j].y) + (y[r][j].z * y[r][j].z + y[r][j].w * y[r][j].w);
#pragma unroll
    for (int o = 1; o < 64; o <<= 1) { const float a = shfl_xor_l(s[0], o, lane), b = shfl_xor_l(s[1], o, lane); s[0] += a; s[1] += b; }
    float s2[2] = {0.f, 0.f};
#pragma unroll
    for (int r = 0; r < 2; ++r) { const float r1 = 1.f / sqrtf(s[r] * (1.f / 1024.f) + RMS_EPS);
#pragma unroll
        for (int j = 0; j < 4; ++j) { const f32x4 ww = wp[64 * j]; x[r][j] = x[r][j] + y[r][j] * r1 * ww;
            if constexpr (XOUT_F32) ((f32x4*)((float*)xout_ + r * DM) + lane)[64 * j] = x[r][j];
            else { v2u o; o.x = pk2(x[r][j].x, x[r][j].y); o.y = pk2(x[r][j].z, x[r][j].w); ((v2u*)((bf16*)xout_ + r * DM) + lane)[64 * j] = o;
                   x[r][j] = (f32x4){bflo(o.x), bfhi(o.x), bflo(o.y), bfhi(o.y)}; }     s2[r] += (x[r][j].x * x[r][j].x + x[r][j].y * x[r][j].y) + (x[r][j].z * x[r][j].z + x[r][j].w * x[r][j].w); } }
    if (rsout) {
#pragma unroll
        for (int o = 1; o < 64; o <<= 1) { const float a = shfl_xor_l(s2[0], o, lane), b = shfl_xor_l(s2[1], o, lane); s2[0] += a; s2[1] += b; }
        if (lane == 0) { rsout[0] = 1.f / sqrtf(s2[0] * (1.f / 1024.f) + RMS_EPS); rsout[1] = 1.f / sqrtf(s2[1] * (1.f / 1024.f) + RMS_EPS); }
    }
}
__device__ __forceinline__ void mla_prep_row(bf16* p3row, bf16* krrow, const float* qn, const float* kvn, const f32x2_t* rope16, int lane) {
    const v4u raw = *((const v4u*)p3row + lane);
    float x[8] = {bflo(raw.x), bfhi(raw.x), bflo(raw.y), bfhi(raw.y), bflo(raw.z), bfhi(raw.z), bflo(raw.w), bfhi(raw.w)};
    float ss = 0.f;
#pragma unroll
    for (int j = 0; j < 8; ++j) ss += x[j] * x[j];
    const float sq = wave_sum(lane < 32 ? ss : 0.f, lane), skv = wave_sum((lane >= 32 && lane < 48) ? ss : 0.f, lane);
    const float rq = 1.f / sqrtf(sq * (1.f / 256.f) + RMS_EPS), rkv = 1.f / sqrtf(skv * (1.f / 128.f) + RMS_EPS);
    if (lane < 48) {
        const float r = lane < 32 ? rq : rkv; const float* wv = lane < 32 ? qn + 8 * lane : kvn + 8 * (lane - 32);
        const f32x4 w0 = *(const f32x4*)wv, w1 = *(const f32x4*)(wv + 4);
        v4u o; o.x = pk2(x[0] * r * w0.x, x[1] * r * w0.y); o.y = pk2(x[2] * r * w0.z, x[3] * r * w0.w); o.z = pk2(x[4] * r * w1.x, x[5] * r * w1.y); o.w = pk2(x[6] * r * w1.z, x[7] * r * w1.w);
        *((v4u*)p3row + lane) = o;
    }
    float part[8];
#pragma unroll
    for (int j = 0; j < 8; ++j) part[j] = shfl_xor_l(x[j], 2, lane);
    if (lane >= 48 && lane < 52) {
        const bool first = lane < 50; float y[8];
#pragma unroll
        for (int j = 0; j < 8; ++j) { const f32x2_t r_ = rope16[8 * (lane & 1) + j]; const float cs = r_.x, sn = r_.y;
            y[j] = first ? (x[j] * cs - part[j] * sn) : (x[j] * cs + part[j] * sn); }
        v4u o; o.x = pk2(y[0], y[1]); o.y = pk2(y[2], y[3]); o.z = pk2(y[4], y[5]); o.w = pk2(y[6], y[7]);
        *((v4u*)krrow + (lane - 48)) = o;
    }
}
template <int NR>
__device__ __forceinline__ void mla_prep_rows(bf16* p3row0, bf16* krrow0, const float* qn, const float* kvn, const f32x2_t* rope0, int lane) {
    v4u raw[NR]; f32x2_t rc[NR][8];
#pragma unroll
    for (int r = 0; r < NR; ++r) raw[r] = *((const v4u*)(p3row0 + (size_t)r * 512) + lane);
    const bool rl = (lane >= 48 && lane < 52);
    if (rl) {
#pragma unroll
        for (int r = 0; r < NR; ++r)
#pragma unroll
            for (int j = 0; j < 8; ++j) rc[r][j] = rope0[(size_t)r * 16 + 8 * (lane & 1) + j];
    }
    float x[NR][8], sq[NR], skv[NR];
#pragma unroll
    for (int r = 0; r < NR; ++r) { x[r][0] = bflo(raw[r].x); x[r][1] = bfhi(raw[r].x); x[r][2] = bflo(raw[r].y); x[r][3] = bfhi(raw[r].y); x[r][4] = bflo(raw[r].z); x[r][5] = bfhi(raw[r].z); x[r][6] = bflo(raw[r].w); x[r][7] = bfhi(raw[r].w);
        float ss = 0.f;
#pragma unroll
        for (int j = 0; j < 8; ++j) ss += x[r][j] * x[r][j];
        sq[r] = lane < 32 ? ss : 0.f; skv[r] = (lane >= 32 && lane < 48) ? ss : 0.f; }
#pragma unroll
    for (int o = 1; o < 64; o <<= 1) {
        float a[NR], b[NR];
#pragma unroll
        for (int r = 0; r < NR; ++r) { a[r] = shfl_xor_l(sq[r], o, lane); b[r] = shfl_xor_l(skv[r], o, lane); }
#pragma unroll
        for (int r = 0; r < NR; ++r) { sq[r] += a[r]; skv[r] += b[r]; }
    }
    const float* wv = lane < 32 ? qn + 8 * lane : kvn + 8 * ((lane - 32) & 15);
    const f32x4 w0 = *(const f32x4*)wv, w1 = *(const f32x4*)(wv + 4);
#pragma unroll
    for (int r = 0; r < NR; ++r) {
        const float rq = 1.f / sqrtf(sq[r] * (1.f / 256.f) + RMS_EPS), rkv = 1.f / sqrtf(skv[r] * (1.f / 128.f) + RMS_EPS);
        float part[8];
#pragma unroll
        for (int j = 0; j < 8; ++j) part[j] = shfl_xor_l(x[r][j], 2, lane);
        if (lane < 48) {
            const float rr = lane < 32 ? rq : rkv;
            v4u o; o.x = pk2(x[r][0] * rr * w0.x, x[r][1] * rr * w0.y); o.y = pk2(x[r][2] * rr * w0.z, x[r][3] * rr * w0.w); o.z = pk2(x[r][4] * rr * w1.x, x[r][5] * rr * w1.y); o.w = pk2(x[r][6] * rr * w1.z, x[r][7] * rr * w1.w);
            *((v4u*)(p3row0 + (size_t)r * 512) + lane) = o;
        }
        if (rl) {
            const bool first = lane < 50; float y[8];
#pragma unroll
            for (int j = 0; j < 8; ++j) { const float cs = rc[r][j].x, sn = rc[r][j].y; y[j] = first ? (x[r][j] * cs - part[j] * sn) : (x[r][j] * cs + part[j] * sn); }
            v4u o; o.x = pk2(y[0], y[1]); o.y = pk2(y[2], y[3]); o.z = pk2(y[4], y[5]); o.w = pk2(y[6], y[7]);
            *((v4u*)(krrow0 + (size_t)r * 32) + (lane - 48)) = o;
        }
    }
}
__device__ __forceinline__ void kmean_task(const bf16* MK, float* kmean, int b, int n, int half, LAS float* scr, int tid) {
    const int wave = tid >> 6, lane = tid & 63, hw = lane >> 5, cl = lane & 31, strm = wave * 2 + hw;
    float acc[8] = {0.f, 0.f, 0.f, 0.f, 0.f, 0.f, 0.f, 0.f};
    const bf16* base = MK + ((size_t)b * SEQ + (size_t)n * 256 + strm * 16) * 512 + half * 256 + cl * 8;
#pragma unroll
    for (int r = 0; r < 16; ++r) { const v4u w = *(const v4u*)(base + (size_t)r * 512);
        acc[0] += bflo(w.x); acc[1] += bfhi(w.x); acc[2] += bflo(w.y); acc[3] += bfhi(w.y); acc[4] += bflo(w.z); acc[5] += bfhi(w.z); acc[6] += bflo(w.w); acc[7] += bfhi(w.w); }
#pragma unroll
    for (int j = 0; j < 8; ++j) scr[strm * 256 + cl * 8 + j] = acc[j];
    __syncthreads();
    if (tid < 256) { float s = 0.f;
#pragma unroll
        for (int w = 0; w < 16; ++w) s += scr[w * 256 + tid];
        const int col = half * 256 + tid, h = col >> 7, d = col & 127;
        kmean[(((size_t)b * 4 + h) * 32 + n) * 128 + d] = s * (1.f / 256.f); }
    __syncthreads();
}
__device__ __forceinline__ void diff_combine_row(const bf16* o12row, bf16* oarow, const float* subln, float lam, float oscale, int lane) {
    const int h = lane >> 4, dc = lane & 15;
    const v4u a = *(const v4u*)(o12row + h * 256 + dc * 8), b = *(const v4u*)(o12row + h * 256 + 128 + dc * 8);
    float d[8] = {bflo(a.x) - lam * bflo(b.x), bfhi(a.x) - lam * bfhi(b.x), bflo(a.y) - lam * bflo(b.y), bfhi(a.y) - lam * bfhi(b.y),
                  bflo(a.z) - lam * bflo(b.z), bfhi(a.z) - lam * bfhi(b.z), bflo(a.w) - lam * bflo(b.w), bfhi(a.w) - lam * bfhi(b.w)};
    float ss = 0.f;
#pragma unroll
    for (int j = 0; j < 8; ++j) ss += d[j] * d[j];
#pragma unroll
    for (int o = 1; o < 16; o <<= 1) ss += shfl_xor_l(ss, o, lane);
    const float r = oscale / sqrtf(ss * (1.f / 128.f) + RMS_EPS);
    const f32x4 w0 = *(const f32x4*)(subln + dc * 8), w1 = *(const f32x4*)(subln + dc * 8 + 4);
    v4u o; o.x = pk2(d[0] * r * w0.x, d[1] * r * w0.y); o.y = pk2(d[2] * r * w0.z, d[3] * r * w0.w); o.z = pk2(d[4] * r * w1.x, d[5] * r * w1.y); o.w = pk2(d[6] * r * w1.z, d[7] * r * w1.w);
    *(v4u*)(oarow + h * 128 + dc * 8) = o;
}

__device__ __forceinline__ int crow(int r, int hi) { return (r & 3) + 8 * (r >> 2) + 4 * hi; }
__device__ __forceinline__ int t5_bucket(int n) {
    if (n < 16) return n;
    return 16 + (n >= 21) + (n >= 27) + (n >= 35) + (n >= 46) + (n >= 59) + (n >= 77) + (n >= 99) + (n >= 128) + (n >= 166) + (n >= 216) + (n >= 280) + (n >= 363) + (n >= 470) + (n >= 609) + (n >= 790);
}
constexpr float LOG2E = 1.4426950408889634f;
constexpr float NEGBIG = -3.0e38f, M_INIT = -1.0e30f;
enum { MODE_MLA = 0, MODE_DIFF = 1, MODE_MOBA = 2 };
struct AttnArgs {
    const bf16* q; int ldq;
    const bf16* k; int ldk;
    const bf16* k2;
    const bf16* v; int ldv;
    bf16* o; int ldo;
    int qb;
    float C;
    const float* bias;
    const f32x2_t* rope;
    const float* kmean;
};
template <int MODE> struct AttnCfg {
    static constexpr int DQK = MODE == MODE_MLA ? 96 : (MODE == MODE_DIFF ? 64 : 128);
    static constexpr int DV = MODE == MODE_MLA ? 64 : 128;
    static constexpr int PK = DQK * 2 + 16, PV = DV * 2 + 64;
    static constexpr int KB = 64 * PK, VB = 64 * PV;
    static constexpr int KCH = DQK / 8, VCH = DV / 8;
    static constexpr int NKC = 64 * KCH, NVC = 64 * VCH;
    static constexpr int KPT = (NKC + 511) / 512, VPT = (NVC + 511) / 512;
    static constexpr int NS = DQK / 16, ND = DV / 32;
};

template <int MODE>
__device__ __forceinline__ void attn_unit(LAS unsigned char* lds, const AttnArgs& a, int wave_s) {
    using C_ = AttnCfg<MODE>;
    constexpr int PK = C_::PK, PV = C_::PV, KB = C_::KB, VB = C_::VB, KCH = C_::KCH, VCH = C_::VCH, NKC = C_::NKC, KPT = C_::KPT, VPT = C_::VPT, NS = C_::NS, ND = C_::ND;
    constexpr float THR = 10.f;
    const int tid = opaque_tid(wave_s), wid = __builtin_amdgcn_readfirstlane(tid >> 6), lane = tid & 63, r32 = lane & 31, hi = lane >> 5;
    const int q0w = a.qb * 256 + wid * 32, qrow = q0w + r32;
    const int NT = 4 * (a.qb + 1);
    LAS float* tab = (LAS float*)(lds + A_TAB);
    LAS float* wscr = (LAS float*)(lds + A_WSCR + wid * 256);
    LAS unsigned* slot = (LAS unsigned*)(lds + A_SLOT);
    bf16x8 qr[NS];
#pragma unroll
    for (int s = 0; s < NS; ++s) qr[s] = *(const bf16x8*)(a.q + (size_t)qrow * a.ldq + 16 * s + 8 * hi);
    if constexpr (MODE == MODE_MLA) {
        const f32x2_t* rp_ = a.rope + (size_t)qrow * 16 + 8 * hi;
#pragma unroll
        for (int j = 0; j < 8; ++j) { const f32x2_t r_ = rp_[j]; const float cs = r_.x, sn = r_.y; const float x1 = bf2f(qr[4][j]), x2 = bf2f(qr[5][j]);
            qr[4][j] = (short)f2bf((x1 * cs - x2 * sn) * a.C); qr[5][j] = (short)f2bf((x2 * cs + x1 * sn) * a.C); }
#pragma unroll
        for (int s = 0; s < 4; ++s)
#pragma unroll
            for (int j = 0; j < 8; ++j) qr[s][j] = (short)f2bf(bf2f(qr[s][j]) * a.C);
    } else {
#pragma unroll
        for (int s = 0; s < NS; ++s)
#pragma unroll
            for (int j = 0; j < 8; ++j) qr[s][j] = (short)f2bf(bf2f(qr[s][j]) * a.C);
    }
    if constexpr (MODE != MODE_MLA) {
        for (int i = tid; i < 1024; i += 512) tab[i] = a.bias[t5_bucket(i) * 8] * LOG2E;
    }
    unsigned mask = 0xffffffffu, umask = 0xffffffffu, wmask = 0xffffffffu;
    if constexpr (MODE == MODE_MOBA) {
        LAS float* km = (LAS float*)(lds + A_KMEAN);
        { const f32x4* src = (const f32x4*)a.kmean + tid * 2; *((LAS f32x4*)km + tid * 2) = src[0]; *((LAS f32x4*)km + tid * 2 + 1) = src[1]; }
        if (tid < 9) slot[8 + tid] = 0u;
        __syncthreads();
        const int own = a.qb;
        float v0 = NEGBIG, v1 = NEGBIG, v2 = NEGBIG; int i0 = 32, i1 = 32, i2 = 32;
        for (int n = 0; n < own; ++n) {
            float g = 0.f;
#pragma unroll
            for (int s = 0; s < NS; ++s) { const f32x4 ka = *(const LAS f32x4*)(km + n * 128 + 16 * s + 8 * hi), kb = *(const LAS f32x4*)(km + n * 128 + 16 * s + 8 * hi + 4);
                g += bf2f(qr[s][0]) * ka.x + bf2f(qr[s][1]) * ka.y + bf2f(qr[s][2]) * ka.z + bf2f(qr[s][3]) * ka.w + bf2f(qr[s][4]) * kb.x + bf2f(qr[s][5]) * kb.y + bf2f(qr[s][6]) * kb.z + bf2f(qr[s][7]) * kb.w; }
            { auto rr = __builtin_amdgcn_permlane32_swap(__float_as_uint(g), __float_as_uint(g), false, false); g = __uint_as_float(rr[0]) + __uint_as_float(rr[1]); }
            if (g > v0) { v2 = v1; i2 = i1; v1 = v0; i1 = i0; v0 = g; i0 = n; }
            else if (g > v1) { v2 = v1; i2 = i1; v1 = g; i1 = n; }
            else if (g > v2) { v2 = g; i2 = n; }
        }
        mask = (1u << own) | (i0 < 32 ? (1u << i0) : 0u) | (i1 < 32 ? (1u << i1) : 0u) | (i2 < 32 ? (1u << i2) : 0u);
        __hip_atomic_fetch_or(slot + 8 + wid, mask, __ATOMIC_RELAXED, __HIP_MEMORY_SCOPE_WORKGROUP);
        __hip_atomic_fetch_or(slot + 16, mask, __ATOMIC_RELAXED, __HIP_MEMORY_SCOPE_WORKGROUP);
        __syncthreads();
        umask = slot[16]; wmask = slot[8 + wid];
        umask = __builtin_amdgcn_readfirstlane(umask); wmask = __builtin_amdgcn_readfirstlane(wmask);
    }
    bf16x8 kst[KPT], vst[VPT];
    unsigned kofs[KPT], vofs[VPT]; [[maybe_unused]] unsigned kstr[KPT];
#pragma unroll
    for (int i = 0; i < KPT; ++i) { const int id = tid + 512 * i; const int row = id / KCH, ch = id % KCH;
        if (MODE == MODE_MLA && ch >= 8) { kofs[i] = (unsigned)((const char*)a.k2 - (const char*)a.k) + row * 64 + (ch - 8) * 16; kstr[i] = 64 * 64; }
        else { kofs[i] = (unsigned)(row * a.ldk * 2 + ch * 16); kstr[i] = (unsigned)(64 * a.ldk * 2); } }
#pragma unroll
    for (int i = 0; i < VPT; ++i) { const int id = tid + 512 * i; const int row = id / VCH, ch = id % VCH; vofs[i] = (unsigned)(row * a.ldv * 2 + ch * 16); }
    auto load_k = [&](int j) {
#pragma unroll
        for (int i = 0; i < KPT; ++i) { const int id = tid + 512 * i;
            if ((NKC % 512 == 0) || id < NKC) {
                if constexpr (MODE == MODE_MLA) kst[i] = *(const bf16x8*)((const char*)a.k + (kofs[i] + __umul24((unsigned)j, kstr[i])));
                else kst[i] = *(const bf16x8*)((const char*)a.k + (size_t)j * (size_t)(64 * a.ldk * 2) + kofs[i]); } }
    };
    auto load_v = [&](int j) {
#pragma unroll
        for (int i = 0; i < VPT; ++i) vst[i] = *(const bf16x8*)((const char*)a.v + (size_t)j * (size_t)(64 * a.ldv * 2) + vofs[i]);
    };
    auto write_k = [&](int kb_) {
#pragma unroll
        for (int i = 0; i < KPT; ++i) { const int id = tid + 512 * i;
            if ((NKC % 512 == 0) || id < NKC) { const int row = id / KCH, ch = id % KCH; *(LAS bf16x8*)(lds + A_KOFF + kb_ * KB + row * PK + ch * 16) = kst[i]; } }
    };
    auto write_v = [&](int vb_) {
#pragma unroll
        for (int i = 0; i < VPT; ++i) { const int id = tid + 512 * i; const int row = id / VCH, ch = id % VCH; *(LAS bf16x8*)(lds + A_VOFF + vb_ * VB + row * PV + ch * 16) = vst[i]; }
    };
    auto next_tile = [&](int j) -> int {
        int jn = j + 1;
        if constexpr (MODE == MODE_MOBA) { while (jn < NT && !((umask >> (jn >> 2)) & 1u)) jn = (jn & ~3) + 4; }
        return jn;
    };
    auto need_tile = [&](int j) -> bool {
        bool need = (64 * j <= q0w + 31);
        if constexpr (MODE == MODE_MOBA) need = need && ((wmask >> (j >> 2)) & 1u);
        return need;
    };
    f32x16 o[ND];
#pragma unroll
    for (int d = 0; d < ND; ++d) o[d] = (f32x16){};
    float m_run = M_INIT, l_run = 0.f;
    const int kbase = r32 * PK + 16 * hi;
    int vbase = (8 * hi + ((lane >> 2) & 3)) * PV + (16 * ((lane >> 4) & 1) + 4 * (lane & 3)) * 2;
    auto partialSM = [&](f32x16& p0, f32x16& p1, int j, float& off, float& al) {
        const int k0 = 64 * j, relq = qrow - k0, relmin = q0w - k0 - 63;
        const bool fast = (MODE == MODE_MLA) ? (relmin >= 0) : (relmin >= 790);
        float cb = 0.f;
        if (fast) { if constexpr (MODE != MODE_MLA) cb = tab[1023]; }
        else if ((MODE != MODE_MLA) && relmin >= 0) {
            const LAS float* tb = tab + (relq - 4 * hi - 59);
#pragma unroll
            for (int r = 0; r < 16; ++r) { const int c_ = (r & 3) + 8 * (r >> 2); p0[r] += tb[59 - c_]; p1[r] += tb[27 - c_]; }
        } else {
#pragma unroll
            for (int r = 0; r < 16; ++r) { const int rel0 = relq - crow(r, hi), rel1 = rel0 - 32;
                float t0 = p0[r], t1 = p1[r];
                if constexpr (MODE != MODE_MLA) { t0 += tab[min(max(rel0, 0), 1023)]; t1 += tab[min(max(rel1, 0), 1023)]; }
                p0[r] = rel0 < 0 ? NEGBIG : t0; p1[r] = rel1 < 0 ? NEGBIG : t1;
                if ((r & 3) == 3) __builtin_amdgcn_sched_barrier(0); }
        }
        if constexpr (MODE == MODE_MOBA) {
            const bool allowed = (mask >> (j >> 2)) & 1u;
#pragma unroll
            for (int r = 0; r < 16; ++r) { p0[r] = allowed ? p0[r] : NEGBIG; p1[r] = allowed ? p1[r] : NEGBIG; }
        }
        float pm = fmaxf(p0[0], p1[0]);
#pragma unroll
        for (int r = 1; r < 16; ++r) pm = fmaxf(fmaxf(pm, p0[r]), p1[r]);
        { auto rr = __builtin_amdgcn_permlane32_swap(__float_as_uint(pm), __float_as_uint(pm), false, false); pm = fmaxf(__uint_as_float(rr[0]), __uint_as_float(rr[1])); }
        pm += cb;
        if (__all(pm - m_run <= THR)) al = 1.f;
        else { const float mn = fmaxf(m_run, pm); al = __builtin_amdgcn_exp2f(m_run - mn); m_run = mn; }
        off = cb - m_run;
#pragma unroll
        for (int r = 0; r < 16; ++r) p0[r] = __builtin_amdgcn_exp2f(p0[r] + off);
    };
    auto lane_now = [&]() -> int { int ln; asm volatile("v_mbcnt_lo_u32_b32 %0, -1, 0\n\tv_mbcnt_hi_u32_b32 %0, -1, %0" : "=v"(ln)); return ln; };
    constexpr bool LSUM = (MODE != MODE_MOBA);
    f32x16 ol = (f32x16){};
    auto rescale = [&](float al) {
        if (!__all(al == 1.f)) {
            const int ln = lane_now();
            LAS float* ws_ = (LAS float*)(lds + A_WSCR + wid * 256);
            if (ln < 32) ws_[ln] = al;
            LDS_WAIT();
#pragma unroll
            for (int g = 0; g < 4; ++g) { const f32x4 a4 = *(const LAS f32x4*)(ws_ + 8 * g + 4 * (ln >> 5));
#pragma unroll
                for (int d = 0; d < ND; ++d) { o[d][4 * g + 0] *= a4.x; o[d][4 * g + 1] *= a4.y; o[d][4 * g + 2] *= a4.z; o[d][4 * g + 3] *= a4.w; }
                if constexpr (LSUM) { ol[4 * g + 0] *= a4.x; ol[4 * g + 1] *= a4.y; ol[4 * g + 2] *= a4.z; ol[4 * g + 3] *= a4.w; } }
        }
    };
    auto finishSM = [&](f32x16& p0, f32x16& p1, float off, float al, bf16x8 (&pa)[4]) {
        if constexpr (LSUM) {
#pragma unroll
            for (int r = 0; r < 16; ++r) p1[r] = __builtin_amdgcn_exp2f(p1[r] + off);
        } else {
        float ps = 0.f;
#pragma unroll
        for (int r = 0; r < 16; ++r) { p1[r] = __builtin_amdgcn_exp2f(p1[r] + off); ps += p0[r] + p1[r]; }
        { auto rr = __builtin_amdgcn_permlane32_swap(__float_as_uint(ps), __float_as_uint(ps), false, false); ps = __uint_as_float(rr[0]) + __uint_as_float(rr[1]); }
        l_run = l_run * al + ps; }
#define PK4(P, BASE, OUT) do { const unsigned a0_ = cvtpk_s(P[BASE + 0], P[BASE + 1]), a1_ = cvtpk_s(P[BASE + 2], P[BASE + 3]);   \
    const unsigned b0_ = cvtpk_s(P[BASE + 4], P[BASE + 5]), b1_ = cvtpk_s(P[BASE + 6], P[BASE + 7]);                              \
    auto r0_ = __builtin_amdgcn_permlane32_swap(a0_, b0_, false, false); auto r1_ = __builtin_amdgcn_permlane32_swap(a1_, b1_, false, false); \
    v4u w_ = {r0_[0], r1_[0], r0_[1], r1_[1]}; OUT = __builtin_bit_cast(bf16x8, w_); } while (0)
        PK4(p0, 0, pa[0]); PK4(p0, 8, pa[1]); PK4(p1, 0, pa[2]); PK4(p1, 8, pa[3]);
#undef PK4
    };
    constexpr int NQ = NS / 2, NG = NQ + ND;
    f32x16 p0, p1; bf16x8 pa[4];
    auto load_grp = [&](int g, bf16x8 (&f)[4], int kb_, int vb_) {
        if (g >= ND) { const LAS unsigned char* Ks = lds + A_KOFF + kb_ * KB + kbase + 64 * (g - ND);
            f[0] = *(const LAS bf16x8*)(Ks); f[1] = *(const LAS bf16x8*)(Ks + 32 * PK); f[2] = *(const LAS bf16x8*)(Ks + 32); f[3] = *(const LAS bf16x8*)(Ks + 32 * PK + 32); }
        else { const LAS unsigned char* Vs = lds + A_VOFF + vb_ * VB + vbase + g * 64;
#pragma unroll
            for (int ks = 0; ks < 4; ++ks) {
                const s16x4 lo = __builtin_bit_cast(s16x4, __builtin_amdgcn_ds_read_tr16_b64_v4i16((LAS v4i16_t*)(Vs + ks * 16 * PV)));
                const s16x4 h4 = __builtin_bit_cast(s16x4, __builtin_amdgcn_ds_read_tr16_b64_v4i16((LAS v4i16_t*)(Vs + ks * 16 * PV + 4 * PV)));
                f[ks] = (bf16x8){lo[0], lo[1], lo[2], lo[3], h4[0], h4[1], h4[2], h4[3]}; } }
    };
    auto mfma_grp = [&](int g, const bf16x8 (&f)[4]) {
        if (g >= ND) { const int q_ = g - ND;
            if (q_ == 0) { p0 = __builtin_amdgcn_mfma_f32_32x32x16_bf16(f[0], qr[0], (f32x16){}, 0, 0, 0); p1 = __builtin_amdgcn_mfma_f32_32x32x16_bf16(f[1], qr[0], (f32x16){}, 0, 0, 0); }
            else { p0 = __builtin_amdgcn_mfma_f32_32x32x16_bf16(f[0], qr[2 * q_], p0, 0, 0, 0); p1 = __builtin_amdgcn_mfma_f32_32x32x16_bf16(f[1], qr[2 * q_], p1, 0, 0, 0); }
            p0 = __builtin_amdgcn_mfma_f32_32x32x16_bf16(f[2], qr[2 * q_ + 1], p0, 0, 0, 0); p1 = __builtin_amdgcn_mfma_f32_32x32x16_bf16(f[3], qr[2 * q_ + 1], p1, 0, 0, 0);
        } else {
#pragma unroll
            for (int ks = 0; ks < 4; ++ks) o[g] = __builtin_amdgcn_mfma_f32_32x32x16_bf16(pa[ks], f[ks], o[g], 0, 0, 0);
            if constexpr (LSUM) { if (g == ND - 1) { const bf16x8 ones = {(short)0x3f80, (short)0x3f80, (short)0x3f80, (short)0x3f80, (short)0x3f80, (short)0x3f80, (short)0x3f80, (short)0x3f80};
#pragma unroll
                for (int ks = 0; ks < 4; ++ks) ol = __builtin_amdgcn_mfma_f32_32x32x16_bf16(pa[ks], ones, ol, 0, 0, 0); } }
        }
    };
    auto half_grp = [&](int g, int h_, int kb_, int vb_) {
        if (g >= ND) { const int s_ = 2 * (g - ND) + h_; const LAS unsigned char* Ks = lds + A_KOFF + kb_ * KB + kbase + 32 * s_;
            const bf16x8 b0 = *(const LAS bf16x8*)(Ks), b1 = *(const LAS bf16x8*)(Ks + 32 * PK);
            if (s_ == 0) { p0 = __builtin_amdgcn_mfma_f32_32x32x16_bf16(b0, qr[0], (f32x16){}, 0, 0, 0); p1 = __builtin_amdgcn_mfma_f32_32x32x16_bf16(b1, qr[0], (f32x16){}, 0, 0, 0); }
            else { p0 = __builtin_amdgcn_mfma_f32_32x32x16_bf16(b0, qr[s_], p0, 0, 0, 0); p1 = __builtin_amdgcn_mfma_f32_32x32x16_bf16(b1, qr[s_], p1, 0, 0, 0); } }
        else { const LAS unsigned char* Vs = lds + A_VOFF + vb_ * VB + vbase + g * 64;
#pragma unroll
            for (int k2 = 0; k2 < 2; ++k2) { const int ks = 2 * h_ + k2;
                const s16x4 lo = __builtin_bit_cast(s16x4, __builtin_amdgcn_ds_read_tr16_b64_v4i16((LAS v4i16_t*)(Vs + ks * 16 * PV)));
                const s16x4 h4 = __builtin_bit_cast(s16x4, __builtin_amdgcn_ds_read_tr16_b64_v4i16((LAS v4i16_t*)(Vs + ks * 16 * PV + 4 * PV)));
                const bf16x8 vb = {lo[0], lo[1], lo[2], lo[3], h4[0], h4[1], h4[2], h4[3]};
                o[g] = __builtin_amdgcn_mfma_f32_32x32x16_bf16(pa[ks], vb, o[g], 0, 0, 0); } }
    };
    auto load_half = [&](int g, int h_, bf16x8 (&f)[2], int kb_, int vb_) {
        if (g >= ND) { const int s_ = 2 * (g - ND) + h_; const LAS unsigned char* Ks = lds + A_KOFF + kb_ * KB + kbase + 32 * s_;
            f[0] = *(const LAS bf16x8*)(Ks); f[1] = *(const LAS bf16x8*)(Ks + 32 * PK); }
        else { const LAS unsigned char* Vs = lds + A_VOFF + vb_ * VB + vbase + g * 64;
#pragma unroll
            for (int k2 = 0; k2 < 2; ++k2) { const int ks = 2 * h_ + k2;
                const s16x4 lo = __builtin_bit_cast(s16x4, __builtin_amdgcn_ds_read_tr16_b64_v4i16((LAS v4i16_t*)(Vs + ks * 16 * PV)));
                const s16x4 h4 = __builtin_bit_cast(s16x4, __builtin_amdgcn_ds_read_tr16_b64_v4i16((LAS v4i16_t*)(Vs + ks * 16 * PV + 4 * PV)));
                f[k2] = (bf16x8){lo[0], lo[1], lo[2], lo[3], h4[0], h4[1], h4[2], h4[3]}; } }
    };
    auto mfma_half = [&](int g, int h_, const bf16x8 (&f)[2]) {
        if (g >= ND) { const int s_ = 2 * (g - ND) + h_;
            if (s_ == 0) { p0 = __builtin_amdgcn_mfma_f32_32x32x16_bf16(f[0], qr[0], (f32x16){}, 0, 0, 0); p1 = __builtin_amdgcn_mfma_f32_32x32x16_bf16(f[1], qr[0], (f32x16){}, 0, 0, 0); }
            else { p0 = __builtin_amdgcn_mfma_f32_32x32x16_bf16(f[0], qr[s_], p0, 0, 0, 0); p1 = __builtin_amdgcn_mfma_f32_32x32x16_bf16(f[1], qr[s_], p1, 0, 0, 0); } }
        else {
#pragma unroll
            for (int k2 = 0; k2 < 2; ++k2) o[g] = __builtin_amdgcn_mfma_f32_32x32x16_bf16(pa[2 * h_ + k2], f[k2], o[g], 0, 0, 0); }
    };
    bf16x8 hA[2], hB[2];
    bf16x8 fA[4], fB[4];
    constexpr bool PIPE = (MODE != MODE_MOBA);
#define HOOK_NONE(I) do { } while (0)
#define RUN_GROUPS(GS, GE, KBUF, VBUF) RUN_GROUPS_H(GS, GE, KBUF, VBUF, HOOK_NONE)
#define RUN_GROUPS_H(GS, GE, KBUF, VBUF, HOOK) do { \
        if constexpr (PIPE) { \
        load_grp(GS, fA, KBUF, VBUF); __builtin_amdgcn_sched_barrier(0); \
        _Pragma("unroll") for (int g_ = (GS); g_ < (GE); ++g_) { \
            if (g_ + 1 < (GE)) { if ((g_ - (GS)) & 1) load_grp(g_ + 1, fA, KBUF, VBUF); else load_grp(g_ + 1, fB, KBUF, VBUF); } \
            __builtin_amdgcn_sched_barrier(0); \
            if ((g_ - (GS)) & 1) mfma_grp(g_, fB); else mfma_grp(g_, fA); \
            __builtin_amdgcn_sched_barrier(0); \
            HOOK(g_ - (GS)); __builtin_amdgcn_sched_barrier(0); } \
        } else { \
        load_half(GS, 0, hA, KBUF, VBUF); __builtin_amdgcn_sched_barrier(0); \
        _Pragma("unroll") for (int g_ = (GS); g_ < (GE); ++g_) { \
            load_half(g_, 1, hB, KBUF, VBUF); __builtin_amdgcn_sched_barrier(0); mfma_half(g_, 0, hA); __builtin_amdgcn_sched_barrier(0); \
            if (g_ + 1 < (GE)) load_half(g_ + 1, 0, hA, KBUF, VBUF); __builtin_amdgcn_sched_barrier(0); mfma_half(g_, 1, hB); __builtin_amdgcn_sched_barrier(0); \
            HOOK(g_ - (GS)); __builtin_amdgcn_sched_barrier(0); } \
        } } while (0)
#define ABAR() do { asm volatile("s_waitcnt lgkmcnt(0)" ::: "memory"); __builtin_amdgcn_s_barrier(); } while (0)
    const int half = 1 - (wid >> 2);
    float off = 0.f, al = 1.f;
    int j = next_tile(-1), it = 0;
    int jn = next_tile(j), jnn = jn < NT ? next_tile(jn) : NT;
    constexpr bool EARLY = (MODE != MODE_MOBA);
    load_k(j); write_k(0);
    if constexpr (EARLY) { load_v(j); if (jn < NT) load_k(jn); }
    ABAR();
#define STAGE_IN()  do { if constexpr (EARLY) { write_v(it & 1); if (jn < NT) write_k((it & 1) ^ 1); if (jn < NT) { load_v(jn); if (jnn < NT) load_k(jnn); } } else { load_v(j); if (jn < NT) load_k(jn); } } while (0)
#define STAGE_IN_W()  do { if constexpr (EARLY) { write_v(it & 1); if (jn < NT) write_k((it & 1) ^ 1); } else { load_v(j); if (jn < NT) load_k(jn); } } while (0)
#define STAGE_LOADS() do { if constexpr (EARLY) { if (jn < NT) { load_v(jn); if (jnn < NT) load_k(jnn); } } } while (0)
#define STAGE_HOOK(I) do { if constexpr (!EARLY) { if ((I) == 0) { load_v(j); if (jn < NT) load_k(jn); } } else { if ((I) == 0) { write_v(it & 1); if (jn < NT) write_k((it & 1) ^ 1); } if ((I) == 1) { if (jn < NT) { load_v(jn); if (jnn < NT) load_k(jnn); } } } } while (0)
#define STAGE_IN_L() do { } while (0)
#define STAGE_OUT() do { if constexpr (EARLY) { } else { write_v(it & 1); if (jn < NT) write_k((it & 1) ^ 1); } } while (0)
#define SOFTMAX()   do { partialSM(p0, p1, j, off, al); rescale(al); finishSM(p0, p1, off, al, pa); } while (0)
    if (half == 0) {
        STAGE_IN_W(); RUN_GROUPS(ND, NG, 0, 0); STAGE_OUT(); SOFTMAX(); STAGE_LOADS(); ABAR();
        while (jn < NT) {
            j = jn; jn = jnn; jnn = jn < NT ? next_tile(jn) : NT; ++it;
            STAGE_IN_L(); RUN_GROUPS_H(0, NG, it & 1, (it & 1) ^ 1, STAGE_HOOK); STAGE_OUT();
            SOFTMAX(); ABAR();
        }
    } else {
        STAGE_IN(); RUN_GROUPS(ND, NG, 0, 0); STAGE_OUT(); ABAR();
        while (jn < NT) {
            SOFTMAX();
            j = jn; jn = jnn; jnn = jn < NT ? next_tile(jn) : NT; ++it;
            STAGE_IN_L(); RUN_GROUPS_H(0, NG, it & 1, (it & 1) ^ 1, STAGE_HOOK); STAGE_OUT();
            ABAR();
        }
        SOFTMAX();
    }
    { const int l2 = lane_now(); vbase = (8 * (l2 >> 5) + ((l2 >> 2) & 3)) * PV + (16 * ((l2 >> 4) & 1) + 4 * (l2 & 3)) * 2; RUN_GROUPS(0, ND, 0, it & 1); }
#undef STAGE_IN
#undef STAGE_OUT
#undef STAGE_IN_W
#undef STAGE_LOADS
#undef STAGE_HOOK
#undef STAGE_IN_L
#undef RUN_GROUPS_H
#undef HOOK_NONE
#undef SOFTMAX
#undef ABAR
#undef RUN_GROUPS
    {
        const int l3 = lane_now(), c = l3 & 31, h3 = l3 >> 5;
        LAS float* ws_ = (LAS float*)(lds + A_WSCR + wid * 256);
        if (h3 == 0) ws_[32 + c] = l_run;
        LDS_WAIT();
#pragma unroll
        for (int g = 0; g < 4; ++g) { const f32x4 l4 = *(const LAS f32x4*)(ws_ + 32 + 8 * g + 4 * h3);
#pragma unroll
            for (int i = 0; i < 4; ++i) { const float rl = 1.f / (LSUM ? ol[4 * g + i] : l4[i]); const int row = a.qb * 256 + wid * 32 + 8 * g + 4 * h3 + i; bf16* orow = a.o + (size_t)row * a.ldo + c;
#pragma unroll
                for (int d = 0; d < ND; ++d) orow[32 * d] = (bf16)f2bf(o[d][4 * g + i] * rl); } }
    }
}
__device__ __forceinline__ int pop_unit(gu32* head, LAS unsigned* slot, int wave_s) {
    if (opaque_tid(wave_s) == 0) slot[0] = __hip_atomic_fetch_add(head, 1u, RLX_AGENT);
    __syncthreads();
    const int u = (int)slot[0];
    __syncthreads();
    return __builtin_amdgcn_readfirstlane(u);
}

__device__ __forceinline__ int next_unit_idx(int k_, int N, int G, int bx, gu32* head, LAS unsigned* slot, int wave_s) {
    if (G == 256 && 256 * (k_ + 1) < N) { __syncthreads(); const int base = 256 * k_; return (k_ & 1) ? base + 255 - bx : base + bx; }
    const int u = pop_unit(head, slot, wave_s);
    return G == 256 ? (N - 256) + u : u;
}

struct Args { const void* in[18]; float* out; unsigned char* ws; int ph_lo, ph_hi; };
typedef const __attribute__((address_space(4))) Args* KArgs;
__device__ __forceinline__ KArgs kargs() { KArgs p = (KArgs)__builtin_amdgcn_kernarg_segment_ptr(); asm volatile("" : "+s"(p)); return p; }
#define INP(k, type) ((const type*)A->in[k])
#define WSP(off, type) ((type*)(A->ws + (off)))
#define PHASE_VARS KArgs A = kargs(); const int tid = opaque_tid(wave0), lane = tid & 63, wave = __builtin_amdgcn_readfirstlane(tid >> 6); const int G = opaque_s(gridDim.x), bx = opaque_s(blockIdx.x); const int gw = bx * NWAVES + wave, NGW = G * NWAVES; (void)tid; (void)lane; (void)G; (void)bx; (void)gw; (void)NGW
__global__ void __launch_bounds__(NWAVES * 64, 2) trunk_fwd(Args args) {
    extern __shared__ __attribute__((aligned(16))) unsigned char lds_raw[];
    LAS unsigned char* lds = (LAS unsigned char*)lds_raw;
    volatile LAS unsigned* MISC = (volatile LAS unsigned*)(lds + MISC_OFF);
    int wave0 = __builtin_amdgcn_readfirstlane((int)threadIdx.x >> 6); asm volatile("" : "+s"(wave0));
    for (int u = threadIdx.x; u < (LDS_BYTES - RING_BYTES) / 4; u += NWAVES * 64) ((LAS unsigned*)(lds + RING_BYTES))[u] = 0u;
    __syncthreads();
    KArgs A0 = kargs();
    (void)xcd_barrier_post((unsigned*)((gu32*)(A0->ws + WS_CTL) + CW_BAR), MISC + 8);
#define GRID_BAR() do { KArgs Ab_ = kargs(); XcdBarrier b_; b_.bar = (unsigned*)((gu32*)(Ab_->ws + WS_CTL) + CW_BAR); b_.x = xb_xcc_id(); b_.st = (volatile LAS unsigned*)(lds + MISC_OFF) + 8; xcd_barrier(b_, opaque_tid(wave0)); } while (0)
#define PH_IN(p) ((p) >= kargs()->ph_lo && (p) < kargs()->ph_hi)
#define SEAM(p) do { if (PH_IN(p) && PH_IN((p) + 1)) GRID_BAR(); } while (0)
    if (PH_IN(0)) {
        PHASE_VARS;
        LAS float* scrw = (LAS float*)(lds + RING_OFF + wave * 16384);
        LayerW L{INP(7, float), INP(11, float), INP(13, float), INP(14, float), INP(15, float), INP(16, float), INP(17, float), INP(3, float), INP(5, float)};
        convert_weights(L, A->ws, scrw, gw, NGW, lane);
        const float* x_in = INP(0, float); bf16* xb = (bf16*)A->out; float* RS = WSP(WS_RS, float);
        for (int m = 4 * gw; m < T; m += 4 * NGW) cast_rows_rs<4>(x_in + (size_t)m * DM, xb + (size_t)m * DM, RS + m, lane);
        { const int* positions = INP(1, int); f32x2_t* ROPE = WSP(WS_ROPE, f32x2_t);
          for (int m4 = gw; m4 < T / 4; m4 += NGW) { const int tg = 4 * m4 + (lane >> 4), i = lane & 15; const float ang = (float)positions[tg] * powf(10000.f, -(float)i * (1.f / 16.f));
              ROPE[(size_t)tg * 16 + i] = (f32x2_t){cosf(ang), sinf(ang)}; } }
    }
    SEAM(0);

    for (int l = 0; l < DEPTH; ++l) {
        const int pb = 1 + 11 * l;
        if (PH_IN(pb + 0)) {
            PHASE_VARS;
            pg8::Gemm g{(const bf16*)A->out, WSP(WS_W1T, bf16), T, 3584, 1024, 1024}; pg8::StaticOrder S; S.init(T, 3584, G, bx);
            pg8::EpiBf16<0> E{WSP(WS_OA, bf16), 512, 512, SLOT, 0, nullptr, 0, WSP(WS_RS, float)};
            pg8::gemm_phase<pg8::EpiBf16<0>, pg8::StaticOrder, true, true>(lds + RING_OFF, g, S, E, wave0);
        }
        SEAM(pb + 0);
        if (PH_IN(pb + 1)) {
            PHASE_VARS;
            const float* qn = INP(10, float) + l * 256; const float* kvn = INP(12, float) + l * 128; const f32x2_t* ROPE = WSP(WS_ROPE, f32x2_t);
            bf16* OC = WSP(WS_OC, bf16); bf16* KR = WSP(WS_KR, bf16);
            for (int m = 4 * gw; m < T; m += 4 * NGW) mla_prep_rows<4>(OC + (size_t)m * 512, KR + (size_t)m * 32, qn, kvn, ROPE + (size_t)m * 16, lane);
        }
        SEAM(pb + 1);
        if (PH_IN(pb + 2)) {
            PHASE_VARS;
#pragma nounroll
            for (int st = 0; st < 2; ++st) {
            if (((st ^ bx) & 1) == 0) {
                __syncthreads();
                for (int c_ = bx; c_ < NB * 64; c_ += G) kmean_task(WSP(WS_MK, bf16), WSP(WS_KMEAN, float), c_ >> 6, (c_ >> 1) & 31, c_ & 1, (LAS float*)(lds + RING_OFF), tid);
            } else {
            pg8::Gemm g{WSP(WS_OC, bf16), WSP(WS_WQKV, bf16), T, 1792, 384, 512}; pg8::StaticOrder S; S.init(T, 1792, G, bx);
            pg8::EpiBf16<0> E{WSP(WS_Q, bf16), 768, 0, 0, 3, WSP(WS_KV, bf16), 1024, nullptr};
            pg8::gemm_phase<pg8::EpiBf16<0>, pg8::StaticOrder, true, true>(lds + RING_OFF, g, S, E, wave0);
            } }
        }
        SEAM(pb + 2);
        if (PH_IN(pb + 3)) {
            LAS unsigned* slot = (LAS unsigned*)(lds + A_SLOT);
            if constexpr (ATM & 1) for (int k_ = 0;; ++k_) {
                PHASE_VARS;
                const int u = next_unit_idx(k_, 512, G, bx, (gu32*)(A->ws + WS_CTL) + CW_QUEUE + 64 * (3 * l), slot, wave0); if (u >= 512) break;
                const int qb = 31 - (u >> 4), r = u & 15, b = r >> 2, h = r & 3; const size_t t0 = (size_t)b * SEQ;
                bf16* OB = WSP(WS_OB, bf16);
                AttnArgs a; a.q = OB + t0 * 512 + h * 128; a.ldq = 512; a.k = WSP(WS_MK, bf16) + t0 * 512 + h * 128; a.ldk = 512; a.k2 = nullptr; a.v = WSP(WS_MV, bf16) + t0 * 512 + h * 128; a.ldv = 512;
                a.o = OB + t0 * 512 + h * 128; a.ldo = 512; a.qb = qb; a.C = 0.08838834764831845f * LOG2E; a.bias = INP(2, float) + 4 + h; a.rope = nullptr; a.kmean = WSP(WS_KMEAN, float) + ((size_t)b * 4 + h) * 32 * 128;
                attn_unit<MODE_MOBA>(lds, a, wave0);
            }
            if constexpr (ATM & 2) for (int k_ = 0;; ++k_) {
                PHASE_VARS;
                const int u = next_unit_idx(k_, 1024, G, bx, (gu32*)(A->ws + WS_CTL) + CW_QUEUE + 64 * (3 * l + 1), slot, wave0); if (u >= 1024) break;
                const int qb = 31 - (u >> 5), r = u & 31, b = r >> 3, h = (r >> 1) & 3, mp = r & 1; const size_t t0 = (size_t)b * SEQ;
                AttnArgs a; a.q = WSP(WS_OA, bf16) + t0 * 512 + h * 128 + mp * 64; a.ldq = 512; a.k = WSP(WS_DK, bf16) + t0 * 512 + h * 128 + mp * 64; a.ldk = 512; a.k2 = nullptr; a.v = WSP(WS_DV, bf16) + t0 * 512 + h * 128; a.ldv = 512;
                a.o = WSP(WS_O12, bf16) + t0 * 1024 + (h * 2 + mp) * 128; a.ldo = 1024; a.qb = qb; a.C = 0.125f * LOG2E; a.bias = INP(2, float) + h; a.rope = nullptr; a.kmean = nullptr;
                attn_unit<MODE_DIFF>(lds, a, wave0);
            }
            if constexpr (ATM & 4) for (int k_ = 0;; ++k_) {
                PHASE_VARS;
                const int u = next_unit_idx(k_, 1024, G, bx, (gu32*)(A->ws + WS_CTL) + CW_QUEUE + 64 * (3 * l + 2), slot, wave0); if (u >= 1024) break;
                const int qb = 31 - (u >> 5), r = u & 31, b = r >> 3, h = r & 7; const size_t t0 = (size_t)b * SEQ;
                bf16* KVB = WSP(WS_KV, bf16);
                AttnArgs a; a.q = WSP(WS_Q, bf16) + t0 * 768 + h * 96; a.ldq = 768; a.k = KVB + t0 * 1024 + h * 128; a.ldk = 1024; a.k2 = WSP(WS_KR, bf16) + t0 * 32; a.v = KVB + t0 * 1024 + h * 128 + 64; a.ldv = 1024;
                a.o = WSP(WS_OC, bf16) + t0 * 512 + h * 64; a.ldo = 512; a.qb = qb; a.C = 0.10206207261596577f * LOG2E; a.bias = nullptr; a.rope = WSP(WS_ROPE, f32x2_t) + t0 * 16; a.kmean = nullptr;
                attn_unit<MODE_MLA>(lds, a, wave0);
            }
        }
        SEAM(pb + 3);
        if (PH_IN(pb + 4)) {
            PHASE_VARS;
#pragma nounroll
            for (int st = 0; st < 2; ++st) {
            if (((st ^ bx) & 1) == 0) {
                const float lam_init = 0.8f - 0.6f * expf(-0.3f * (float)l);
                const float* dl = INP(8, float) + l * 256;
                const float lam = expf(wave_sum(dl[lane] * dl[64 + lane], lane)) - expf(wave_sum(dl[128 + lane] * dl[192 + lane], lane)) + lam_init;
                const bf16* O12 = WSP(WS_O12, bf16); bf16* OA = WSP(WS_OA, bf16); const float* subln = INP(9, float) + l * 128;
                for (int m = gw; m < T; m += NGW) diff_combine_row(O12 + (size_t)m * 1024, OA + (size_t)m * 512, subln, lam, 1.f - lam_init, lane);
            } else {
            pg8::Gemm g{(const bf16*)A->out, WSP(WS_WGT, bf16), T, 3072, 1024, 1024}; pg8::StaticOrder S; S.init(T, 3072, G, bx);
            pg8::EpiBf16<2> E{WSP(WS_S, bf16), 3072, 0, 0, 0, nullptr, 0, WSP(WS_RS, float)};
            pg8::gemm_phase<pg8::EpiBf16<2>, pg8::StaticOrder, true, true>(lds + RING_OFF, g, S, E, wave0);
            } }
        }
        SEAM(pb + 4);
        if (PH_IN(pb + 5)) {
            PHASE_VARS;
            pg8::Gemm g{WSP(WS_OA, bf16), WSP(WS_WBT, bf16), 3 * T, 3 * 1024, 512, 512}; pg8::BranchOrder S; S.init(T, G, bx);
            pg8::EpiBranch E{WSP(WS_S, bf16), WSP(WS_H, bf16)};
            pg8::gemm_phase<pg8::EpiBranch, pg8::BranchOrder, true, true>(lds + RING_OFF, g, S, E, wave0);
        }
        SEAM(pb + 5);
        if (PH_IN(pb + 6)) {
            PHASE_VARS;
            pg8::Gemm g{WSP(WS_H, bf16), WSP(WS_WOT, bf16), T, 1024, 1024, 1024}; pg8::StaticOrder S; S.init(T, 1024, G, bx);
            pg8::EpiBf16<0> E{WSP(WS_Y, bf16), 1024, 0, 0, 0, nullptr, 0, nullptr};
            pg8::gemm_phase<pg8::EpiBf16<0>, pg8::StaticOrder, true, true>(lds + RING_OFF, g, S, E, wave0);
        }
        SEAM(pb + 6);
        if (PH_IN(pb + 7)) {
            PHASE_VARS;
            bf16* xb = (bf16*)A->out; bf16* xdst = (l == DEPTH - 1) ? WSP(WS_O12, bf16) : xb;
            const bf16* YB = WSP(WS_Y, bf16); float* RS = WSP(WS_RS, float); const float* wpost = INP(4, float) + l * DM;
            if (l == 0) { const float* xin = INP(0, float); for (int m = 2 * gw; m < T; m += 2 * NGW) resid_row2<true, false>(YB + (size_t)m * DM, xin + (size_t)m * DM, xdst + (size_t)m * DM, wpost, RS + m, lane); }
            else { for (int m = 2 * gw; m < T; m += 2 * NGW) resid_row2<false, false>(YB + (size_t)m * DM, xb + (size_t)m * DM, xdst + (size_t)m * DM, wpost, RS + m, lane); }
        }
        SEAM(pb + 7);
        if (PH_IN(pb + 8)) {
            PHASE_VARS;
            pg8::Gemm g{(l == DEPTH - 1) ? (const bf16*)WSP(WS_O12, bf16) : (const bf16*)A->out, WSP(WS_WUPT, bf16), T, 4096, 1024, 1024}; pg8::StaticOrder S; S.init(T, 4096, G, bx);
            pg8::EpiBf16<3> E{WSP(WS_U, bf16), 4096, 0, 0, 0, nullptr, 0, WSP(WS_RS, float)};
            pg8::gemm_phase<pg8::EpiBf16<3>, pg8::StaticOrder, true, true>(lds + RING_OFF, g, S, E, wave0);
        }
        SEAM(pb + 8);
        if (PH_IN(pb + 9)) {
            PHASE_VARS;
            pg8::Gemm g{WSP(WS_U, bf16), WSP(WS_WDNT, bf16), T, 1024, 4096, 4096}; pg8::StaticOrder S; S.init(T, 1024, G, bx);
            pg8::EpiBf16<0> E{WSP(WS_D, bf16), 1024, 0, 0, 0, nullptr, 0, nullptr};
            pg8::gemm_phase<pg8::EpiBf16<0>, pg8::StaticOrder, true, true>(lds + RING_OFF, g, S, E, wave0);
        }
        SEAM(pb + 9);
        if (PH_IN(pb + 10)) {
            PHASE_VARS;
            const bool more = (l + 1 < DEPTH);
            if (more) {
                const size_t n = (size_t)(l + 1);
                LAS float* scrw = (LAS float*)(lds + RING_OFF + wave * 16384);
                LayerW L{INP(7, float) + n * 1024 * DIN, INP(11, float) + n * 256 * 768, INP(13, float) + n * 128 * 1024, INP(14, float) + n * 3 * 512 * 1024,
                         INP(15, float) + n * 1024 * 1024, INP(16, float) + n * 1024 * 4096, INP(17, float) + n * 4096 * 1024, INP(3, float) + n * DM, INP(5, float) + n * DM};
                convert_weights(L, A->ws, scrw, gw, NGW, lane);
            }
            const bf16* DB = WSP(WS_D, bf16); float* RS = WSP(WS_RS, float);
            const float* wpost = INP(6, float) + l * DM;
            if (more) { bf16* xb = (bf16*)A->out; for (int m = 2 * gw; m < T; m += 2 * NGW) resid_row2<false, false>(DB + (size_t)m * DM, xb + (size_t)m * DM, xb + (size_t)m * DM, wpost, RS + m, lane); }
            else { const bf16* xsrc = WSP(WS_O12, bf16); float* xo = A->out; for (int m = 2 * gw; m < T; m += 2 * NGW) resid_row2<false, true>(DB + (size_t)m * DM, xsrc + (size_t)m * DM, xo + (size_t)m * DM, wpost, (float*)nullptr, lane); }
        }
        if (l + 1 < DEPTH) SEAM(pb + 10);
    }
}

extern "C" void kernel_launch(void* const* d_in, const int* in_sizes, int n_in, void* d_out, int out_size, void* d_ws, size_t ws_size, hipStream_t stream) {
    static int grid = 0;
    if (grid == 0) {
        if (n_in != 18 || in_sizes[0] != T * DM || out_size != T * DM || ws_size < WS_END) { fprintf(stderr, "kernel_launch: unexpected shapes (n_in %d, in0 %d, out %d, ws %zu, need %zu); nothing launched\n", n_in, n_in > 0 ? in_sizes[0] : -1, out_size, ws_size, (size_t)WS_END); grid = -1; return; }
        int dev = 0, cus = 0, per_cu = 0;
        if (hipGetDevice(&dev) != hipSuccess || hipDeviceGetAttribute(&cus, hipDeviceAttributeMultiprocessorCount, dev) != hipSuccess) { grid = -1; return; }
        if (hipFuncSetAttribute((const void*)trunk_fwd, hipFuncAttributeMaxDynamicSharedMemorySize, LDS_BYTES) != hipSuccess) { fprintf(stderr, "kernel_launch: hipFuncSetAttribute failed\n"); grid = -1; return; }
        if (hipOccupancyMaxActiveBlocksPerMultiprocessor(&per_cu, (const void*)trunk_fwd, NWAVES * 64, LDS_BYTES) != hipSuccess || per_cu < 1) { fprintf(stderr, "kernel_launch: occupancy query says %d blocks per CU\n", per_cu); }
        (void)hipGetLastError();
        grid = cus;
    }
    if (grid < 0) return;
    if (hipMemsetAsync((char*)d_ws + WS_CTL, 0, CTL_ZERO_BYTES, stream) != hipSuccess) return;
    Args a{};
    for (int i = 0; i < 18; ++i) a.in[i] = d_in[i];
    a.out = (float*)d_out; a.ws = (unsigned char*)d_ws;
    constexpr int NPH = 1 + 11 * DEPTH;
#ifndef N_LAUNCH
#define N_LAUNCH 1
#endif
    for (int li = 0; li < N_LAUNCH; ++li) {
        a.ph_lo = (N_LAUNCH == 1) ? 0 : li; a.ph_hi = (N_LAUNCH == 1) ? NPH : li + 1;
        hipLaunchKernelGGL(trunk_fwd, dim3(grid), dim3(NWAVES * 64), LDS_BYTES, stream, a);
        const hipError_t le = hipPeekAtLastError();
        if (le != hipSuccess) { fprintf(stderr, "kernel_launch: launch failed: %s\n", hipGetErrorName(le)); break; }
    }
}
```

```cpp
#include <hip/hip_runtime.h>
#include <cstdio>
#include <cstdint>
__device__ __forceinline__ int opaque_tid(int wave_s) { int l; asm volatile("v_mbcnt_lo_u32_b32 %0, -1, 0\n\tv_mbcnt_hi_u32_b32 %0, -1, %0" : "=v"(l)); return wave_s * 64 + l; }
__device__ __forceinline__ int opaque_s(int v) { asm volatile("" : "+s"(v)); return v; }
namespace pg8 {
#define PG8_LAS __attribute__((address_space(3)))
typedef unsigned short bf16_t;
typedef short bf16x8 __attribute__((ext_vector_type(8)));
typedef float f32x4 __attribute__((ext_vector_type(4)));
typedef unsigned u32x4 __attribute__((ext_vector_type(4)));
constexpr int BM = 256, BK = 64, HALF = 128, HTB = HALF * BK * 2  , STAGE_BYTES = 8 * HTB, NXCD = 8, WGM = 8;

__host__ __device__ __forceinline__ int lds_byte(int r, int c) { const int st = (r >> 4) * 2 + (c >> 5), rr = r & 15, cc = c & 31, ob = rr * 64 + cc * 2; return st * 1024 + (ob ^ (((ob >> 9) & 1) << 5)); }
__host__ __device__ __forceinline__ void stage_rc(int b, int& R, int& C) { const int st = b / 1024, sb = b % 1024, swz = sb ^ (((sb >> 9) & 1) << 5); R = (st >> 1) * 16 + swz / 64; C = (st & 1) * 32 + (swz % 64) / 2; }
__host__ __device__ __forceinline__ int perm32(int rho) { const int n = rho >> 4, i = rho & 15; return 8 * (i >> 2) + 4 * n + (i & 3); }

struct Unit { int pm, pn; };
struct Gemm { const bf16_t* A; const bf16_t* Bt; int M, N, K, lda; int split_pn = 0, k_hi = 0, nt_lo = 0, nt_hi = 0; };

struct StaticOrder {
    int nM, nN, nwg, G, c;
    __host__ __device__ void init(int M, int N, int G_, int c_) { nM = M / BM; nN = N / BM; nwg = nM * nN; G = G_; c = c_; }
    __host__ __device__ bool next(int i, Unit& u) const {
        const long L = (long)i * G + c; if (L >= nwg) return false;
        int wgid = (int)L; { const int q = nwg / NXCD, r = nwg % NXCD, xcd = wgid % NXCD, off = wgid / NXCD; wgid = (xcd < r ? xcd * (q + 1) : r * (q + 1) + (xcd - r) * q) + off; }
        const int nig = WGM * nN, gid = wgid / nig, fm = gid * WGM, gsz = (nM - fm) < WGM ? (nM - fm) : WGM;
        u.pm = fm + ((wgid % nig) % gsz); u.pn = (wgid % nig) / gsz; return true;
    }
    __device__ __forceinline__ void a_ready(const Unit&) const {}
    __device__ __forceinline__ void done(const Unit&) const {}
};

typedef float f32x2c __attribute__((ext_vector_type(2))); typedef __bf16 bf16x2c __attribute__((ext_vector_type(2)));
__device__ __forceinline__ unsigned cvt_pk_bf16(float lo, float hi) { f32x2c v = {lo, hi}; bf16x2c b = __builtin_convertvector(v, bf16x2c); return __builtin_bit_cast(unsigned, b); }
__device__ __forceinline__ float bf_lo(unsigned w) { return __builtin_bit_cast(float, w << 16); }
__device__ __forceinline__ float bf_hi(unsigned w) { return __builtin_bit_cast(float, w & 0xffff0000u); }
__device__ __forceinline__ float act_sigmoid(float v) { return __builtin_amdgcn_rcpf(1.f + __builtin_amdgcn_exp2f(-1.4426950408889634f * v)); }
__device__ __forceinline__ float act_relu2(float v) { const float r = fmaxf(v, 0.f); return r * r; }

template <int ACT  > struct EpiBf16 {
    static constexpr bool PERM = true, AFTER_DRAIN = false;
    bf16_t* O; int ldc; int split_cols; size_t split_stride; int pn2; bf16_t* O2; int ldc2; const float* rs;
    __device__ __forceinline__ void operator()(const f32x4 (&acc)[2][2][4][2], const Unit& u, int wr, int wc, int fr, int fq) const {
        const int row0 = u.pm * BM + wr * 64 + fr; int colt = u.pn * BM; bf16_t* base = O; int ldc = this->ldc;
        if (pn2 && u.pn >= pn2) { base = O2; ldc = ldc2; colt = (u.pn - pn2) * BM; }
        if (split_cols) { const int t = colt / split_cols; base += (size_t)t * split_stride; colt -= t * split_cols; }
        const int col0 = colt + wc * 32 + 8 * fq;
#pragma unroll
        for (int ai = 0; ai < 2; ++ai)
#pragma unroll
            for (int m = 0; m < 4; ++m) { bf16_t* rowp = base + (size_t)(row0 + ai * HALF + m * 16) * ldc + col0; const float rsc = rs ? rs[row0 + ai * HALF + m * 16] : 1.f;
#pragma unroll
                for (int bj = 0; bj < 2; ++bj) { f32x4 v0 = acc[ai][bj][m][0] * rsc, v1 = acc[ai][bj][m][1] * rsc;
                    if (ACT == 2) { v0 = (f32x4){act_sigmoid(v0[0]), act_sigmoid(v0[1]), act_sigmoid(v0[2]), act_sigmoid(v0[3])}; v1 = (f32x4){act_sigmoid(v1[0]), act_sigmoid(v1[1]), act_sigmoid(v1[2]), act_sigmoid(v1[3])}; }
                    if (ACT == 3) { v0 = (f32x4){act_relu2(v0[0]), act_relu2(v0[1]), act_relu2(v0[2]), act_relu2(v0[3])}; v1 = (f32x4){act_relu2(v1[0]), act_relu2(v1[1]), act_relu2(v1[2]), act_relu2(v1[3])}; }
                    u32x4 w; w.x = cvt_pk_bf16(v0[0], v0[1]); w.y = cvt_pk_bf16(v0[2], v0[3]); w.z = cvt_pk_bf16(v1[0], v1[1]); w.w = cvt_pk_bf16(v1[2], v1[3]);
                    *(u32x4*)(rowp + bj * HALF) = w; } }
    }
};

struct EpiF32 {
    static constexpr bool PERM = true, AFTER_DRAIN = false;
    float* O; int ldc;
    __device__ __forceinline__ void operator()(const f32x4 (&acc)[2][2][4][2], const Unit& u, int wr, int wc, int fr, int fq) const {
        const int row0 = u.pm * BM + wr * 64 + fr; const int col0 = u.pn * BM + wc * 32 + 8 * fq;
#pragma unroll
        for (int ai = 0; ai < 2; ++ai)
#pragma unroll
            for (int m = 0; m < 4; ++m) { float* rowp = O + (size_t)(row0 + ai * HALF + m * 16) * ldc + col0;
#pragma unroll
                for (int bj = 0; bj < 2; ++bj) { *(f32x4*)(rowp + bj * HALF) = acc[ai][bj][m][0]; *(f32x4*)(rowp + bj * HALF + 4) = acc[ai][bj][m][1]; } }
    }
};

struct EpiBranch {
    static constexpr bool PERM = true, AFTER_DRAIN = false;
    const bf16_t* S; bf16_t* Mo;
    __device__ __forceinline__ void operator()(const f32x4 (&acc)[2][2][4][2], const Unit& u, int wr, int wc, int fr, int fq) const {
        const int g = u.pm >> 7, pm = u.pm & 127, pn = u.pn & 3;
        const int row0 = pm * BM + wr * 64 + fr; const int col0 = pn * BM + wc * 32 + 8 * fq;
#pragma unroll
        for (int ai = 0; ai < 2; ++ai)
#pragma unroll
            for (int m = 0; m < 4; ++m) { const size_t row = (size_t)(row0 + ai * HALF + m * 16);
#pragma unroll
                for (int bj = 0; bj < 2; ++bj) { const int col = col0 + bj * HALF;
                    const u32x4 sv = *(const u32x4*)(S + row * 3072 + g * 1024 + col);
                    const f32x4 v0 = acc[ai][bj][m][0], v1 = acc[ai][bj][m][1];
                    float r0 = bf_lo(sv.x) * v0[0], r1 = bf_hi(sv.x) * v0[1], r2 = bf_lo(sv.y) * v0[2], r3 = bf_hi(sv.y) * v0[3];
                    float r4 = bf_lo(sv.z) * v1[0], r5 = bf_hi(sv.z) * v1[1], r6 = bf_lo(sv.w) * v1[2], r7 = bf_hi(sv.w) * v1[3];
                    u32x4* dst = (u32x4*)(Mo + row * 1024 + col);
                    if (g > 0) { const u32x4 pv = *dst; r0 += bf_lo(pv.x); r1 += bf_hi(pv.x); r2 += bf_lo(pv.y); r3 += bf_hi(pv.y); r4 += bf_lo(pv.z); r5 += bf_hi(pv.z); r6 += bf_lo(pv.w); r7 += bf_hi(pv.w); }
                    u32x4 w; w.x = cvt_pk_bf16(r0, r1); w.y = cvt_pk_bf16(r2, r3); w.z = cvt_pk_bf16(r4, r5); w.w = cvt_pk_bf16(r6, r7);
                    *dst = w; } }
    }
};
struct BranchOrder {
    StaticOrder S0;
    __device__ void init(int M, int G_, int c_) { S0.init(M, 1024, G_, c_); }
    __device__ bool next(int i, Unit& u) const { Unit t; if (!S0.next(i / 3, t)) return false; const int g = i % 3; u.pm = g * 128 + t.pm; u.pn = g * 4 + t.pn; return true; }
    __device__ __forceinline__ void a_ready(const Unit&) const {}
    __device__ __forceinline__ void done(const Unit&) const {}
};

template <class Epi, class Sched, bool ALIGN_EPI = false, bool SP2 = false>
__device__ __forceinline__ void gemm_phase(PG8_LAS unsigned char* lds, const Gemm g, const Sched& S, const Epi& E, int wave_s) {
    const int tid = opaque_tid(wave_s), wid = __builtin_amdgcn_readfirstlane(tid >> 6), lane = tid & 63, wr = wid >> 2, wc = wid & 3, fr = lane & 15, fq = lane >> 4;
    const int K = g.K; int nt = g.split_pn ? 0 : K / BK;
    unsigned voffA[2], voffB[2];
#pragma unroll
    for (int i = 0; i < 2; ++i) { int R, C; stage_rc(tid * 16 + i * 8192, R, C); const int Rb = Epi::PERM ? ((R & ~31) + perm32(R & 31)) : R;
        voffA[i] = (unsigned)(R * g.lda + C) * 2u; voffB[i] = (unsigned)(Rb * K + C) * 2u; }
    const size_t kstep = (size_t)(BK * 2);
    const size_t hstep = (size_t)HALF * K * 2;
    const size_t tstep = 2 * hstep; const size_t hstepA = (size_t)HALF * g.lda * 2, tstepA = 2 * hstepA;
    const unsigned ldsw = (unsigned)wid * 1024u;
    const int aoff = lds_byte(wr * 64 + fr, fq * 8), boff = lds_byte(wc * 32 + fr, fq * 8);
#define PG8_SA(b, h) (((b) * 2 + (h)) * HTB)
#define PG8_SB(b, h) ((4 + (b) * 2 + (h)) * HTB)
#define PG8_STAGE(bufoff, gbase, voff) do { _Pragma("unroll") for (int _i = 0; _i < 2; ++_i) \
        __builtin_amdgcn_global_load_lds((const unsigned*)((const char*)(gbase) + (voff)[_i]), (PG8_LAS unsigned*)(lds + (bufoff) + ldsw + _i * 8192), 16, 0, 0); } while (0)
#define PG8_LDA(dst, b, h) do { _Pragma("unroll") for (int m = 0; m < 4; ++m) _Pragma("unroll") for (int k = 0; k < 2; ++k) dst[m][k] = *(const PG8_LAS bf16x8*)(lds + PG8_SA(b, h) + aoff + m * 2048 + k * 1024); } while (0)
#define PG8_LDB(dst, b, h) do { _Pragma("unroll") for (int n = 0; n < 2; ++n) _Pragma("unroll") for (int k = 0; k < 2; ++k) dst[n][k] = *(const PG8_LAS bf16x8*)(lds + PG8_SB(b, h) + boff + n * 2048 + k * 1024); } while (0)
#define PG8_MMA(ai, bj, At, Bt) do { __builtin_amdgcn_s_setprio(1); _Pragma("unroll") for (int m = 0; m < 4; ++m) _Pragma("unroll") for (int n = 0; n < 2; ++n) _Pragma("unroll") for (int k = 0; k < 2; ++k) \
        acc[ai][bj][m][n] = __builtin_amdgcn_mfma_f32_16x16x32_bf16(Bt[n][k], At[m][k], acc[ai][bj][m][n], 0, 0, 0); __builtin_amdgcn_s_setprio(0); } while (0)
#define PG8_WAIT_V(n) asm volatile("s_waitcnt vmcnt(" #n ")" ::: "memory")
#define PG8_WAIT_L(n) asm volatile("s_waitcnt lgkmcnt(" #n ")" ::: "memory")
#define PG8_BAR __builtin_amdgcn_s_barrier()
#define PG8_SCHED __builtin_amdgcn_sched_barrier(0)
    Unit cur, nxt; int ui = 0;
    if (!S.next(0, cur)) return;
    f32x4 acc[2][2][4][2];
#pragma unroll
    for (int a = 0; a < 2; ++a)
#pragma unroll
        for (int b = 0; b < 2; ++b)
#pragma unroll
            for (int m = 0; m < 4; ++m)
#pragma unroll
                for (int n = 0; n < 2; ++n) acc[a][b][m][n] = (f32x4){0.f, 0.f, 0.f, 0.f};
    bf16x8 At[4][2], B0[2][2], B1[2][2];
    const char* cA = (const char*)g.A + (size_t)cur.pm * tstepA; const char* cB = (const char*)g.Bt + (size_t)cur.pn * tstep;
    if (g.split_pn) { const bool hi_ = cur.pn >= g.split_pn; nt = hi_ ? g.nt_hi : g.nt_lo; if (hi_) { cA += (size_t)g.k_hi * 2; cB += (size_t)g.k_hi * 2; } }
    S.a_ready(cur);
    if constexpr (SP2) {
        PG8_STAGE(PG8_SB(0, 0), cB, voffB); PG8_STAGE(PG8_SB(0, 1), cB + hstep, voffB); PG8_STAGE(PG8_SA(0, 0), cA, voffA); PG8_STAGE(PG8_SA(0, 1), cA + hstepA, voffA);
        if (wr == 1) PG8_BAR;
        PG8_WAIT_V(2); PG8_BAR;
        PG8_STAGE(PG8_SB(1, 0), cB + kstep, voffB); PG8_STAGE(PG8_SA(1, 0), cA + kstep, voffA); PG8_STAGE(PG8_SB(1, 1), cB + hstep + kstep, voffB);
        PG8_WAIT_V(6); PG8_BAR;
    } else {
        PG8_STAGE(PG8_SB(0, 0), cB, voffB); PG8_STAGE(PG8_SA(0, 0), cA, voffA); PG8_STAGE(PG8_SB(0, 1), cB + hstep, voffB); PG8_STAGE(PG8_SA(0, 1), cA + hstepA, voffA);
        if (wr == 1) PG8_BAR;
        PG8_WAIT_V(4); PG8_BAR;
        PG8_STAGE(PG8_SB(1, 0), cB + kstep, voffB); PG8_STAGE(PG8_SA(1, 0), cA + kstep, voffA); PG8_STAGE(PG8_SB(1, 1), cB + hstep + kstep, voffB);
        PG8_WAIT_V(6); PG8_BAR;
    }
    for (;;) {
        const bool has_next = S.next(ui + 1, nxt);
        const char* nA = has_next ? (const char*)g.A + (size_t)nxt.pm * tstepA : cA; const char* nB = has_next ? (const char*)g.Bt + (size_t)nxt.pn * tstep : cB;
        int nt_nxt = nt;
        if (g.split_pn && has_next) { const bool hi_ = nxt.pn >= g.split_pn; nt_nxt = hi_ ? g.nt_hi : g.nt_lo; if (hi_) { nA += (size_t)g.k_hi * 2; nB += (size_t)g.k_hi * 2; } }
        for (int t = 0; t < nt; t += 2) {
            const bool last = (t == nt - 2);
            const char* a1 = cA + (size_t)(t + 1) * kstep;
            const char* a2 = last ? nA : cA + (size_t)(t + 2) * kstep; const char* b2 = last ? nB : cB + (size_t)(t + 2) * kstep;
            const char* a3 = a2 + kstep; const char* b3 = b2 + kstep;
            if (last && has_next) S.a_ready(nxt);
            if constexpr (SP2) {
            PG8_LDB(B0, 0, 0); PG8_LDB(B1, 0, 1); PG8_SCHED; PG8_LDA(At, 0, 0); PG8_STAGE(PG8_SA(1, 1), a1 + hstepA, voffA);
            PG8_WAIT_V(8); PG8_WAIT_L(0); PG8_BAR; PG8_MMA(0, 0, At, B0); PG8_MMA(0, 1, At, B1); PG8_BAR; PG8_SCHED;
            PG8_LDA(At, 0, 1); PG8_STAGE(PG8_SB(0, 0), b2, voffB); PG8_STAGE(PG8_SB(0, 1), b2 + hstep, voffB); PG8_STAGE(PG8_SA(0, 0), a2, voffA);
            PG8_WAIT_V(8); PG8_WAIT_L(0); PG8_BAR; PG8_MMA(1, 0, At, B0); PG8_MMA(1, 1, At, B1); PG8_BAR; PG8_SCHED;
            PG8_LDB(B0, 1, 0); PG8_LDB(B1, 1, 1); PG8_SCHED; PG8_LDA(At, 1, 0); PG8_STAGE(PG8_SA(0, 1), a2 + hstepA, voffA);
            PG8_WAIT_V(8); PG8_WAIT_L(0); PG8_BAR; PG8_MMA(0, 0, At, B0); PG8_MMA(0, 1, At, B1); PG8_BAR; PG8_SCHED;
            PG8_LDA(At, 1, 1); PG8_STAGE(PG8_SB(1, 0), b3, voffB); PG8_STAGE(PG8_SB(1, 1), b3 + hstep, voffB); PG8_STAGE(PG8_SA(1, 0), a3, voffA);
            PG8_WAIT_V(8); PG8_WAIT_L(0); PG8_BAR; PG8_MMA(1, 0, At, B0); PG8_MMA(1, 1, At, B1); PG8_BAR; PG8_SCHED;
            } else {
            PG8_LDB(B0, 0, 0); PG8_SCHED; PG8_LDA(At, 0, 0); PG8_STAGE(PG8_SA(1, 1), a1 + hstepA, voffA);
            PG8_WAIT_L(8); PG8_BAR; PG8_WAIT_L(0); PG8_MMA(0, 0, At, B0); PG8_BAR; PG8_SCHED;
            PG8_LDB(B1, 0, 1); PG8_STAGE(PG8_SB(0, 0), b2, voffB);
            PG8_BAR; PG8_WAIT_L(0); PG8_MMA(0, 1, At, B1); PG8_BAR;
            PG8_LDA(At, 0, 1); PG8_STAGE(PG8_SA(0, 0), a2, voffA);
            PG8_BAR; PG8_WAIT_L(0); PG8_MMA(1, 0, At, B0); PG8_BAR; PG8_SCHED;
            PG8_STAGE(PG8_SB(0, 1), b2 + hstep, voffB);
            PG8_WAIT_V(6); PG8_BAR; PG8_MMA(1, 1, At, B1); PG8_BAR;
            PG8_LDB(B0, 1, 0); PG8_SCHED; PG8_LDA(At, 1, 0); PG8_STAGE(PG8_SA(0, 1), a2 + hstepA, voffA);
            PG8_WAIT_L(8); PG8_BAR; PG8_WAIT_L(0); PG8_MMA(0, 0, At, B0); PG8_BAR; PG8_SCHED;
            PG8_LDB(B1, 1, 1); PG8_STAGE(PG8_SB(1, 0), b3, voffB);
            PG8_BAR; PG8_WAIT_L(0); PG8_MMA(0, 1, At, B1); PG8_BAR;
            PG8_LDA(At, 1, 1); PG8_STAGE(PG8_SA(1, 0), a3, voffA);
            PG8_BAR; PG8_WAIT_L(0); PG8_MMA(1, 0, At, B0); PG8_BAR; PG8_SCHED;
            PG8_STAGE(PG8_SB(1, 1), b3 + hstep, voffB);
            PG8_WAIT_V(6); PG8_BAR; PG8_MMA(1, 1, At, B1); PG8_BAR;
            }
        }
        if constexpr (ALIGN_EPI) { if (wr == 0) PG8_BAR; }
        if constexpr (!Epi::AFTER_DRAIN) { E(acc, cur, wr, wc, fr, fq); S.done(cur); }
        if (!has_next) break;
#pragma unroll
        for (int a = 0; a < 2; ++a)
#pragma unroll
            for (int b = 0; b < 2; ++b)
#pragma unroll
                for (int m = 0; m < 4; ++m)
#pragma unroll
                    for (int n = 0; n < 2; ++n) acc[a][b][m][n] = (f32x4){0.f, 0.f, 0.f, 0.f};
        cur = nxt; cA = nA; cB = nB; nt = nt_nxt; ++ui;
        if constexpr (ALIGN_EPI) { if (wr == 1) PG8_BAR; }
    }
    PG8_WAIT_V(0);
    if constexpr (!ALIGN_EPI) { if (wr == 0) PG8_BAR; }
    PG8_BAR;
    if constexpr (Epi::AFTER_DRAIN) { E.fused(acc, cur, wr, wc, fr, fq, lds, wid, lane); S.done(cur); }
#undef PG8_SA
#undef PG8_SB
#undef PG8_STAGE
#undef PG8_LDA
#undef PG8_LDB
#undef PG8_MMA
#undef PG8_WAIT_V
#undef PG8_WAIT_L
#undef PG8_BAR
#undef PG8_SCHED
}
}

constexpr int NB = 4, SEQ = 8192, DM = 1024, T = NB * SEQ, DEPTH = 4, DIN = 6560, DFF = 4096;
constexpr float RMS_EPS = 1e-6f;
#define N_LAUNCH 1
constexpr int NWAVES = 8;
#ifndef ATM
#define ATM 7
#endif
constexpr size_t MiB = 1u << 20;
constexpr size_t WS_CTL = 0, CTL_ZERO_BYTES = 65536;
constexpr size_t WS_RS = 768 * 1024;
constexpr size_t WS_KMEAN = 512 * 1024;
constexpr size_t WS_W1T = 1 * MiB, WS_WGT = 8 * MiB, WS_WQKV = 14 * MiB  , WS_WBT = 16 * MiB, WS_WOT = 19 * MiB, WS_WUPT = 21 * MiB, WS_WDNT = 29 * MiB;
constexpr size_t WS_H = 37 * MiB;
constexpr size_t WS_OA = 101 * MiB, WS_OB = 133 * MiB, WS_OC = 165 * MiB, WS_DK = 197 * MiB, WS_DV = 229 * MiB, WS_MK = 261 * MiB, WS_MV = 293 * MiB;
constexpr size_t WS_Q = 325 * MiB, WS_KV = 373 * MiB, WS_KR = 437 * MiB, WS_O12 = 439 * MiB;
constexpr size_t WS_ROPE = 503 * MiB, WS_END = 507 * MiB;
constexpr size_t WS_S = 197 * MiB;
constexpr size_t WS_Y = 197 * MiB;
constexpr size_t WS_U = 101 * MiB;
constexpr size_t WS_D = 373 * MiB;
constexpr size_t SLOT = (size_t)T * 512;
constexpr int CW_BAR = 4096;
constexpr int CW_QUEUE = 8192;

constexpr int RING_OFF = 0, RING_BYTES = 131072;
constexpr int MISC_OFF = RING_BYTES + 320;
constexpr int LDS_BYTES = 147456;
constexpr int A_KOFF = 0, A_VOFF = 34816, A_TAB = 96256, A_WSCR = 100352, A_KMEAN = 102400, A_SLOT = 118784;

#define GAS __attribute__((address_space(1)))
#define LAS __attribute__((address_space(3)))
typedef unsigned short bf16;
typedef unsigned v4u __attribute__((ext_vector_type(4)));
typedef unsigned v2u __attribute__((ext_vector_type(2)));
typedef float f32x4 __attribute__((ext_vector_type(4)));
typedef float f32x2_t __attribute__((ext_vector_type(2)));
typedef float f32x16 __attribute__((ext_vector_type(16)));
typedef short bf16x8 __attribute__((ext_vector_type(8)));
typedef short s16x4 __attribute__((ext_vector_type(4)));
typedef short v4i16_t __attribute__((ext_vector_type(4)));
typedef __bf16 bf16x2_t __attribute__((ext_vector_type(2)));
typedef GAS unsigned gu32;
#define RLX_AGENT __ATOMIC_RELAXED, __HIP_MEMORY_SCOPE_AGENT
#define LDS_WAIT() asm volatile("s_waitcnt lgkmcnt(0)" ::: "memory")
#define VM_WAIT() asm volatile("s_waitcnt vmcnt(0)" ::: "memory")
__device__ __forceinline__ unsigned f2bf(float f) { unsigned u = __builtin_bit_cast(unsigned, f); return (u + 0x7fffu + ((u >> 16) & 1u)) >> 16; }
__device__ __forceinline__ unsigned pk2(float lo, float hi) { return f2bf(lo) | (f2bf(hi) << 16); }
__device__ __forceinline__ unsigned cvtpk_s(float lo, float hi) { f32x2_t v = {lo, hi}; bf16x2_t b = __builtin_convertvector(v, bf16x2_t); return __builtin_bit_cast(unsigned, b); }
__device__ __forceinline__ float bflo(unsigned w) { return __builtin_bit_cast(float, w << 16); }
__device__ __forceinline__ float bfhi(unsigned w) { return __builtin_bit_cast(float, w & 0xffff0000u); }
__device__ __forceinline__ float bf2f(short s) { return __builtin_bit_cast(float, ((unsigned)(unsigned short)s) << 16); }

#define XB_TMO      128
#define XB_XCNT(j)  (256  + 64 * (j))
#define XB_XSUB(j)  (1280 + 64 * (j))
#define XB_XGEN(j)  (2304 + 64 * (j))
#define XB_TOP      3328
#define XB_TOPGEN   3392
#define XCD_BAR_WORDS 3456
#define XB_SPIN_CAP (1u << 20)

__device__ __forceinline__ unsigned xb_ld(unsigned* p)              { return __hip_atomic_load(p, __ATOMIC_RELAXED, __HIP_MEMORY_SCOPE_AGENT); }
__device__ __forceinline__ unsigned xb_add(unsigned* p, unsigned v) { return __hip_atomic_fetch_add(p, v, __ATOMIC_RELAXED, __HIP_MEMORY_SCOPE_AGENT); }
__device__ __forceinline__ unsigned xb_xcc_id() { return (unsigned)__builtin_amdgcn_s_getreg((3 << 11) | 20) & 0xFu; }
#define XB_SPIN(cond, bar) do { unsigned _sp = 0; while (cond) { __builtin_amdgcn_s_sleep(1); \
    if ((++_sp & 255u) == 0u) { if (xb_ld(&(bar)[XB_TMO])) break; if (_sp > XB_SPIN_CAP) { atomicAdd(&(bar)[XB_TMO], 1u); break; } } } } while (0)

struct XcdBarrier {
    unsigned* bar; unsigned x;
    volatile LAS unsigned* st;
};
__device__ __forceinline__ XcdBarrier xcd_barrier_post(unsigned* bar, volatile LAS unsigned* st) {
    XcdBarrier b; b.bar = bar; b.x = xb_xcc_id(); b.st = st;
    if (threadIdx.x == 0) (void)xb_add(&bar[XB_XCNT(b.x)], 1u);
    return b;
}
__device__ __forceinline__ void xcd_barrier_complete(unsigned* bar, unsigned x, unsigned& nloc, unsigned& nx) {
    const unsigned G = gridDim.x * gridDim.y * gridDim.z;
    unsigned sum, cnt, mine, sp = 0u;
    for (;;) {
        sum = 0u; cnt = 0u; mine = 0u;
#pragma unroll
        for (unsigned j = 0; j < 16; ++j) { const unsigned c = xb_ld(&bar[XB_XCNT(j)]); sum += c; cnt += (c > 0u) ? 1u : 0u; mine = (j == x) ? c : mine; }
        if (sum == G) break;
        __builtin_amdgcn_s_sleep(1);
        if ((++sp & 255u) == 0u) { if (xb_ld(&bar[XB_TMO])) break; if (sp > XB_SPIN_CAP) { atomicAdd(&bar[XB_TMO], 1u); break; } }
    }
    nloc = mine > 0u ? mine : 1u; nx = cnt > 0u ? cnt : 1u;
}
__device__ __forceinline__ void xcd_barrier(const XcdBarrier& b, int tid_) {
    asm volatile("s_waitcnt vmcnt(0)" ::: "memory");
    __syncthreads();
    if (tid_ == 0) {
        unsigned* bar = b.bar;
        __builtin_amdgcn_s_waitcnt(0);
        unsigned nloc = b.st[0], nx = b.st[1];
        if (nloc == 0u) { xcd_barrier_complete(bar, b.x, nloc, nx); b.st[0] = nloc; b.st[1] = nx; }
        const unsigned old = xb_add(&bar[XB_XSUB(b.x)], 1u);
        const unsigned gen = old / nloc;
        if (old + 1u == (gen + 1u) * nloc) {
            __builtin_amdgcn_fence(__ATOMIC_RELEASE, "agent");
            asm volatile("s_waitcnt vmcnt(0)" ::: "memory");
            const unsigned og = xb_add(&bar[XB_TOP], 1u);
            const unsigned tg = og / nx;
            if (og + 1u == (tg + 1u) * nx) xb_add(&bar[XB_TOPGEN], 1u);
            else XB_SPIN(xb_ld(&bar[XB_TOPGEN]) == tg, bar);
            __builtin_amdgcn_fence(__ATOMIC_ACQUIRE, "agent");
            xb_add(&bar[XB_XGEN(b.x)], 1u);
            asm volatile("s_waitcnt vmcnt(0)" ::: "memory");
        } else {
            XB_SPIN(xb_ld(&bar[XB_XGEN(b.x)]) == gen, bar);
            __builtin_amdgcn_fence(__ATOMIC_ACQUIRE, "agent");
            asm volatile("s_waitcnt vmcnt(0)" ::: "memory");
        }
    }
    __syncthreads();
}

__device__ __forceinline__ float shfl_xor_l(float v, int o, int lane) { return __builtin_bit_cast(float, __builtin_amdgcn_ds_bpermute((lane ^ o) << 2, __builtin_bit_cast(int, v))); }
__device__ __forceinline__ float wave_sum(float v, int lane) {
#pragma unroll
    for (int o = 1; o < 64; o <<= 1) v += shfl_xor_l(v, o, lane);
    return v;
}
__device__ __forceinline__ void tr_item(const float* W, int ldw, int k0, int n0, bf16* WT, int drow0, int Kd, int kd0, const float* ksc, LAS float* scr, int lane) {
    f32x4 v_[8]; float sc_[8];
#pragma unroll
    for (int i = 0; i < 8; ++i) { const int kk = 8 * i + (lane >> 3); v_[i] = *(const f32x4*)(W + (size_t)(k0 + kk) * ldw + n0 + 4 * (lane & 7)); sc_[i] = ksc ? ksc[k0 + kk] : 1.f; }
#pragma unroll
    for (int i = 0; i < 8; ++i) { const int kk = 8 * i + (lane >> 3); LAS float* d_ = scr + kk * 33 + 4 * (lane & 7);
        d_[0] = v_[i].x * sc_[i]; d_[1] = v_[i].y * sc_[i]; d_[2] = v_[i].z * sc_[i]; d_[3] = v_[i].w * sc_[i]; }
    LDS_WAIT(); asm volatile("" ::: "memory");
    const int c = lane & 7;
#pragma unroll
    for (int j = 0; j < 4; ++j) { const int n = (lane >> 3) + 8 * j; const LAS float* s = scr + (8 * c) * 33 + n;
        v4u o; o.x = pk2(s[0 * 33], s[1 * 33]); o.y = pk2(s[2 * 33], s[3 * 33]); o.z = pk2(s[4 * 33], s[5 * 33]); o.w = pk2(s[6 * 33], s[7 * 33]);
        *(v4u*)(WT + (size_t)(drow0 + n) * Kd + kd0 + k0 + 8 * c) = o; }
    LDS_WAIT(); asm volatile("" ::: "memory");
}
__device__ __forceinline__ void zero_item(bf16* WT, int drow0, int Kd, int k0, int lane) {
    const int c = lane & 7;
#pragma unroll
    for (int j = 0; j < 4; ++j) { const int n = (lane >> 3) + 8 * j; *(v4u*)(WT + (size_t)(drow0 + n) * Kd + k0 + 8 * c) = (v4u){0u, 0u, 0u, 0u}; }
}
__device__ __forceinline__ bool seg_item(int& r, const float* W, int ldw, int K, int n_src0, int n_count, bf16* WT, int drow0, int Kd, int kd0, const float* ksc, LAS float* scr, int lane) {
    const int nb = n_count / 32, cnt = (K / 64) * nb;
    if (r >= cnt) { r -= cnt; return false; }
    const int kb = r / nb, b = r % nb;
    tr_item(W, ldw, 64 * kb, n_src0 + 32 * b, WT, drow0 + 32 * b, Kd, kd0, ksc, scr, lane);
    return true;
}
struct LayerW { const float *w_in, *uq, *ukv, *wb, *wo, *wup, *wdn, *n_mix, *n_mlp; };
__device__ __forceinline__ void convert_weights(const LayerW& L, unsigned char* ws, LAS float* scr, int gw, int NGW, int lane) {
    bf16* W1T = (bf16*)(ws + WS_W1T); bf16* WGT = (bf16*)(ws + WS_WGT); bf16* WQKV = (bf16*)(ws + WS_WQKV);
    bf16* WBT = (bf16*)(ws + WS_WBT); bf16* WOT = (bf16*)(ws + WS_WOT); bf16* WUPT = (bf16*)(ws + WS_WUPT); bf16* WDNT = (bf16*)(ws + WS_WDNT);
    constexpr int N_TR = 16 * (16 * 6 + 13) + 16 * 96 + 4 * 24 + 2 * 32 + 3 * 8 * 32 + 16 * 32 + 16 * 128 + 64 * 32;
    constexpr int N_Z1 = 16 * 3, N_Z2 = 2 * 24, N_Z3 = 4 * 32;
    for (int it = gw; it < N_TR + N_Z1 + N_Z2 + N_Z3; it += NGW) {
        int r = it;
        if (seg_item(r, L.w_in, DIN, 1024, 0,    512, W1T, 0,    1024, 0, L.n_mix, scr, lane)) continue;
        if (seg_item(r, L.w_in, DIN, 1024, 1536, 512, W1T, 512,  1024, 0, L.n_mix, scr, lane)) continue;
        if (seg_item(r, L.w_in, DIN, 1024, 3072, 416, W1T, 1024, 1024, 0, L.n_mix, scr, lane)) continue;
        if (seg_item(r, L.w_in, DIN, 1024, 512,  512, W1T, 1536, 1024, 0, L.n_mix, scr, lane)) continue;
        if (seg_item(r, L.w_in, DIN, 1024, 1024, 512, W1T, 2048, 1024, 0, L.n_mix, scr, lane)) continue;
        if (seg_item(r, L.w_in, DIN, 1024, 2048, 512, W1T, 2560, 1024, 0, L.n_mix, scr, lane)) continue;
        if (seg_item(r, L.w_in, DIN, 1024, 2560, 512, W1T, 3072, 1024, 0, L.n_mix, scr, lane)) continue;
        if (seg_item(r, L.w_in, DIN, 1024, 3488, 3072, WGT, 0,   1024, 0, L.n_mix, scr, lane)) continue;
        if (seg_item(r, L.uq,  768,  256, 0, 768,  WQKV, 0,   384, 0,   nullptr, scr, lane)) continue;
        if (seg_item(r, L.ukv, 1024, 128, 0, 1024, WQKV, 768, 384, 256, nullptr, scr, lane)) continue;
        if (seg_item(r, L.wb,                     1024, 512, 0, 1024, WBT, 0,    512, 0, nullptr, scr, lane)) continue;
        if (seg_item(r, L.wb + (size_t)512 * 1024, 1024, 512, 0, 1024, WBT, 1024, 512, 0, nullptr, scr, lane)) continue;
        if (seg_item(r, L.wb + (size_t)1024 * 1024, 1024, 512, 0, 1024, WBT, 2048, 512, 0, nullptr, scr, lane)) continue;
        if (seg_item(r, L.wo,  1024, 1024, 0, 1024, WOT,  0, 1024, 0, nullptr, scr, lane)) continue;
        if (seg_item(r, L.wup, 4096, 1024, 0, 4096, WUPT, 0, 1024, 0, L.n_mlp, scr, lane)) continue;
        if (seg_item(r, L.wdn, 1024, 4096, 0, 1024, WDNT, 0, 4096, 0, nullptr, scr, lane)) continue;
        if (r < N_Z1) { zero_item(W1T, 1440 + 32 * (r % 3), 1024, 64 * (r / 3), lane); continue; } r -= N_Z1;
        if (r < N_Z2) { zero_item(WQKV, 32 * (r % 24), 384, 256 + 64 * (r / 24), lane); continue; } r -= N_Z2;
        { const int kb = r / 32; zero_item(WQKV, 768 + 32 * (r % 32), 384, 64 * kb, lane); }
    }
}
__device__ __forceinline__ void norm_row_bf16(const float* xrow, const float* w, bf16* orow, int lane) {
    const f32x4* xr = (const f32x4*)xrow + lane; const f32x4* wr = (const f32x4*)w + lane;
    f32x4 v[4]; float s = 0.f;
#pragma unroll
    for (int j = 0; j < 4; ++j) { v[j] = xr[64 * j]; s += (v[j].x * v[j].x + v[j].y * v[j].y) + (v[j].z * v[j].z + v[j].w * v[j].w); }
    const float rstd = 1.f / sqrtf(wave_sum(s, lane) * (1.f / 1024.f) + RMS_EPS);
    v2u* o8 = (v2u*)orow + lane;
#pragma unroll
    for (int j = 0; j < 4; ++j) { const f32x4 ww = wr[64 * j]; v2u o; o.x = pk2(v[j].x * rstd * ww.x, v[j].y * rstd * ww.y); o.y = pk2(v[j].z * rstd * ww.z, v[j].w * rstd * ww.w); o8[64 * j] = o; }
}
__device__ __forceinline__ void resid_row(const float* yrow, const float* xold, float* xout, const float* wpost, const float* wnext, bf16* hout, int lane) {
    const f32x4* yr = (const f32x4*)yrow + lane; const f32x4* xr = (const f32x4*)xold + lane; const f32x4* wp = (const f32x4*)wpost + lane;
    f32x4 y[4], x[4]; float s = 0.f;
#pragma unroll
    for (int j = 0; j < 4; ++j) { y[j] = yr[64 * j]; x[j] = xr[64 * j]; s += (y[j].x * y[j].x + y[j].y * y[j].y) + (y[j].z * y[j].z + y[j].w * y[j].w); }
    const float r1 = 1.f / sqrtf(wave_sum(s, lane) * (1.f / 1024.f) + RMS_EPS);
    float s2 = 0.f; f32x4* xo = (f32x4*)xout + lane;
#pragma unroll
    for (int j = 0; j < 4; ++j) { const f32x4 ww = wp[64 * j]; x[j] = x[j] + y[j] * r1 * ww; xo[64 * j] = x[j]; s2 += (x[j].x * x[j].x + x[j].y * x[j].y) + (x[j].z * x[j].z + x[j].w * x[j].w); }
    if (wnext) {
        const float r2 = 1.f / sqrtf(wave_sum(s2, lane) * (1.f / 1024.f) + RMS_EPS);
        const f32x4* wn = (const f32x4*)wnext + lane; v2u* o8 = (v2u*)hout + lane;
#pragma unroll
        for (int j = 0; j < 4; ++j) { const f32x4 ww = wn[64 * j]; v2u o; o.x = pk2(x[j].x * r2 * ww.x, x[j].y * r2 * ww.y); o.y = pk2(x[j].z * r2 * ww.z, x[j].w * r2 * ww.w); o8[64 * j] = o; }
    }
}
__device__ __forceinline__ void cast_row_rs(const float* xrow, bf16* orow, float* rs, int lane) {
    const f32x4* xr = (const f32x4*)xrow + lane; f32x4 v[4]; float s = 0.f;
#pragma unroll
    for (int j = 0; j < 4; ++j) { v[j] = xr[64 * j]; s += (v[j].x * v[j].x + v[j].y * v[j].y) + (v[j].z * v[j].z + v[j].w * v[j].w); }
    const float rstd = 1.f / sqrtf(wave_sum(s, lane) * (1.f / 1024.f) + RMS_EPS);
    v2u* o8 = (v2u*)orow + lane;
#pragma unroll
    for (int j = 0; j < 4; ++j) { v2u o; o.x = pk2(v[j].x, v[j].y); o.y = pk2(v[j].z, v[j].w); o8[64 * j] = o; }
    if (lane == 0) *rs = rstd;
}
template <int NR>
__device__ __forceinline__ void cast_rows_rs(const float* xrow0, bf16* orow0, float* rs0, int lane) {
    f32x4 v[NR][4]; float s[NR];
#pragma unroll
    for (int r = 0; r < NR; ++r)
#pragma unroll
        for (int j = 0; j < 4; ++j) v[r][j] = ((const f32x4*)(xrow0 + (size_t)r * DM) + lane)[64 * j];
#pragma unroll
    for (int r = 0; r < NR; ++r) { s[r] = 0.f;
#pragma unroll
        for (int j = 0; j < 4; ++j) s[r] += (v[r][j].x * v[r][j].x + v[r][j].y * v[r][j].y) + (v[r][j].z * v[r][j].z + v[r][j].w * v[r][j].w); }
#pragma unroll
    for (int o = 1; o < 64; o <<= 1) { float t[NR];
#pragma unroll
        for (int r = 0; r < NR; ++r) t[r] = shfl_xor_l(s[r], o, lane);
#pragma unroll
        for (int r = 0; r < NR; ++r) s[r] += t[r]; }
#pragma unroll
    for (int r = 0; r < NR; ++r) { v2u* o8 = (v2u*)(orow0 + (size_t)r * DM) + lane;
#pragma unroll
        for (int j = 0; j < 4; ++j) { v2u o; o.x = pk2(v[r][j].x, v[r][j].y); o.y = pk2(v[r][j].z, v[r][j].w); o8[64 * j] = o; }
        if (lane == 0) rs0[r] = 1.f / sqrtf(s[r] * (1.f / 1024.f) + RMS_EPS); }
}
template <bool XIN_F32, bool XOUT_F32>
__device__ __forceinline__ void resid_row2(const bf16* yrow, const void* xold_, void* xout_, const float* wpost, float* rsout, int lane) {
    const f32x4* wp = (const f32x4*)wpost + lane;
    f32x4 y[2][4], x[2][4]; float s[2] = {0.f, 0.f};
#pragma unroll
    for (int r = 0; r < 2; ++r) { const v2u* yr = (const v2u*)(yrow + r * DM) + lane;
#pragma unroll
        for (int j = 0; j < 4; ++j) { const v2u yw = yr[64 * j]; y[r][j] = (f32x4){bflo(yw.x), bfhi(yw.x), bflo(yw.y), bfhi(yw.y)};
            if constexpr (XIN_F32) x[r][j] = ((const f32x4*)((const float*)xold_ + r * DM) + lane)[64 * j];
            else { const v2u xw = ((const v2u*)((const bf16*)xold_ + r * DM) + lane)[64 * j]; x[r][j] = (f32x4){bflo(xw.x), bfhi(xw.x), bflo(xw.y), bfhi(xw.y)}; } } }
#pragma unroll
    for (int r = 0; r < 2; ++r)
#pragma unroll
        for (int j = 0; j < 4; ++j) s[r] += (y[r][j].x * y[r][j].x + y[r][j].y * y[r][j].y) + (y[r][j].z * y[r][j].z + y[r][j].w * y[r][j].w);
#pragma unroll
    for (int o = 1; o < 64; o <<= 1) { const float a = shfl_xor_l(s[0], o, lane), b = shfl_xor_l(s[1], o, lane); s[0] += a; s[1] += b; }
    float s2[2] = {0.f, 0.f};
#pragma unroll
    for (int r = 0; r < 2; ++r) { const float r1 = 1.f / sqrtf(s[r] * (1.f / 1024.f) + RMS_EPS);
#pragma unroll
        for (int j = 0; j < 4; ++j) { const f32x4 ww = wp[64 * j]; x[r][j] = x[r][j] + y[r][j] * r1 * ww;
            if constexpr (XOUT_F32) ((f32x4*)((float*)xout_ + r * DM) + lane)[64 * j] = x[r][j];
            else { v2u o; o.x = pk2(x[r][j].x, x[r][j].y); o.y = pk2(x[r][j].z, x[r][j].w); ((v2u*)((bf16*)xout_ + r * DM) + lane)[64 * j] = o;
                   x[r][j] = (f32x4){bflo(o.x), bfhi(o.x), bflo(o.y), bfhi(o.y)}; }     s2[r] += (x[r][j].x * x[r][j].x + x[r][j].y * x[r][j].y) + (x[r][j].z * x[r][j].z + x[r][j].w * x[r][j].w); } }
    if (rsout) {
#pragma unroll
        for (int o = 1; o < 64; o <<= 1) { const float a = shfl_xor_l(s2[0], o, lane), b = shfl_xor_l(s2[1], o, lane); s2[0] += a; s2[1] += b; }
        if (lane == 0) { rsout[0] = 1.f / sqrtf(s2[0] * (1.f / 1024.f) + RMS_EPS); rsout[1] = 1.f / sqrtf(s2[1] * (1.f / 1024.f) + RMS_EPS); }
    }
}
__device__ __forceinline__ void mla_prep_row(bf16* p3row, bf16* krrow, const float* qn, const float* kvn, const f32x2_t* rope16, int lane) {
    const v4u raw = *((const v4u*)p3row + lane);
    float x[8] = {bflo(raw.x), bfhi(raw.x), bflo(raw.y), bfhi(raw.y), bflo(raw.z), bfhi(raw.z), bflo(raw.w), bfhi(raw.w)};
    float ss = 0.f;
#pragma unroll
    for (int j = 0; j < 8; ++j) ss += x[j] * x[j];
    const float sq = wave_sum(lane < 32 ? ss : 0.f, lane), skv = wave_sum((lane >= 32 && lane < 48) ? ss : 0.f, lane);
    const float rq = 1.f / sqrtf(sq * (1.f / 256.f) + RMS_EPS), rkv = 1.f / sqrtf(skv * (1.f / 128.f) + RMS_EPS);
    if (lane < 48) {
        const float r = lane < 32 ? rq : rkv; const float* wv = lane < 32 ? qn + 8 * lane : kvn + 8 * (lane - 32);
        const f32x4 w0 = *(const f32x4*)wv, w1 = *(const f32x4*)(wv + 4);
        v4u o; o.x = pk2(x[0] * r * w0.x, x[1] * r * w0.y); o.y = pk2(x[2] * r * w0.z, x[3] * r * w0.w); o.z = pk2(x[4] * r * w1.x, x[5] * r * w1.y); o.w = pk2(x[6] * r * w1.z, x[7] * r * w1.w);
        *((v4u*)p3row + lane) = o;
    }
    float part[8];
#pragma unroll
    for (int j = 0; j < 8; ++j) part[j] = shfl_xor_l(x[j], 2, lane);
    if (lane >= 48 && lane < 52) {
        const bool first = lane < 50; float y[8];
#pragma unroll
        for (int j = 0; j < 8; ++j) { const f32x2_t r_ = rope16[8 * (lane & 1) + j]; const float cs = r_.x, sn = r_.y;
            y[j] = first ? (x[j] * cs - part[j] * sn) : (x[j] * cs + part[j] * sn); }
        v4u o; o.x = pk2(y[0], y[1]); o.y = pk2(y[2], y[3]); o.z = pk2(y[4], y[5]); o.w = pk2(y[6], y[7]);
        *((v4u*)krrow + (lane - 48)) = o;
    }
}
template <int NR>
__device__ __forceinline__ void mla_prep_rows(bf16* p3row0, bf16* krrow0, const float* qn, const float* kvn, const f32x2_t* rope0, int lane) {
    v4u raw[NR]; f32x2_t rc[NR][8];
#pragma unroll
    for (int r = 0; r < NR; ++r) raw[r] = *((const v4u*)(p3row0 + (size_t)r * 512) + lane);
    const bool rl = (lane >= 48 && lane < 52);
    if (rl) {
#pragma unroll
        for (int r = 0; r < NR; ++r)
#pragma unroll
            for (int j = 0; j < 8; ++j) rc[r][j] = rope0[(size_t)r * 16 + 8 * (lane & 1) + j];
    }
    float x[NR][8], sq[NR], skv[NR];
#pragma unroll
    for (int r = 0; r < NR; ++r) { x[r][0] = bflo(raw[r].x); x[r][1] = bfhi(raw[r].x); x[r][2] = bflo(raw[r].y); x[r][3] = bfhi(raw[r].y); x[r][4] = bflo(raw[r].z); x[r][5] = bfhi(raw[r].z); x[r][6] = bflo(raw[r].w); x[r][7] = bfhi(raw[r].w);
        float ss = 0.f;
#pragma unroll
        for (int j = 0; j < 8; ++j) ss += x[r][j] * x[r][j];
        sq[r] = lane < 32 ? ss : 0.f; skv[r] = (lane >= 32 && lane < 48) ? ss : 0.f; }
#pragma unroll
    for (int o = 1; o < 64; o <<= 1) {
        float a[NR], b[NR];
#pragma unroll
        for (int r = 0; r < NR; ++r) { a[r] = shfl_xor_l(sq[r], o, lane); b[r] = shfl_xor_l(skv[r], o, lane); }
#pragma unroll
        for (int r = 0; r < NR; ++r) { sq[r] += a[r]; skv[r] += b[r]; }
    }
    const float* wv = lane < 32 ? qn + 8 * lane : kvn + 8 * ((lane - 32) & 15);
    const f32x4 w0 = *(const f32x4*)wv, w1 = *(const f32x4*)(wv + 4);
#pragma unroll
    for (int r = 0; r < NR; ++r) {
        const float rq = 1.f / sqrtf(sq[r] * (1.f / 256.f) + RMS_EPS), rkv = 1.f / sqrtf(skv[r] * (1.f / 128.f) + RMS_EPS);
        float part[8];
#pragma unroll
        for (int j = 0; j < 8; ++j) part[j] = shfl_xor_l(x[r][j], 2, lane);
        if (lane < 48) {
            const float rr = lane < 32 ? rq : rkv;
            v4u o; o.x = pk2(x[r][0] * rr * w0.x, x[r][1] * rr * w0.y); o.y = pk2(x[r][2] * rr * w0.z, x[r][3] * rr * w0.w); o.z = pk2(x[r][4] * rr * w1.x, x[r][5] * rr * w1.y); o.w = pk2(x[r][6] * rr * w1.z, x[r][7] * rr * w1.w);
            *((v4u*)(p3row0 + (size_t)r * 512) + lane) = o;
        }
        if (rl) {
            const bool first = lane < 50; float y[8];
#pragma unroll
            for (int j = 0; j < 8; ++j) { const float cs = rc[r][j].x, sn = rc[r][j].y; y[j] = first ? (x[r][j] * cs - part[j] * sn) : (x[r][j] * cs + part[j] * sn); }
            v4u o; o.x = pk2(y[0], y[1]); o.y = pk2(y[2], y[3]); o.z = pk2(y[4], y[5]); o.w = pk2(y[6], y[7]);
            *((v4u*)(krrow0 + (size_t)r * 32) + (lane - 48)) = o;
        }
    }
}
__device__ __forceinline__ void kmean_task(const bf16* MK, float* kmean, int b, int n, int half, LAS float* scr, int tid) {
    const int wave = tid >> 6, lane = tid & 63, hw = lane >> 5, cl = lane & 31, strm = wave * 2 + hw;
    float acc[8] = {0.f, 0.f, 0.f, 0.f, 0.f, 0.f, 0.f, 0.f};
    const bf16* base = MK + ((size_t)b * SEQ + (size_t)n * 256 + strm * 16) * 512 + half * 256 + cl * 8;
#pragma unroll
    for (int r = 0; r < 16; ++r) { const v4u w = *(const v4u*)(base + (size_t)r * 512);
        acc[0] += bflo(w.x); acc[1] += bfhi(w.x); acc[2] += bflo(w.y); acc[3] += bfhi(w.y); acc[4] += bflo(w.z); acc[5] += bfhi(w.z); acc[6] += bflo(w.w); acc[7] += bfhi(w.w); }
#pragma unroll
    for (int j = 0; j < 8; ++j) scr[strm * 256 + cl * 8 + j] = acc[j];
    __syncthreads();
    if (tid < 256) { float s = 0.f;
#pragma unroll
        for (int w = 0; w < 16; ++w) s += scr[w * 256 + tid];
        const int col = half * 256 + tid, h = col >> 7, d = col & 127;
        kmean[(((size_t)b * 4 + h) * 32 + n) * 128 + d] = s * (1.f / 256.f); }
    __syncthreads();
}
__device__ __forceinline__ void diff_combine_row(const bf16* o12row, bf16* oarow, const float* subln, float lam, float oscale, int lane) {
    const int h = lane >> 4, dc = lane & 15;
    const v4u a = *(const v4u*)(o12row + h * 256 + dc * 8), b = *(const v4u*)(o12row + h * 256 + 128 + dc * 8);
    float d[8] = {bflo(a.x) - lam * bflo(b.x), bfhi(a.x) - lam * bfhi(b.x), bflo(a.y) - lam * bflo(b.y), bfhi(a.y) - lam * bfhi(b.y),
                  bflo(a.z) - lam * bflo(b.z), bfhi(a.z) - lam * bfhi(b.z), bflo(a.w) - lam * bflo(b.w), bfhi(a.w) - lam * bfhi(b.w)};
    float ss = 0.f;
#pragma unroll
    for (int j = 0; j < 8; ++j) ss += d[j] * d[j];
#pragma unroll
    for (int o = 1; o < 16; o <<= 1) ss += shfl_xor_l(ss, o, lane);
    const float r = oscale / sqrtf(ss * (1.f / 128.f) + RMS_EPS);
    const f32x4 w0 = *(const f32x4*)(subln + dc * 8), w1 = *(const f32x4*)(subln + dc * 8 + 4);
    v4u o; o.x = pk2(d[0] * r * w0.x, d[1] * r * w0.y); o.y = pk2(d[2] * r * w0.z, d[3] * r * w0.w); o.z = pk2(d[4] * r * w1.x, d[5] * r * w1.y); o.w = pk2(d[6] * r * w1.z, d[7] * r * w1.w);
    *(v4u*)(oarow + h * 128 + dc * 8) = o;
}

__device__ __forceinline__ int crow(int r, int hi) { return (r & 3) + 8 * (r >> 2) + 4 * hi; }
__device__ __forceinline__ int t5_bucket(int n) {
    if (n < 16) return n;
    return 16 + (n >= 21) + (n >= 27) + (n >= 35) + (n >= 46) + (n >= 59) + (n >= 77) + (n >= 99) + (n >= 128) + (n >= 166) + (n >= 216) + (n >= 280) + (n >= 363) + (n >= 470) + (n >= 609) + (n >= 790);
}
constexpr float LOG2E = 1.4426950408889634f;
constexpr float NEGBIG = -3.0e38f, M_INIT = -1.0e30f;
enum { MODE_MLA = 0, MODE_DIFF = 1, MODE_MOBA = 2 };
struct AttnArgs {
    const bf16* q; int ldq;
    const bf16* k; int ldk;
    const bf16* k2;
    const bf16* v; int ldv;
    bf16* o; int ldo;
    int qb;
    float C;
    const float* bias;
    const f32x2_t* rope;
    const float* kmean;
};
template <int MODE> struct AttnCfg {
    static constexpr int DQK = MODE == MODE_MLA ? 96 : (MODE == MODE_DIFF ? 64 : 128);
    static constexpr int DV = MODE == MODE_MLA ? 64 : 128;
    static constexpr int PK = DQK * 2 + 16, PV = DV * 2 + 64;
    static constexpr int KB = 64 * PK, VB = 64 * PV;
    static constexpr int KCH = DQK / 8, VCH = DV / 8;
    static constexpr int NKC = 64 * KCH, NVC = 64 * VCH;
    static constexpr int KPT = (NKC + 511) / 512, VPT = (NVC + 511) / 512;
    static constexpr int NS = DQK / 16, ND = DV / 32;
};

template <int MODE>
__device__ __forceinline__ void attn_unit(LAS unsigned char* lds, const AttnArgs& a, int wave_s) {
    using C_ = AttnCfg<MODE>;
    constexpr int PK = C_::PK, PV = C_::PV, KB = C_::KB, VB = C_::VB, KCH = C_::KCH, VCH = C_::VCH, NKC = C_::NKC, KPT = C_::KPT, VPT = C_::VPT, NS = C_::NS, ND = C_::ND;
    constexpr float THR = 10.f;
    const int tid = opaque_tid(wave_s), wid = __builtin_amdgcn_readfirstlane(tid >> 6), lane = tid & 63, r32 = lane & 31, hi = lane >> 5;
    const int q0w = a.qb * 256 + wid * 32, qrow = q0w + r32;
    const int NT = 4 * (a.qb + 1);
    LAS float* tab = (LAS float*)(lds + A_TAB);
    LAS float* wscr = (LAS float*)(lds + A_WSCR + wid * 256);
    LAS unsigned* slot = (LAS unsigned*)(lds + A_SLOT);
    bf16x8 qr[NS];
#pragma unroll
    for (int s = 0; s < NS; ++s) qr[s] = *(const bf16x8*)(a.q + (size_t)qrow * a.ldq + 16 * s + 8 * hi);
    if constexpr (MODE == MODE_MLA) {
        const f32x2_t* rp_ = a.rope + (size_t)qrow * 16 + 8 * hi;
#pragma unroll
        for (int j = 0; j < 8; ++j) { const f32x2_t r_ = rp_[j]; const float cs = r_.x, sn = r_.y; const float x1 = bf2f(qr[4][j]), x2 = bf2f(qr[5][j]);
            qr[4][j] = (short)f2bf((x1 * cs - x2 * sn) * a.C); qr[5][j] = (short)f2bf((x2 * cs + x1 * sn) * a.C); }
#pragma unroll
        for (int s = 0; s < 4; ++s)
#pragma unroll
            for (int j = 0; j < 8; ++j) qr[s][j] = (short)f2bf(bf2f(qr[s][j]) * a.C);
    } else {
#pragma unroll
        for (int s = 0; s < NS; ++s)
#pragma unroll
            for (int j = 0; j < 8; ++j) qr[s][j] = (short)f2bf(bf2f(qr[s][j]) * a.C);
    }
    if constexpr (MODE != MODE_MLA) {
        for (int i = tid; i < 1024; i += 512) tab[i] = a.bias[t5_bucket(i) * 8] * LOG2E;
    }
    unsigned mask = 0xffffffffu, umask = 0xffffffffu, wmask = 0xffffffffu;
    if constexpr (MODE == MODE_MOBA) {
        LAS float* km = (LAS float*)(lds + A_KMEAN);
        { const f32x4* src = (const f32x4*)a.kmean + tid * 2; *((LAS f32x4*)km + tid * 2) = src[0]; *((LAS f32x4*)km + tid * 2 + 1) = src[1]; }
        if (tid < 9) slot[8 + tid] = 0u;
        __syncthreads();
        const int own = a.qb;
        float v0 = NEGBIG, v1 = NEGBIG, v2 = NEGBIG; int i0 = 32, i1 = 32, i2 = 32;
        for (int n = 0; n < own; ++n) {
            float g = 0.f;
#pragma unroll
            for (int s = 0; s < NS; ++s) { const f32x4 ka = *(const LAS f32x4*)(km + n * 128 + 16 * s + 8 * hi), kb = *(const LAS f32x4*)(km + n * 128 + 16 * s + 8 * hi + 4);
                g += bf2f(qr[s][0]) * ka.x + bf2f(qr[s][1]) * ka.y + bf2f(qr[s][2]) * ka.z + bf2f(qr[s][3]) * ka.w + bf2f(qr[s][4]) * kb.x + bf2f(qr[s][5]) * kb.y + bf2f(qr[s][6]) * kb.z + bf2f(qr[s][7]) * kb.w; }
            { auto rr = __builtin_amdgcn_permlane32_swap(__float_as_uint(g), __float_as_uint(g), false, false); g = __uint_as_float(rr[0]) + __uint_as_float(rr[1]); }
            if (g > v0) { v2 = v1; i2 = i1; v1 = v0; i1 = i0; v0 = g; i0 = n; }
            else if (g > v1) { v2 = v1; i2 = i1; v1 = g; i1 = n; }
            else if (g > v2) { v2 = g; i2 = n; }
        }
        mask = (1u << own) | (i0 < 32 ? (1u << i0) : 0u) | (i1 < 32 ? (1u << i1) : 0u) | (i2 < 32 ? (1u << i2) : 0u);
        __hip_atomic_fetch_or(slot + 8 + wid, mask, __ATOMIC_RELAXED, __HIP_MEMORY_SCOPE_WORKGROUP);
        __hip_atomic_fetch_or(slot + 16, mask, __ATOMIC_RELAXED, __HIP_MEMORY_SCOPE_WORKGROUP);
        __syncthreads();
        umask = slot[16]; wmask = slot[8 + wid];
        umask = __builtin_amdgcn_readfirstlane(umask); wmask = __builtin_amdgcn_readfirstlane(wmask);
    }
    bf16x8 kst[KPT], vst[VPT];
    unsigned kofs[KPT], vofs[VPT]; [[maybe_unused]] unsigned kstr[KPT];
#pragma unroll
    for (int i = 0; i < KPT; ++i) { const int id = tid + 512 * i; const int row = id / KCH, ch = id % KCH;
        if (MODE == MODE_MLA && ch >= 8) { kofs[i] = (unsigned)((const char*)a.k2 - (const char*)a.k) + row * 64 + (ch - 8) * 16; kstr[i] = 64 * 64; }
        else { kofs[i] = (unsigned)(row * a.ldk * 2 + ch * 16); kstr[i] = (unsigned)(64 * a.ldk * 2); } }
#pragma unroll
    for (int i = 0; i < VPT; ++i) { const int id = tid + 512 * i; const int row = id / VCH, ch = id % VCH; vofs[i] = (unsigned)(row * a.ldv * 2 + ch * 16); }
    auto load_k = [&](int j) {
#pragma unroll
        for (int i = 0; i < KPT; ++i) { const int id = tid + 512 * i;
            if ((NKC % 512 == 0) || id < NKC) {
                if constexpr (MODE == MODE_MLA) kst[i] = *(const bf16x8*)((const char*)a.k + (kofs[i] + __umul24((unsigned)j, kstr[i])));
                else kst[i] = *(const bf16x8*)((const char*)a.k + (size_t)j * (size_t)(64 * a.ldk * 2) + kofs[i]); } }
    };
    auto load_v = [&](int j) {
#pragma unroll
        for (int i = 0; i < VPT; ++i) vst[i] = *(const bf16x8*)((const char*)a.v + (size_t)j * (size_t)(64 * a.ldv * 2) + vofs[i]);
    };
    auto write_k = [&](int kb_) {
#pragma unroll
        for (int i = 0; i < KPT; ++i) { const int id = tid + 512 * i;
            if ((NKC % 512 == 0) || id < NKC) { const int row = id / KCH, ch = id % KCH; *(LAS bf16x8*)(lds + A_KOFF + kb_ * KB + row * PK + ch * 16) = kst[i]; } }
    };
    auto write_v = [&](int vb_) {
#pragma unroll
        for (int i = 0; i < VPT; ++i) { const int id = tid + 512 * i; const int row = id / VCH, ch = id % VCH; *(LAS bf16x8*)(lds + A_VOFF + vb_ * VB + row * PV + ch * 16) = vst[i]; }
    };
    auto next_tile = [&](int j) -> int {
        int jn = j + 1;
        if constexpr (MODE == MODE_MOBA) { while (jn < NT && !((umask >> (jn >> 2)) & 1u)) jn = (jn & ~3) + 4; }
        return jn;
    };
    auto need_tile = [&](int j) -> bool {
        bool need = (64 * j <= q0w + 31);
        if constexpr (MODE == MODE_MOBA) need = need && ((wmask >> (j >> 2)) & 1u);
        return need;
    };
    f32x16 o[ND];
#pragma unroll
    for (int d = 0; d < ND; ++d) o[d] = (f32x16){};
    float m_run = M_INIT, l_run = 0.f;
    const int kbase = r32 * PK + 16 * hi;
    int vbase = (8 * hi + ((lane >> 2) & 3)) * PV + (16 * ((lane >> 4) & 1) + 4 * (lane & 3)) * 2;
    auto partialSM = [&](f32x16& p0, f32x16& p1, int j, float& off, float& al) {
        const int k0 = 64 * j, relq = qrow - k0, relmin = q0w - k0 - 63;
        const bool fast = (MODE == MODE_MLA) ? (relmin >= 0) : (relmin >= 790);
        float cb = 0.f;
        if (fast) { if constexpr (MODE != MODE_MLA) cb = tab[1023]; }
        else if ((MODE != MODE_MLA) && relmin >= 0) {
            const LAS float* tb = tab + (relq - 4 * hi - 59);
#pragma unroll
            for (int r = 0; r < 16; ++r) { const int c_ = (r & 3) + 8 * (r >> 2); p0[r] += tb[59 - c_]; p1[r] += tb[27 - c_]; }
        } else {
#pragma unroll
            for (int r = 0; r < 16; ++r) { const int rel0 = relq - crow(r, hi), rel1 = rel0 - 32;
                float t0 = p0[r], t1 = p1[r];
                if constexpr (MODE != MODE_MLA) { t0 += tab[min(max(rel0, 0), 1023)]; t1 += tab[min(max(rel1, 0), 1023)]; }
                p0[r] = rel0 < 0 ? NEGBIG : t0; p1[r] = rel1 < 0 ? NEGBIG : t1;
                if ((r & 3) == 3) __builtin_amdgcn_sched_barrier(0); }
        }
        if constexpr (MODE == MODE_MOBA) {
            const bool allowed = (mask >> (j >> 2)) & 1u;
#pragma unroll
            for (int r = 0; r < 16; ++r) { p0[r] = allowed ? p0[r] : NEGBIG; p1[r] = allowed ? p1[r] : NEGBIG; }
        }
        float pm = fmaxf(p0[0], p1[0]);
#pragma unroll
        for (int r = 1; r < 16; ++r) pm = fmaxf(fmaxf(pm, p0[r]), p1[r]);
        { auto rr = __builtin_amdgcn_permlane32_swap(__float_as_uint(pm), __float_as_uint(pm), false, false); pm = fmaxf(__uint_as_float(rr[0]), __uint_as_float(rr[1])); }
        pm += cb;
        if (__all(pm - m_run <= THR)) al = 1.f;
        else { const float mn = fmaxf(m_run, pm); al = __builtin_amdgcn_exp2f(m_run - mn); m_run = mn; }
        off = cb - m_run;
#pragma unroll
        for (int r = 0; r < 16; ++r) p0[r] = __builtin_amdgcn_exp2f(p0[r] + off);
    };
    auto lane_now = [&]() -> int { int ln; asm volatile("v_mbcnt_lo_u32_b32 %0, -1, 0\n\tv_mbcnt_hi_u32_b32 %0, -1, %0" : "=v"(ln)); return ln; };
    constexpr bool LSUM = (MODE == MODE_MLA);
    f32x16 ol = (f32x16){};
    auto rescale = [&](float al) {
        if (!__all(al == 1.f)) {
            const int ln = lane_now();
            LAS float* ws_ = (LAS float*)(lds + A_WSCR + wid * 256);
            if (ln < 32) ws_[ln] = al;
            LDS_WAIT();
#pragma unroll
            for (int g = 0; g < 4; ++g) { const f32x4 a4 = *(const LAS f32x4*)(ws_ + 8 * g + 4 * (ln >> 5));
#pragma unroll
                for (int d = 0; d < ND; ++d) { o[d][4 * g + 0] *= a4.x; o[d][4 * g + 1] *= a4.y; o[d][4 * g + 2] *= a4.z; o[d][4 * g + 3] *= a4.w; }
                if constexpr (LSUM) { ol[4 * g + 0] *= a4.x; ol[4 * g + 1] *= a4.y; ol[4 * g + 2] *= a4.z; ol[4 * g + 3] *= a4.w; } }
        }
    };
    auto finishSM = [&](f32x16& p0, f32x16& p1, float off, float al, bf16x8 (&pa)[4]) {
        if constexpr (LSUM) {
#pragma unroll
            for (int r = 0; r < 16; ++r) p1[r] = __builtin_amdgcn_exp2f(p1[r] + off);
        } else {
        float ps = 0.f;
#pragma unroll
        for (int r = 0; r < 16; ++r) { p1[r] = __builtin_amdgcn_exp2f(p1[r] + off); ps += p0[r] + p1[r]; }
        { auto rr = __builtin_amdgcn_permlane32_swap(__float_as_uint(ps), __float_as_uint(ps), false, false); ps = __uint_as_float(rr[0]) + __uint_as_float(rr[1]); }
        l_run = l_run * al + ps; }
#define PK4(P, BASE, OUT) do { const unsigned a0_ = cvtpk_s(P[BASE + 0], P[BASE + 1]), a1_ = cvtpk_s(P[BASE + 2], P[BASE + 3]);   \
    const unsigned b0_ = cvtpk_s(P[BASE + 4], P[BASE + 5]), b1_ = cvtpk_s(P[BASE + 6], P[BASE + 7]);                              \
    auto r0_ = __builtin_amdgcn_permlane32_swap(a0_, b0_, false, false); auto r1_ = __builtin_amdgcn_permlane32_swap(a1_, b1_, false, false); \
    v4u w_ = {r0_[0], r1_[0], r0_[1], r1_[1]}; OUT = __builtin_bit_cast(bf16x8, w_); } while (0)
        PK4(p0, 0, pa[0]); PK4(p0, 8, pa[1]); PK4(p1, 0, pa[2]); PK4(p1, 8, pa[3]);
#undef PK4
    };
    constexpr int NQ = NS / 2, NG = NQ + ND;
    f32x16 p0, p1; bf16x8 pa[4];
    auto load_grp = [&](int g, bf16x8 (&f)[4], int kb_, int vb_) {
        if (g >= ND) { const LAS unsigned char* Ks = lds + A_KOFF + kb_ * KB + kbase + 64 * (g - ND);
            f[0] = *(const LAS bf16x8*)(Ks); f[1] = *(const LAS bf16x8*)(Ks + 32 * PK); f[2] = *(const LAS bf16x8*)(Ks + 32); f[3] = *(const LAS bf16x8*)(Ks + 32 * PK + 32); }
        else { const LAS unsigned char* Vs = lds + A_VOFF + vb_ * VB + vbase + g * 64;
#pragma unroll
            for (int ks = 0; ks < 4; ++ks) {
                const s16x4 lo = __builtin_bit_cast(s16x4, __builtin_amdgcn_ds_read_tr16_b64_v4i16((LAS v4i16_t*)(Vs + ks * 16 * PV)));
                const s16x4 h4 = __builtin_bit_cast(s16x4, __builtin_amdgcn_ds_read_tr16_b64_v4i16((LAS v4i16_t*)(Vs + ks * 16 * PV + 4 * PV)));
                f[ks] = (bf16x8){lo[0], lo[1], lo[2], lo[3], h4[0], h4[1], h4[2], h4[3]}; } }
    };
    auto mfma_grp = [&](int g, const bf16x8 (&f)[4]) {
        if (g >= ND) { const int q_ = g - ND;
            if (q_ == 0) { p0 = __builtin_amdgcn_mfma_f32_32x32x16_bf16(f[0], qr[0], (f32x16){}, 0, 0, 0); p1 = __builtin_amdgcn_mfma_f32_32x32x16_bf16(f[1], qr[0], (f32x16){}, 0, 0, 0); }
            else { p0 = __builtin_amdgcn_mfma_f32_32x32x16_bf16(f[0], qr[2 * q_], p0, 0, 0, 0); p1 = __builtin_amdgcn_mfma_f32_32x32x16_bf16(f[1], qr[2 * q_], p1, 0, 0, 0); }
            p0 = __builtin_amdgcn_mfma_f32_32x32x16_bf16(f[2], qr[2 * q_ + 1], p0, 0, 0, 0); p1 = __builtin_amdgcn_mfma_f32_32x32x16_bf16(f[3], qr[2 * q_ + 1], p1, 0, 0, 0);
        } else {
#pragma unroll
            for (int ks = 0; ks < 4; ++ks) o[g] = __builtin_amdgcn_mfma_f32_32x32x16_bf16(pa[ks], f[ks], o[g], 0, 0, 0);
            if constexpr (LSUM) { if (g == ND - 1) { const bf16x8 ones = {(short)0x3f80, (short)0x3f80, (short)0x3f80, (short)0x3f80, (short)0x3f80, (short)0x3f80, (short)0x3f80, (short)0x3f80};
#pragma unroll
                for (int ks = 0; ks < 4; ++ks) ol = __builtin_amdgcn_mfma_f32_32x32x16_bf16(pa[ks], ones, ol, 0, 0, 0); } }
        }
    };
    auto half_grp = [&](int g, int h_, int kb_, int vb_) {
        if (g >= ND) { const int s_ = 2 * (g - ND) + h_; const LAS unsigned char* Ks = lds + A_KOFF + kb_ * KB + kbase + 32 * s_;
            const bf16x8 b0 = *(const LAS bf16x8*)(Ks), b1 = *(const LAS bf16x8*)(Ks + 32 * PK);
            if (s_ == 0) { p0 = __builtin_amdgcn_mfma_f32_32x32x16_bf16(b0, qr[0], (f32x16){}, 0, 0, 0); p1 = __builtin_amdgcn_mfma_f32_32x32x16_bf16(b1, qr[0], (f32x16){}, 0, 0, 0); }
            else { p0 = __builtin_amdgcn_mfma_f32_32x32x16_bf16(b0, qr[s_], p0, 0, 0, 0); p1 = __builtin_amdgcn_mfma_f32_32x32x16_bf16(b1, qr[s_], p1, 0, 0, 0); } }
        else { const LAS unsigned char* Vs = lds + A_VOFF + vb_ * VB + vbase + g * 64;
#pragma unroll
            for (int k2 = 0; k2 < 2; ++k2) { const int ks = 2 * h_ + k2;
                const s16x4 lo = __builtin_bit_cast(s16x4, __builtin_amdgcn_ds_read_tr16_b64_v4i16((LAS v4i16_t*)(Vs + ks * 16 * PV)));
                const s16x4 h4 = __builtin_bit_cast(s16x4, __builtin_amdgcn_ds_read_tr16_b64_v4i16((LAS v4i16_t*)(Vs + ks * 16 * PV + 4 * PV)));
                const bf16x8 vb = {lo[0], lo[1], lo[2], lo[3], h4[0], h4[1], h4[2], h4[3]};
                o[g] = __builtin_amdgcn_mfma_f32_32x32x16_bf16(pa[ks], vb, o[g], 0, 0, 0); } }
    };
    auto load_half = [&](int g, int h_, bf16x8 (&f)[2], int kb_, int vb_) {
        if (g >= ND) { const int s_ = 2 * (g - ND) + h_; const LAS unsigned char* Ks = lds + A_KOFF + kb_ * KB + kbase + 32 * s_;
            f[0] = *(const LAS bf16x8*)(Ks); f[1] = *(const LAS bf16x8*)(Ks + 32 * PK); }
        else { const LAS unsigned char* Vs = lds + A_VOFF + vb_ * VB + vbase + g * 64;
#pragma unroll
            for (int k2 = 0; k2 < 2; ++k2) { const int ks = 2 * h_ + k2;
                const s16x4 lo = __builtin_bit_cast(s16x4, __builtin_amdgcn_ds_read_tr16_b64_v4i16((LAS v4i16_t*)(Vs + ks * 16 * PV)));
                const s16x4 h4 = __builtin_bit_cast(s16x4, __builtin_amdgcn_ds_read_tr16_b64_v4i16((LAS v4i16_t*)(Vs + ks * 16 * PV + 4 * PV)));
                f[k2] = (bf16x8){lo[0], lo[1], lo[2], lo[3], h4[0], h4[1], h4[2], h4[3]}; } }
    };
    auto mfma_half = [&](int g, int h_, const bf16x8 (&f)[2]) {
        if (g >= ND) { const int s_ = 2 * (g - ND) + h_;
            if (s_ == 0) { p0 = __builtin_amdgcn_mfma_f32_32x32x16_bf16(f[0], qr[0], (f32x16){}, 0, 0, 0); p1 = __builtin_amdgcn_mfma_f32_32x32x16_bf16(f[1], qr[0], (f32x16){}, 0, 0, 0); }
            else { p0 = __builtin_amdgcn_mfma_f32_32x32x16_bf16(f[0], qr[s_], p0, 0, 0, 0); p1 = __builtin_amdgcn_mfma_f32_32x32x16_bf16(f[1], qr[s_], p1, 0, 0, 0); } }
        else {
#pragma unroll
            for (int k2 = 0; k2 < 2; ++k2) o[g] = __builtin_amdgcn_mfma_f32_32x32x16_bf16(pa[2 * h_ + k2], f[k2], o[g], 0, 0, 0); }
    };
    bf16x8 hA[2], hB[2];
    bf16x8 fA[4], fB[4];
    constexpr bool PIPE = (MODE != MODE_MOBA);
#define HOOK_NONE(I) do { } while (0)
#define RUN_GROUPS(GS, GE, KBUF, VBUF) RUN_GROUPS_H(GS, GE, KBUF, VBUF, HOOK_NONE)
#define RUN_GROUPS_H(GS, GE, KBUF, VBUF, HOOK) do { \
        if constexpr (PIPE) { \
        load_grp(GS, fA, KBUF, VBUF); __builtin_amdgcn_sched_barrier(0); \
        _Pragma("unroll") for (int g_ = (GS); g_ < (GE); ++g_) { \
            if (g_ + 1 < (GE)) { if ((g_ - (GS)) & 1) load_grp(g_ + 1, fA, KBUF, VBUF); else load_grp(g_ + 1, fB, KBUF, VBUF); } \
            __builtin_amdgcn_sched_barrier(0); \
            if ((g_ - (GS)) & 1) mfma_grp(g_, fB); else mfma_grp(g_, fA); \
            __builtin_amdgcn_sched_barrier(0); \
            HOOK(g_ - (GS)); __builtin_amdgcn_sched_barrier(0); } \
        } else { \
        load_half(GS, 0, hA, KBUF, VBUF); __builtin_amdgcn_sched_barrier(0); \
        _Pragma("unroll") for (int g_ = (GS); g_ < (GE); ++g_) { \
            load_half(g_, 1, hB, KBUF, VBUF); __builtin_amdgcn_sched_barrier(0); mfma_half(g_, 0, hA); __builtin_amdgcn_sched_barrier(0); \
            if (g_ + 1 < (GE)) load_half(g_ + 1, 0, hA, KBUF, VBUF); __builtin_amdgcn_sched_barrier(0); mfma_half(g_, 1, hB); __builtin_amdgcn_sched_barrier(0); \
            HOOK(g_ - (GS)); __builtin_amdgcn_sched_barrier(0); } \
        } } while (0)
#define ABAR() do { asm volatile("s_waitcnt lgkmcnt(0)" ::: "memory"); __builtin_amdgcn_s_barrier(); } while (0)
    const int half = 1 - (wid >> 2);
    float off = 0.f, al = 1.f;
    int j = next_tile(-1), it = 0;
    int jn = next_tile(j), jnn = jn < NT ? next_tile(jn) : NT;
    constexpr bool EARLY = (MODE != MODE_MOBA);
    load_k(j); write_k(0);
    if constexpr (EARLY) { load_v(j); if (jn < NT) load_k(jn); }
    ABAR();
#define STAGE_IN()  do { if constexpr (EARLY) { write_v(it & 1); if (jn < NT) write_k((it & 1) ^ 1); if (jn < NT) { load_v(jn); if (jnn < NT) load_k(jnn); } } else { load_v(j); if (jn < NT) load_k(jn); } } while (0)
#define STAGE_HOOK(I) do { if constexpr (!EARLY) { if ((I) == 0) { load_v(j); if (jn < NT) load_k(jn); } } else { if ((I) == 0) { write_v(it & 1); if (jn < NT) write_k((it & 1) ^ 1); } if ((I) == 1) { if (jn < NT) { load_v(jn); if (jnn < NT) load_k(jnn); } } } } while (0)
#define STAGE_IN_L() do { } while (0)
#define STAGE_OUT() do { if constexpr (EARLY) { } else { write_v(it & 1); if (jn < NT) write_k((it & 1) ^ 1); } } while (0)
#define SOFTMAX()   do { partialSM(p0, p1, j, off, al); rescale(al); finishSM(p0, p1, off, al, pa); } while (0)
    if (half == 0) {
        STAGE_IN(); RUN_GROUPS(ND, NG, 0, 0); STAGE_OUT(); SOFTMAX(); ABAR();
        while (jn < NT) {
            j = jn; jn = jnn; jnn = jn < NT ? next_tile(jn) : NT; ++it;
            STAGE_IN_L(); RUN_GROUPS_H(0, NG, it & 1, (it & 1) ^ 1, STAGE_HOOK); STAGE_OUT();
            SOFTMAX(); ABAR();
        }
    } else {
        STAGE_IN(); RUN_GROUPS(ND, NG, 0, 0); STAGE_OUT(); ABAR();
        while (jn < NT) {
            SOFTMAX();
            j = jn; jn = jnn; jnn = jn < NT ? next_tile(jn) : NT; ++it;
            STAGE_IN_L(); RUN_GROUPS_H(0, NG, it & 1, (it & 1) ^ 1, STAGE_HOOK); STAGE_OUT();
            ABAR();
        }
        SOFTMAX();
    }
    { const int l2 = lane_now(); vbase = (8 * (l2 >> 5) + ((l2 >> 2) & 3)) * PV + (16 * ((l2 >> 4) & 1) + 4 * (l2 & 3)) * 2; RUN_GROUPS(0, ND, 0, it & 1); }
#undef STAGE_IN
#undef STAGE_OUT
#undef STAGE_HOOK
#undef STAGE_IN_L
#undef RUN_GROUPS_H
#undef HOOK_NONE
#undef SOFTMAX
#undef ABAR
#undef RUN_GROUPS
    {
        const int l3 = lane_now(), c = l3 & 31, h3 = l3 >> 5;
        LAS float* ws_ = (LAS float*)(lds + A_WSCR + wid * 256);
        if (h3 == 0) ws_[32 + c] = l_run;
        LDS_WAIT();
#pragma unroll
        for (int g = 0; g < 4; ++g) { const f32x4 l4 = *(const LAS f32x4*)(ws_ + 32 + 8 * g + 4 * h3);
#pragma unroll
            for (int i = 0; i < 4; ++i) { const float rl = 1.f / (LSUM ? ol[4 * g + i] : l4[i]); const int row = a.qb * 256 + wid * 32 + 8 * g + 4 * h3 + i; bf16* orow = a.o + (size_t)row * a.ldo + c;
#pragma unroll
                for (int d = 0; d < ND; ++d) orow[32 * d] = (bf16)f2bf(o[d][4 * g + i] * rl); } }
    }
}
__device__ __forceinline__ int pop_unit(gu32* head, LAS unsigned* slot, int wave_s) {
    if (opaque_tid(wave_s) == 0) slot[0] = __hip_atomic_fetch_add(head, 1u, RLX_AGENT);
    __syncthreads();
    const int u = (int)slot[0];
    __syncthreads();
    return __builtin_amdgcn_readfirstlane(u);
}

__device__ __forceinline__ int next_unit_idx(int k_, int N, int G, int bx, gu32* head, LAS unsigned* slot, int wave_s) {
    if (G == 256 && 256 * (k_ + 1) < N) { __syncthreads(); const int base = 256 * k_; return (k_ & 1) ? base + 255 - bx : base + bx; }
    const int u = pop_unit(head, slot, wave_s);
    return G == 256 ? (N - 256) + u : u;
}

struct Args { const void* in[18]; float* out; unsigned char* ws; int ph_lo, ph_hi; };
typedef const __attribute__((address_space(4))) Args* KArgs;
__device__ __forceinline__ KArgs kargs() { KArgs p = (KArgs)__builtin_amdgcn_kernarg_segment_ptr(); asm volatile("" : "+s"(p)); return p; }
#define INP(k, type) ((const type*)A->in[k])
#define WSP(off, type) ((type*)(A->ws + (off)))
#define PHASE_VARS KArgs A = kargs(); const int tid = opaque_tid(wave0), lane = tid & 63, wave = __builtin_amdgcn_readfirstlane(tid >> 6); const int G = opaque_s(gridDim.x), bx = opaque_s(blockIdx.x); const int gw = bx * NWAVES + wave, NGW = G * NWAVES; (void)tid; (void)lane; (void)G; (void)bx; (void)gw; (void)NGW
__global__ void __launch_bounds__(NWAVES * 64, 2) trunk_fwd(Args args) {
    extern __shared__ __attribute__((aligned(16))) unsigned char lds_raw[];
    LAS unsigned char* lds = (LAS unsigned char*)lds_raw;
    volatile LAS unsigned* MISC = (volatile LAS unsigned*)(lds + MISC_OFF);
    int wave0 = __builtin_amdgcn_readfirstlane((int)threadIdx.x >> 6); asm volatile("" : "+s"(wave0));
    for (int u = threadIdx.x; u < (LDS_BYTES - RING_BYTES) / 4; u += NWAVES * 64) ((LAS unsigned*)(lds + RING_BYTES))[u] = 0u;
    __syncthreads();
    KArgs A0 = kargs();
    (void)xcd_barrier_post((unsigned*)((gu32*)(A0->ws + WS_CTL) + CW_BAR), MISC + 8);
#define GRID_BAR() do { KArgs Ab_ = kargs(); XcdBarrier b_; b_.bar = (unsigned*)((gu32*)(Ab_->ws + WS_CTL) + CW_BAR); b_.x = xb_xcc_id(); b_.st = (volatile LAS unsigned*)(lds + MISC_OFF) + 8; xcd_barrier(b_, opaque_tid(wave0)); } while (0)
#define PH_IN(p) ((p) >= kargs()->ph_lo && (p) < kargs()->ph_hi)
#define SEAM(p) do { if (PH_IN(p) && PH_IN((p) + 1)) GRID_BAR(); } while (0)
    if (PH_IN(0)) {
        PHASE_VARS;
        LAS float* scrw = (LAS float*)(lds + RING_OFF + wave * 16384);
        LayerW L{INP(7, float), INP(11, float), INP(13, float), INP(14, float), INP(15, float), INP(16, float), INP(17, float), INP(3, float), INP(5, float)};
        convert_weights(L, A->ws, scrw, gw, NGW, lane);
        const float* x_in = INP(0, float); bf16* xb = (bf16*)A->out; float* RS = WSP(WS_RS, float);
        for (int m = 4 * gw; m < T; m += 4 * NGW) cast_rows_rs<4>(x_in + (size_t)m * DM, xb + (size_t)m * DM, RS + m, lane);
        { const int* positions = INP(1, int); f32x2_t* ROPE = WSP(WS_ROPE, f32x2_t);
          for (int m4 = gw; m4 < T / 4; m4 += NGW) { const int tg = 4 * m4 + (lane >> 4), i = lane & 15; const float ang = (float)positions[tg] * powf(10000.f, -(float)i * (1.f / 16.f));
              ROPE[(size_t)tg * 16 + i] = (f32x2_t){cosf(ang), sinf(ang)}; } }
    }
    SEAM(0);

    for (int l = 0; l < DEPTH; ++l) {
        const int pb = 1 + 11 * l;
        if (PH_IN(pb + 0)) {
            PHASE_VARS;
            pg8::Gemm g{(const bf16*)A->out, WSP(WS_W1T, bf16), T, 3584, 1024, 1024}; pg8::StaticOrder S; S.init(T, 3584, G, bx);
            pg8::EpiBf16<0> E{WSP(WS_OA, bf16), 512, 512, SLOT, 0, nullptr, 0, WSP(WS_RS, float)};
            pg8::gemm_phase<pg8::EpiBf16<0>, pg8::StaticOrder, true, true>(lds + RING_OFF, g, S, E, wave0);
        }
        SEAM(pb + 0);
        if (PH_IN(pb + 1)) {
            PHASE_VARS;
            const float* qn = INP(10, float) + l * 256; const float* kvn = INP(12, float) + l * 128; const f32x2_t* ROPE = WSP(WS_ROPE, f32x2_t);
            bf16* OC = WSP(WS_OC, bf16); bf16* KR = WSP(WS_KR, bf16);
            for (int m = 4 * gw; m < T; m += 4 * NGW) mla_prep_rows<4>(OC + (size_t)m * 512, KR + (size_t)m * 32, qn, kvn, ROPE + (size_t)m * 16, lane);
        }
        SEAM(pb + 1);
        if (PH_IN(pb + 2)) {
            PHASE_VARS;
#pragma nounroll
            for (int st = 0; st < 2; ++st) {
            if (((st ^ bx) & 1) == 0) {
                __syncthreads();
                for (int c_ = bx; c_ < NB * 64; c_ += G) kmean_task(WSP(WS_MK, bf16), WSP(WS_KMEAN, float), c_ >> 6, (c_ >> 1) & 31, c_ & 1, (LAS float*)(lds + RING_OFF), tid);
            } else {
            pg8::Gemm g{WSP(WS_OC, bf16), WSP(WS_WQKV, bf16), T, 1792, 384, 512, 3, 256, 4, 2}; pg8::StaticOrder S; S.init(T, 1792, G, bx);
            pg8::EpiBf16<0> E{WSP(WS_Q, bf16), 768, 0, 0, 3, WSP(WS_KV, bf16), 1024, nullptr};
            pg8::gemm_phase<pg8::EpiBf16<0>, pg8::StaticOrder, true, true>(lds + RING_OFF, g, S, E, wave0);
            } }
        }
        SEAM(pb + 2);
        if (PH_IN(pb + 3)) {
            LAS unsigned* slot = (LAS unsigned*)(lds + A_SLOT);
            if constexpr (ATM & 1) for (int k_ = 0;; ++k_) {
                PHASE_VARS;
                const int u = next_unit_idx(k_, 512, G, bx, (gu32*)(A->ws + WS_CTL) + CW_QUEUE + 64 * (3 * l), slot, wave0); if (u >= 512) break;
                const int qb = 31 - (u >> 4), r = u & 15, b = r >> 2, h = r & 3; const size_t t0 = (size_t)b * SEQ;
                bf16* OB = WSP(WS_OB, bf16);
                AttnArgs a; a.q = OB + t0 * 512 + h * 128; a.ldq = 512; a.k = WSP(WS_MK, bf16) + t0 * 512 + h * 128; a.ldk = 512; a.k2 = nullptr; a.v = WSP(WS_MV, bf16) + t0 * 512 + h * 128; a.ldv = 512;
                a.o = OB + t0 * 512 + h * 128; a.ldo = 512; a.qb = qb; a.C = 0.08838834764831845f * LOG2E; a.bias = INP(2, float) + 4 + h; a.rope = nullptr; a.kmean = WSP(WS_KMEAN, float) + ((size_t)b * 4 + h) * 32 * 128;
                attn_unit<MODE_MOBA>(lds, a, wave0);
            }
            if constexpr (ATM & 2) for (int k_ = 0;; ++k_) {
                PHASE_VARS;
                const int u = next_unit_idx(k_, 1024, G, bx, (gu32*)(A->ws + WS_CTL) + CW_QUEUE + 64 * (3 * l + 1), slot, wave0); if (u >= 1024) break;
                const int qb = 31 - (u >> 5), r = u & 31, b = r >> 3, h = (r >> 1) & 3, mp = r & 1; const size_t t0 = (size_t)b * SEQ;
                AttnArgs a; a.q = WSP(WS_OA, bf16) + t0 * 512 + h * 128 + mp * 64; a.ldq = 512; a.k = WSP(WS_DK, bf16) + t0 * 512 + h * 128 + mp * 64; a.ldk = 512; a.k2 = nullptr; a.v = WSP(WS_DV, bf16) + t0 * 512 + h * 128; a.ldv = 512;
                a.o = WSP(WS_O12, bf16) + t0 * 1024 + (h * 2 + mp) * 128; a.ldo = 1024; a.qb = qb; a.C = 0.125f * LOG2E; a.bias = INP(2, float) + h; a.rope = nullptr; a.kmean = nullptr;
                attn_unit<MODE_DIFF>(lds, a, wave0);
            }
            if constexpr (ATM & 4) for (int k_ = 0;; ++k_) {
                PHASE_VARS;
                const int u = next_unit_idx(k_, 1024, G, bx, (gu32*)(A->ws + WS_CTL) + CW_QUEUE + 64 * (3 * l + 2), slot, wave0); if (u >= 1024) break;
                const int qb = 31 - (u >> 5), r = u & 31, b = r >> 3, h = r & 7; const size_t t0 = (size_t)b * SEQ;
                bf16* KVB = WSP(WS_KV, bf16);
                AttnArgs a; a.q = WSP(WS_Q, bf16) + t0 * 768 + h * 96; a.ldq = 768; a.k = KVB + t0 * 1024 + h * 128; a.ldk = 1024; a.k2 = WSP(WS_KR, bf16) + t0 * 32; a.v = KVB + t0 * 1024 + h * 128 + 64; a.ldv = 1024;
                a.o = WSP(WS_OC, bf16) + t0 * 512 + h * 64; a.ldo = 512; a.qb = qb; a.C = 0.10206207261596577f * LOG2E; a.bias = nullptr; a.rope = WSP(WS_ROPE, f32x2_t) + t0 * 16; a.kmean = nullptr;
                attn_unit<MODE_MLA>(lds, a, wave0);
            }
        }
        SEAM(pb + 3);
        if (PH_IN(pb + 4)) {
            PHASE_VARS;
#pragma nounroll
            for (int st = 0; st < 2; ++st) {
            if (((st ^ bx) & 1) == 0) {
                const float lam_init = 0.8f - 0.6f * expf(-0.3f * (float)l);
                const float* dl = INP(8, float) + l * 256;
                const float lam = expf(wave_sum(dl[lane] * dl[64 + lane], lane)) - expf(wave_sum(dl[128 + lane] * dl[192 + lane], lane)) + lam_init;
                const bf16* O12 = WSP(WS_O12, bf16); bf16* OA = WSP(WS_OA, bf16); const float* subln = INP(9, float) + l * 128;
                for (int m = gw; m < T; m += NGW) diff_combine_row(O12 + (size_t)m * 1024, OA + (size_t)m * 512, subln, lam, 1.f - lam_init, lane);
            } else {
            pg8::Gemm g{(const bf16*)A->out, WSP(WS_WGT, bf16), T, 3072, 1024, 1024}; pg8::StaticOrder S; S.init(T, 3072, G, bx);
            pg8::EpiBf16<2> E{WSP(WS_S, bf16), 3072, 0, 0, 0, nullptr, 0, WSP(WS_RS, float)};
            pg8::gemm_phase<pg8::EpiBf16<2>, pg8::StaticOrder, true, true>(lds + RING_OFF, g, S, E, wave0);
            } }
        }
        SEAM(pb + 4);
        if (PH_IN(pb + 5)) {
            PHASE_VARS;
            pg8::Gemm g{WSP(WS_OA, bf16), WSP(WS_WBT, bf16), 3 * T, 3 * 1024, 512, 512}; pg8::BranchOrder S; S.init(T, G, bx);
            pg8::EpiBranch E{WSP(WS_S, bf16), WSP(WS_H, bf16)};
            pg8::gemm_phase<pg8::EpiBranch, pg8::BranchOrder, true, true>(lds + RING_OFF, g, S, E, wave0);
        }
        SEAM(pb + 5);
        if (PH_IN(pb + 6)) {
            PHASE_VARS;
            pg8::Gemm g{WSP(WS_H, bf16), WSP(WS_WOT, bf16), T, 1024, 1024, 1024}; pg8::StaticOrder S; S.init(T, 1024, G, bx);
            pg8::EpiBf16<0> E{WSP(WS_Y, bf16), 1024, 0, 0, 0, nullptr, 0, nullptr};
            pg8::gemm_phase<pg8::EpiBf16<0>, pg8::StaticOrder, true, true>(lds + RING_OFF, g, S, E, wave0);
        }
        SEAM(pb + 6);
        if (PH_IN(pb + 7)) {
            PHASE_VARS;
            bf16* xb = (bf16*)A->out; bf16* xdst = (l == DEPTH - 1) ? WSP(WS_O12, bf16) : xb;
            const bf16* YB = WSP(WS_Y, bf16); float* RS = WSP(WS_RS, float); const float* wpost = INP(4, float) + l * DM;
            if (l == 0) { const float* xin = INP(0, float); for (int m = 2 * gw; m < T; m += 2 * NGW) resid_row2<true, false>(YB + (size_t)m * DM, xin + (size_t)m * DM, xdst + (size_t)m * DM, wpost, RS + m, lane); }
            else { for (int m = 2 * gw; m < T; m += 2 * NGW) resid_row2<false, false>(YB + (size_t)m * DM, xb + (size_t)m * DM, xdst + (size_t)m * DM, wpost, RS + m, lane); }
        }
        SEAM(pb + 7);
        if (PH_IN(pb + 8)) {
            PHASE_VARS;
            pg8::Gemm g{(l == DEPTH - 1) ? (const bf16*)WSP(WS_O12, bf16) : (const bf16*)A->out, WSP(WS_WUPT, bf16), T, 4096, 1024, 1024}; pg8::StaticOrder S; S.init(T, 4096, G, bx);
            pg8::EpiBf16<3> E{WSP(WS_U, bf16), 4096, 0, 0, 0, nullptr, 0, WSP(WS_RS, float)};
            pg8::gemm_phase<pg8::EpiBf16<3>, pg8::StaticOrder, true, true>(lds + RING_OFF, g, S, E, wave0);
        }
        SEAM(pb + 8);
        if (PH_IN(pb + 9)) {
            PHASE_VARS;
            pg8::Gemm g{WSP(WS_U, bf16), WSP(WS_WDNT, bf16), T, 1024, 4096, 4096}; pg8::StaticOrder S; S.init(T, 1024, G, bx);
            pg8::EpiBf16<0> E{WSP(WS_D, bf16), 1024, 0, 0, 0, nullptr, 0, nullptr};
            pg8::gemm_phase<pg8::EpiBf16<0>, pg8::StaticOrder, true, true>(lds + RING_OFF, g, S, E, wave0);
        }
        SEAM(pb + 9);
        if (PH_IN(pb + 10)) {
            PHASE_VARS;
            const bool more = (l + 1 < DEPTH);
            if (more) {
                const size_t n = (size_t)(l + 1);
                LAS float* scrw = (LAS float*)(lds + RING_OFF + wave * 16384);
                LayerW L{INP(7, float) + n * 1024 * DIN, INP(11, float) + n * 256 * 768, INP(13, float) + n * 128 * 1024, INP(14, float) + n * 3 * 512 * 1024,
                         INP(15, float) + n * 1024 * 1024, INP(16, float) + n * 1024 * 4096, INP(17, float) + n * 4096 * 1024, INP(3, float) + n * DM, INP(5, float) + n * DM};
                convert_weights(L, A->ws, scrw, gw, NGW, lane);
            }
            const bf16* DB = WSP(WS_D, bf16); float* RS = WSP(WS_RS, float);
            const float* wpost = INP(6, float) + l * DM;
            if (more) { bf16* xb = (bf16*)A->out; for (int m = 2 * gw; m < T; m += 2 * NGW) resid_row2<false, false>(DB + (size_t)m * DM, xb + (size_t)m * DM, xb + (size_t)m * DM, wpost, RS + m, lane); }
            else { const bf16* xsrc = WSP(WS_O12, bf16); float* xo = A->out; for (int m = 2 * gw; m < T; m += 2 * NGW) resid_row2<false, true>(DB + (size_t)m * DM, xsrc + (size_t)m * DM, xo + (size_t)m * DM, wpost, (float*)nullptr, lane); }
        }
        if (l + 1 < DEPTH) SEAM(pb + 10);
    }
}

extern "C" void kernel_launch(void* const* d_in, const int* in_sizes, int n_in, void* d_out, int out_size, void* d_ws, size_t ws_size, hipStream_t stream) {
    static int grid = 0;
    if (grid == 0) {
        if (n_in != 18 || in_sizes[0] != T * DM || out_size != T * DM || ws_size < WS_END) { fprintf(stderr, "kernel_launch: unexpected shapes (n_in %d, in0 %d, out %d, ws %zu, need %zu); nothing launched\n", n_in, n_in > 0 ? in_sizes[0] : -1, out_size, ws_size, (size_t)WS_END); grid = -1; return; }
        int dev = 0, cus = 0, per_cu = 0;
        if (hipGetDevice(&dev) != hipSuccess || hipDeviceGetAttribute(&cus, hipDeviceAttributeMultiprocessorCount, dev) != hipSuccess) { grid = -1; return; }
        if (hipFuncSetAttribute((const void*)trunk_fwd, hipFuncAttributeMaxDynamicSharedMemorySize, LDS_BYTES) != hipSuccess) { fprintf(stderr, "kernel_launch: hipFuncSetAttribute failed\n"); grid = -1; return; }
        if (hipOccupancyMaxActiveBlocksPerMultiprocessor(&per_cu, (const void*)trunk_fwd, NWAVES * 64, LDS_BYTES) != hipSuccess || per_cu < 1) { fprintf(stderr, "kernel_launch: occupancy query says %d blocks per CU\n", per_cu); }
        (void)hipGetLastError();
        grid = cus;
    }
    if (grid < 0) return;
    if (hipMemsetAsync((char*)d_ws + WS_CTL, 0, CTL_ZERO_BYTES, stream) != hipSuccess) return;
    Args a{};
    for (int i = 0; i < 18; ++i) a.in[i] = d_in[i];
    a.out = (float*)d_out; a.ws = (unsigned char*)d_ws;
    constexpr int NPH = 1 + 11 * DEPTH;
#ifndef N_LAUNCH
#define N_LAUNCH 1
#endif
    for (int li = 0; li < N_LAUNCH; ++li) {
        a.ph_lo = (N_LAUNCH == 1) ? 0 : li; a.ph_hi = (N_LAUNCH == 1) ? NPH : li + 1;
        hipLaunchKernelGGL(trunk_fwd, dim3(grid), dim3(NWAVES * 64), LDS_BYTES, stream, a);
        const hipError_t le = hipPeekAtLastError();
        if (le != hipSuccess) { fprintf(stderr, "kernel_launch: launch failed: %s\n", hipGetErrorName(le)); break; }
    }
}
```

```cpp
#include <hip/hip_runtime.h>
#include <cstdio>
#include <cstdint>
__device__ __forceinline__ int opaque_tid(int wave_s) { int l; asm volatile("v_mbcnt_lo_u32_b32 %0, -1, 0\n\tv_mbcnt_hi_u32_b32 %0, -1, %0" : "=v"(l)); return wave_s * 64 + l; }
__device__ __forceinline__ int opaque_s(int v) { asm volatile("" : "+s"(v)); return v; }
namespace pg8 {
#define PG8_LAS __attribute__((address_space(3)))
typedef unsigned short bf16_t;
typedef short bf16x8 __attribute__((ext_vector_type(8)));
typedef float f32x4 __attribute__((ext_vector_type(4)));
typedef unsigned u32x4 __attribute__((ext_vector_type(4)));
constexpr int BM = 256, BK = 64, HALF = 128, HTB = HALF * BK * 2  , STAGE_BYTES = 8 * HTB, NXCD = 8, WGM = 8;

__host__ __device__ __forceinline__ int lds_byte(int r, int c) { const int st = (r >> 4) * 2 + (c >> 5), rr = r & 15, cc = c & 31, ob = rr * 64 + cc * 2; return st * 1024 + (ob ^ (((ob >> 9) & 1) << 5)); }
__host__ __device__ __forceinline__ void stage_rc(int b, int& R, int& C) { const int st = b / 1024, sb = b % 1024, swz = sb ^ (((sb >> 9) & 1) << 5); R = (st >> 1) * 16 + swz / 64; C = (st & 1) * 32 + (swz % 64) / 2; }
__host__ __device__ __forceinline__ int perm32(int rho) { const int n = rho >> 4, i = rho & 15; return 8 * (i >> 2) + 4 * n + (i & 3); }

struct Unit { int pm, pn; };
struct Gemm { const bf16_t* A; const bf16_t* Bt; int M, N, K, lda; int split_pn = 0, k_hi = 0, nt_lo = 0, nt_hi = 0; };

struct StaticOrder {
    int nM, nN, nwg, G, c;
    __host__ __device__ void init(int M, int N, int G_, int c_) { nM = M / BM; nN = N / BM; nwg = nM * nN; G = G_; c = c_; }
    __host__ __device__ bool next(int i, Unit& u) const {
        const long L = (long)i * G + c; if (L >= nwg) return false;
        int wgid = (int)L; { const int q = nwg / NXCD, r = nwg % NXCD, xcd = wgid % NXCD, off = wgid / NXCD; wgid = (xcd < r ? xcd * (q + 1) : r * (q + 1) + (xcd - r) * q) + off; }
        const int nig = WGM * nN, gid = wgid / nig, fm = gid * WGM, gsz = (nM - fm) < WGM ? (nM - fm) : WGM;
        u.pm = fm + ((wgid % nig) % gsz); u.pn = (wgid % nig) / gsz; return true;
    }
    __device__ __forceinline__ void a_ready(const Unit&) const {}
    __device__ __forceinline__ void done(const Unit&) const {}
};

typedef float f32x2c __attribute__((ext_vector_type(2))); typedef __bf16 bf16x2c __attribute__((ext_vector_type(2)));
__device__ __forceinline__ unsigned cvt_pk_bf16(float lo, float hi) { f32x2c v = {lo, hi}; bf16x2c b = __builtin_convertvector(v, bf16x2c); return __builtin_bit_cast(unsigned, b); }
__device__ __forceinline__ float bf_lo(unsigned w) { return __builtin_bit_cast(float, w << 16); }
__device__ __forceinline__ float bf_hi(unsigned w) { return __builtin_bit_cast(float, w & 0xffff0000u); }
__device__ __forceinline__ float act_sigmoid(float v) { return __builtin_amdgcn_rcpf(1.f + __builtin_amdgcn_exp2f(-1.4426950408889634f * v)); }
__device__ __forceinline__ float act_relu2(float v) { const float r = fmaxf(v, 0.f); return r * r; }

template <int ACT  > struct EpiBf16 {
    static constexpr bool PERM = true, AFTER_DRAIN = false;
    bf16_t* O; int ldc; int split_cols; size_t split_stride; int pn2; bf16_t* O2; int ldc2; const float* rs;
    __device__ __forceinline__ void operator()(const f32x4 (&acc)[2][2][4][2], const Unit& u, int wr, int wc, int fr, int fq) const {
        const int row0 = u.pm * BM + wr * 64 + fr; int colt = u.pn * BM; bf16_t* base = O; int ldc = this->ldc;
        if (pn2 && u.pn >= pn2) { base = O2; ldc = ldc2; colt = (u.pn - pn2) * BM; }
        if (split_cols) { const int t = colt / split_cols; base += (size_t)t * split_stride; colt -= t * split_cols; }
        const int col0 = colt + wc * 32 + 8 * fq;
#pragma unroll
        for (int ai = 0; ai < 2; ++ai)
#pragma unroll
            for (int m = 0; m < 4; ++m) { bf16_t* rowp = base + (size_t)(row0 + ai * HALF + m * 16) * ldc + col0; const float rsc = rs ? rs[row0 + ai * HALF + m * 16] : 1.f;
#pragma unroll
                for (int bj = 0; bj < 2; ++bj) { f32x4 v0 = acc[ai][bj][m][0] * rsc, v1 = acc[ai][bj][m][1] * rsc;
                    if (ACT == 2) { v0 = (f32x4){act_sigmoid(v0[0]), act_sigmoid(v0[1]), act_sigmoid(v0[2]), act_sigmoid(v0[3])}; v1 = (f32x4){act_sigmoid(v1[0]), act_sigmoid(v1[1]), act_sigmoid(v1[2]), act_sigmoid(v1[3])}; }
                    if (ACT == 3) { v0 = (f32x4){act_relu2(v0[0]), act_relu2(v0[1]), act_relu2(v0[2]), act_relu2(v0[3])}; v1 = (f32x4){act_relu2(v1[0]), act_relu2(v1[1]), act_relu2(v1[2]), act_relu2(v1[3])}; }
                    u32x4 w; w.x = cvt_pk_bf16(v0[0], v0[1]); w.y = cvt_pk_bf16(v0[2], v0[3]); w.z = cvt_pk_bf16(v1[0], v1[1]); w.w = cvt_pk_bf16(v1[2], v1[3]);
                    *(u32x4*)(rowp + bj * HALF) = w; } }
    }
};

struct EpiF32 {
    static constexpr bool PERM = true, AFTER_DRAIN = false;
    float* O; int ldc;
    __device__ __forceinline__ void operator()(const f32x4 (&acc)[2][2][4][2], const Unit& u, int wr, int wc, int fr, int fq) const {
        const int row0 = u.pm * BM + wr * 64 + fr; const int col0 = u.pn * BM + wc * 32 + 8 * fq;
#pragma unroll
        for (int ai = 0; ai < 2; ++ai)
#pragma unroll
            for (int m = 0; m < 4; ++m) { float* rowp = O + (size_t)(row0 + ai * HALF + m * 16) * ldc + col0;
#pragma unroll
                for (int bj = 0; bj < 2; ++bj) { *(f32x4*)(rowp + bj * HALF) = acc[ai][bj][m][0]; *(f32x4*)(rowp + bj * HALF + 4) = acc[ai][bj][m][1]; } }
    }
};

struct EpiBranch {
    static constexpr bool PERM = true, AFTER_DRAIN = false;
    const bf16_t* S; bf16_t* Mo;
    __device__ __forceinline__ void operator()(const f32x4 (&acc)[2][2][4][2], const Unit& u, int wr, int wc, int fr, int fq) const {
        const int g = u.pm >> 7, pm = u.pm & 127, pn = u.pn & 3;
        const int row0 = pm * BM + wr * 64 + fr; const int col0 = pn * BM + wc * 32 + 8 * fq;
#pragma unroll
        for (int ai = 0; ai < 2; ++ai)
#pragma unroll
            for (int m = 0; m < 4; ++m) { const size_t row = (size_t)(row0 + ai * HALF + m * 16);
#pragma unroll
                for (int bj = 0; bj < 2; ++bj) { const int col = col0 + bj * HALF;
                    const u32x4 sv = *(const u32x4*)(S + row * 3072 + g * 1024 + col);
                    const f32x4 v0 = acc[ai][bj][m][0], v1 = acc[ai][bj][m][1];
                    float r0 = bf_lo(sv.x) * v0[0], r1 = bf_hi(sv.x) * v0[1], r2 = bf_lo(sv.y) * v0[2], r3 = bf_hi(sv.y) * v0[3];
                    float r4 = bf_lo(sv.z) * v1[0], r5 = bf_hi(sv.z) * v1[1], r6 = bf_lo(sv.w) * v1[2], r7 = bf_hi(sv.w) * v1[3];
                    u32x4* dst = (u32x4*)(Mo + row * 1024 + col);
                    if (g > 0) { const u32x4 pv = *dst; r0 += bf_lo(pv.x); r1 += bf_hi(pv.x); r2 += bf_lo(pv.y); r3 += bf_hi(pv.y); r4 += bf_lo(pv.z); r5 += bf_hi(pv.z); r6 += bf_lo(pv.w); r7 += bf_hi(pv.w); }
                    u32x4 w; w.x = cvt_pk_bf16(r0, r1); w.y = cvt_pk_bf16(r2, r3); w.z = cvt_pk_bf16(r4, r5); w.w = cvt_pk_bf16(r6, r7);
                    *dst = w; } }
    }
};
struct BranchOrder {
    StaticOrder S0;
    __device__ void init(int M, int G_, int c_) { S0.init(M, 1024, G_, c_); }
    __device__ bool next(int i, Unit& u) const { Unit t; if (!S0.next(i / 3, t)) return false; const int g = i % 3; u.pm = g * 128 + t.pm; u.pn = g * 4 + t.pn; return true; }
    __device__ __forceinline__ void a_ready(const Unit&) const {}
    __device__ __forceinline__ void done(const Unit&) const {}
};

template <class Epi, class Sched, bool ALIGN_EPI = false, bool SP2 = false>
__device__ __forceinline__ void gemm_phase(PG8_LAS unsigned char* lds, const Gemm g, const Sched& S, const Epi& E, int wave_s) {
    const int tid = opaque_tid(wave_s), wid = __builtin_amdgcn_readfirstlane(tid >> 6), lane = tid & 63, wr = wid >> 2, wc = wid & 3, fr = lane & 15, fq = lane >> 4;
    const int K = g.K; int nt = g.split_pn ? 0 : K / BK;
    unsigned voffA[2], voffB[2];
#pragma unroll
    for (int i = 0; i < 2; ++i) { int R, C; stage_rc(tid * 16 + i * 8192, R, C); const int Rb = Epi::PERM ? ((R & ~31) + perm32(R & 31)) : R;
        voffA[i] = (unsigned)(R * g.lda + C) * 2u; voffB[i] = (unsigned)(Rb * K + C) * 2u; }
    const size_t kstep = (size_t)(BK * 2);
    const size_t hstep = (size_t)HALF * K * 2;
    const size_t tstep = 2 * hstep; const size_t hstepA = (size_t)HALF * g.lda * 2, tstepA = 2 * hstepA;
    const unsigned ldsw = (unsigned)wid * 1024u;
    const int aoff = lds_byte(wr * 64 + fr, fq * 8), boff = lds_byte(wc * 32 + fr, fq * 8);
#define PG8_SA(b, h) (((b) * 2 + (h)) * HTB)
#define PG8_SB(b, h) ((4 + (b) * 2 + (h)) * HTB)
#define PG8_STAGE(bufoff, gbase, voff) do { _Pragma("unroll") for (int _i = 0; _i < 2; ++_i) \
        __builtin_amdgcn_global_load_lds((const unsigned*)((const char*)(gbase) + (voff)[_i]), (PG8_LAS unsigned*)(lds + (bufoff) + ldsw + _i * 8192), 16, 0, 0); } while (0)
#define PG8_LDA(dst, b, h) do { _Pragma("unroll") for (int m = 0; m < 4; ++m) _Pragma("unroll") for (int k = 0; k < 2; ++k) dst[m][k] = *(const PG8_LAS bf16x8*)(lds + PG8_SA(b, h) + aoff + m * 2048 + k * 1024); } while (0)
#define PG8_LDB(dst, b, h) do { _Pragma("unroll") for (int n = 0; n < 2; ++n) _Pragma("unroll") for (int k = 0; k < 2; ++k) dst[n][k] = *(const PG8_LAS bf16x8*)(lds + PG8_SB(b, h) + boff + n * 2048 + k * 1024); } while (0)
#define PG8_MMA(ai, bj, At, Bt) do { __builtin_amdgcn_s_setprio(1); _Pragma("unroll") for (int m = 0; m < 4; ++m) _Pragma("unroll") for (int n = 0; n < 2; ++n) _Pragma("unroll") for (int k = 0; k < 2; ++k) \
        acc[ai][bj][m][n] = __builtin_amdgcn_mfma_f32_16x16x32_bf16(Bt[n][k], At[m][k], acc[ai][bj][m][n], 0, 0, 0); __builtin_amdgcn_s_setprio(0); } while (0)
#define PG8_WAIT_V(n) asm volatile("s_waitcnt vmcnt(" #n ")" ::: "memory")
#define PG8_WAIT_L(n) asm volatile("s_waitcnt lgkmcnt(" #n ")" ::: "memory")
#define PG8_BAR __builtin_amdgcn_s_barrier()
#define PG8_SCHED __builtin_amdgcn_sched_barrier(0)
    Unit cur, nxt; int ui = 0;
    if (!S.next(0, cur)) return;
    f32x4 acc[2][2][4][2];
#pragma unroll
    for (int a = 0; a < 2; ++a)
#pragma unroll
        for (int b = 0; b < 2; ++b)
#pragma unroll
            for (int m = 0; m < 4; ++m)
#pragma unroll
                for (int n = 0; n < 2; ++n) acc[a][b][m][n] = (f32x4){0.f, 0.f, 0.f, 0.f};
    bf16x8 At[4][2], B0[2][2], B1[2][2];
    const char* cA = (const char*)g.A + (size_t)cur.pm * tstepA; const char* cB = (const char*)g.Bt + (size_t)cur.pn * tstep;
    if (g.split_pn) { const bool hi_ = cur.pn >= g.split_pn; nt = hi_ ? g.nt_hi : g.nt_lo; if (hi_) { cA += (size_t)g.k_hi * 2; cB += (size_t)g.k_hi * 2; } }
    S.a_ready(cur);
    if constexpr (SP2) {
        PG8_STAGE(PG8_SB(0, 0), cB, voffB); PG8_STAGE(PG8_SB(0, 1), cB + hstep, voffB); PG8_STAGE(PG8_SA(0, 0), cA, voffA); PG8_STAGE(PG8_SA(0, 1), cA + hstepA, voffA);
        if (wr == 1) PG8_BAR;
        PG8_WAIT_V(2); PG8_BAR;
        PG8_STAGE(PG8_SB(1, 0), cB + kstep, voffB); PG8_STAGE(PG8_SA(1, 0), cA + kstep, voffA); PG8_STAGE(PG8_SB(1, 1), cB + hstep + kstep, voffB);
        PG8_WAIT_V(6); PG8_BAR;
    } else {
        PG8_STAGE(PG8_SB(0, 0), cB, voffB); PG8_STAGE(PG8_SA(0, 0), cA, voffA); PG8_STAGE(PG8_SB(0, 1), cB + hstep, voffB); PG8_STAGE(PG8_SA(0, 1), cA + hstepA, voffA);
        if (wr == 1) PG8_BAR;
        PG8_WAIT_V(4); PG8_BAR;
        PG8_STAGE(PG8_SB(1, 0), cB + kstep, voffB); PG8_STAGE(PG8_SA(1, 0), cA + kstep, voffA); PG8_STAGE(PG8_SB(1, 1), cB + hstep + kstep, voffB);
        PG8_WAIT_V(6); PG8_BAR;
    }
    for (;;) {
        const bool has_next = S.next(ui + 1, nxt);
        const char* nA = has_next ? (const char*)g.A + (size_t)nxt.pm * tstepA : cA; const char* nB = has_next ? (const char*)g.Bt + (size_t)nxt.pn * tstep : cB;
        int nt_nxt = nt;
        if (g.split_pn && has_next) { const bool hi_ = nxt.pn >= g.split_pn; nt_nxt = hi_ ? g.nt_hi : g.nt_lo; if (hi_) { nA += (size_t)g.k_hi * 2; nB += (size_t)g.k_hi * 2; } }
        for (int t = 0; t < nt; t += 2) {
            const bool last = (t == nt - 2);
            const char* a1 = cA + (size_t)(t + 1) * kstep;
            const char* a2 = last ? nA : cA + (size_t)(t + 2) * kstep; const char* b2 = last ? nB : cB + (size_t)(t + 2) * kstep;
            const char* a3 = a2 + kstep; const char* b3 = b2 + kstep;
            if (last && has_next) S.a_ready(nxt);
            if constexpr (SP2) {
            PG8_LDB(B0, 0, 0); PG8_LDB(B1, 0, 1); PG8_SCHED; PG8_LDA(At, 0, 0); PG8_STAGE(PG8_SA(1, 1), a1 + hstepA, voffA);
            PG8_WAIT_V(8); PG8_WAIT_L(0); PG8_BAR; PG8_MMA(0, 0, At, B0); PG8_MMA(0, 1, At, B1); PG8_BAR; PG8_SCHED;
            PG8_LDA(At, 0, 1); PG8_STAGE(PG8_SB(0, 0), b2, voffB); PG8_STAGE(PG8_SB(0, 1), b2 + hstep, voffB); PG8_STAGE(PG8_SA(0, 0), a2, voffA);
            PG8_WAIT_V(8); PG8_WAIT_L(0); PG8_BAR; PG8_MMA(1, 0, At, B0); PG8_MMA(1, 1, At, B1); PG8_BAR; PG8_SCHED;
            PG8_LDB(B0, 1, 0); PG8_LDB(B1, 1, 1); PG8_SCHED; PG8_LDA(At, 1, 0); PG8_STAGE(PG8_SA(0, 1), a2 + hstepA, voffA);
            PG8_WAIT_V(8); PG8_WAIT_L(0); PG8_BAR; PG8_MMA(0, 0, At, B0); PG8_MMA(0, 1, At, B1); PG8_BAR; PG8_SCHED;
            PG8_LDA(At, 1, 1); PG8_STAGE(PG8_SB(1, 0), b3, voffB); PG8_STAGE(PG8_SB(1, 1), b3 + hstep, voffB); PG8_STAGE(PG8_SA(1, 0), a3, voffA);
            PG8_WAIT_V(8); PG8_WAIT_L(0); PG8_BAR; PG8_MMA(1, 0, At, B0); PG8_MMA(1, 1, At, B1); PG8_BAR; PG8_SCHED;
            } else {
            PG8_LDB(B0, 0, 0); PG8_SCHED; PG8_LDA(At, 0, 0); PG8_STAGE(PG8_SA(1, 1), a1 + hstepA, voffA);
            PG8_WAIT_L(8); PG8_BAR; PG8_WAIT_L(0); PG8_MMA(0, 0, At, B0); PG8_BAR; PG8_SCHED;
            PG8_LDB(B1, 0, 1); PG8_STAGE(PG8_SB(0, 0), b2, voffB);
            PG8_BAR; PG8_WAIT_L(0); PG8_MMA(0, 1, At, B1); PG8_BAR;
            PG8_LDA(At, 0, 1); PG8_STAGE(PG8_SA(0, 0), a2, voffA);
            PG8_BAR; PG8_WAIT_L(0); PG8_MMA(1, 0, At, B0); PG8_BAR; PG8_SCHED;
            PG8_STAGE(PG8_SB(0, 1), b2 + hstep, voffB);
            PG8_WAIT_V(6); PG8_BAR; PG8_MMA(1, 1, At, B1); PG8_BAR;
            PG8_LDB(B0, 1, 0); PG8_SCHED; PG8_LDA(At, 1, 0); PG8_STAGE(PG8_SA(0, 1), a2 + hstepA, voffA);
            PG8_WAIT_L(8); PG8_BAR; PG8_WAIT_L(0); PG8_MMA(0, 0, At, B0); PG8_BAR; PG8_SCHED;
            PG8_LDB(B1, 1, 1); PG8_STAGE(PG8_SB(1, 0), b3, voffB);
            PG8_BAR; PG8_WAIT_L(0); PG8_MMA(0, 1, At, B1); PG8_BAR;
            PG8_LDA(At, 1, 1); PG8_STAGE(PG8_SA(1, 0), a3, voffA);
            PG8_BAR; PG8_WAIT_L(0); PG8_MMA(1, 0, At, B0); PG8_BAR; PG8_SCHED;
            PG8_STAGE(PG8_SB(1, 1), b3 + hstep, voffB);
            PG8_WAIT_V(6); PG8_BAR; PG8_MMA(1, 1, At, B1); PG8_BAR;
            }
        }
        if constexpr (ALIGN_EPI) { if (wr == 0) PG8_BAR; }
        if constexpr (!Epi::AFTER_DRAIN) { E(acc, cur, wr, wc, fr, fq); S.done(cur); }
        if (!has_next) break;
#pragma unroll
        for (int a = 0; a < 2; ++a)
#pragma unroll
            for (int b = 0; b < 2; ++b)
#pragma unroll
                for (int m = 0; m < 4; ++m)
#pragma unroll
                    for (int n = 0; n < 2; ++n) acc[a][b][m][n] = (f32x4){0.f, 0.f, 0.f, 0.f};
        cur = nxt; cA = nA; cB = nB; nt = nt_nxt; ++ui;
        if constexpr (ALIGN_EPI) { if (wr == 1) PG8_BAR; }
    }
    PG8_WAIT_V(0);
    if constexpr (!ALIGN_EPI) { if (wr == 0) PG8_BAR; }
    PG8_BAR;
    if constexpr (Epi::AFTER_DRAIN) { E.fused(acc, cur, wr, wc, fr, fq, lds, wid, lane); S.done(cur); }
#undef PG8_SA
#undef PG8_SB
#undef PG8_STAGE
#undef PG8_LDA
#undef PG8_LDB
#undef PG8_MMA
#undef PG8_WAIT_V
#undef PG8_WAIT_L
#undef PG8_BAR
#undef PG8_SCHED
}
}

constexpr int NB = 4, SEQ = 8192, DM = 1024, T = NB * SEQ, DEPTH = 4, DIN = 6560, DFF = 4096;
constexpr float RMS_EPS = 1e-6f;
#define N_LAUNCH 1
constexpr int NWAVES = 8;
#ifndef ATM
#define ATM 7
#endif
constexpr size_t MiB = 1u << 20;
constexpr size_t WS_CTL = 0, CTL_ZERO_BYTES = 65536;
constexpr size_t WS_RS = 768 * 1024;
constexpr size_t WS_KMEAN = 512 * 1024;
constexpr size_t WS_W1T = 1 * MiB, WS_WGT = 8 * MiB, WS_WQKV = 14 * MiB  , WS_WBT = 16 * MiB, WS_WOT = 19 * MiB, WS_WUPT = 21 * MiB, WS_WDNT = 29 * MiB;
constexpr size_t WS_H = 37 * MiB;
constexpr size_t WS_OA = 101 * MiB, WS_OB = 133 * MiB, WS_OC = 165 * MiB, WS_DK = 197 * MiB, WS_DV = 229 * MiB, WS_MK = 261 * MiB, WS_MV = 293 * MiB;
constexpr size_t WS_Q = 325 * MiB, WS_KV = 373 * MiB, WS_KR = 437 * MiB, WS_O12 = 439 * MiB;
constexpr size_t WS_ROPE = 503 * MiB, WS_END = 507 * MiB;
constexpr size_t WS_S = 197 * MiB;
constexpr size_t WS_Y = 197 * MiB;
constexpr size_t WS_U = 101 * MiB;
constexpr size_t WS_D = 373 * MiB;
constexpr size_t SLOT = (size_t)T * 512;
constexpr int CW_BAR = 4096;
constexpr int CW_QUEUE = 8192;

constexpr int RING_OFF = 0, RING_BYTES = 131072;
constexpr int MISC_OFF = RING_BYTES + 320;
constexpr int LDS_BYTES = 147456;
constexpr int A_KOFF = 0, A_VOFF = 34816, A_TAB = 96256, A_WSCR = 100352, A_KMEAN = 102400, A_SLOT = 118784;

#define GAS __attribute__((address_space(1)))
#define LAS __attribute__((address_space(3)))
typedef unsigned short bf16;
typedef unsigned v4u __attribute__((ext_vector_type(4)));
typedef unsigned v2u __attribute__((ext_vector_type(2)));
typedef float f32x4 __attribute__((ext_vector_type(4)));
typedef float f32x2_t __attribute__((ext_vector_type(2)));
typedef float f32x16 __attribute__((ext_vector_type(16)));
typedef short bf16x8 __attribute__((ext_vector_type(8)));
typedef short s16x4 __attribute__((ext_vector_type(4)));
typedef short v4i16_t __attribute__((ext_vector_type(4)));
typedef __bf16 bf16x2_t __attribute__((ext_vector_type(2)));
typedef GAS unsigned gu32;
#define RLX_AGENT __ATOMIC_RELAXED, __HIP_MEMORY_SCOPE_AGENT
#define LDS_WAIT() asm volatile("s_waitcnt lgkmcnt(0)" ::: "memory")
#define VM_WAIT() asm volatile("s_waitcnt vmcnt(0)" ::: "memory")
__device__ __forceinline__ unsigned f2bf(float f) { unsigned u = __builtin_bit_cast(unsigned, f); return (u + 0x7fffu + ((u >> 16) & 1u)) >> 16; }
__device__ __forceinline__ unsigned pk2(float lo, float hi) { return f2bf(lo) | (f2bf(hi) << 16); }
__device__ __forceinline__ unsigned cvtpk_s(float lo, float hi) { f32x2_t v = {lo, hi}; bf16x2_t b = __builtin_convertvector(v, bf16x2_t); return __builtin_bit_cast(unsigned, b); }
__device__ __forceinline__ float bflo(unsigned w) { return __builtin_bit_cast(float, w << 16); }
__device__ __forceinline__ float bfhi(unsigned w) { return __builtin_bit_cast(float, w & 0xffff0000u); }
__device__ __forceinline__ float bf2f(short s) { return __builtin_bit_cast(float, ((unsigned)(unsigned short)s) << 16); }

#define XB_TMO      128
#define XB_XCNT(j)  (256  + 64 * (j))
#define XB_XSUB(j)  (1280 + 64 * (j))
#define XB_XGEN(j)  (2304 + 64 * (j))
#define XB_TOP      3328
#define XB_TOPGEN   3392
#define XCD_BAR_WORDS 3456
#define XB_SPIN_CAP (1u << 20)

__device__ __forceinline__ unsigned xb_ld(unsigned* p)              { return __hip_atomic_load(p, __ATOMIC_RELAXED, __HIP_MEMORY_SCOPE_AGENT); }
__device__ __forceinline__ unsigned xb_add(unsigned* p, unsigned v) { return __hip_atomic_fetch_add(p, v, __ATOMIC_RELAXED, __HIP_MEMORY_SCOPE_AGENT); }
__device__ __forceinline__ unsigned xb_xcc_id() { return (unsigned)__builtin_amdgcn_s_getreg((3 << 11) | 20) & 0xFu; }
#define XB_SPIN(cond, bar) do { unsigned _sp = 0; while (cond) { __builtin_amdgcn_s_sleep(1); \
    if ((++_sp & 255u) == 0u) { if (xb_ld(&(bar)[XB_TMO])) break; if (_sp > XB_SPIN_CAP) { atomicAdd(&(bar)[XB_TMO], 1u); break; } } } } while (0)

struct XcdBarrier {
    unsigned* bar; unsigned x;
    volatile LAS unsigned* st;
};
__device__ __forceinline__ XcdBarrier xcd_barrier_post(unsigned* bar, volatile LAS unsigned* st) {
    XcdBarrier b; b.bar = bar; b.x = xb_xcc_id(); b.st = st;
    if (threadIdx.x == 0) (void)xb_add(&bar[XB_XCNT(b.x)], 1u);
    return b;
}
__device__ __forceinline__ void xcd_barrier_complete(unsigned* bar, unsigned x, unsigned& nloc, unsigned& nx) {
    const unsigned G = gridDim.x * gridDim.y * gridDim.z;
    unsigned sum, cnt, mine, sp = 0u;
    for (;;) {
        sum = 0u; cnt = 0u; mine = 0u;
#pragma unroll
        for (unsigned j = 0; j < 16; ++j) { const unsigned c = xb_ld(&bar[XB_XCNT(j)]); sum += c; cnt += (c > 0u) ? 1u : 0u; mine = (j == x) ? c : mine; }
        if (sum == G) break;
        __builtin_amdgcn_s_sleep(1);
        if ((++sp & 255u) == 0u) { if (xb_ld(&bar[XB_TMO])) break; if (sp > XB_SPIN_CAP) { atomicAdd(&bar[XB_TMO], 1u); break; } }
    }
    nloc = mine > 0u ? mine : 1u; nx = cnt > 0u ? cnt : 1u;
}
__device__ __forceinline__ void xcd_barrier(const XcdBarrier& b, int tid_) {
    asm volatile("s_waitcnt vmcnt(0)" ::: "memory");
    __syncthreads();
    if (tid_ == 0) {
        unsigned* bar = b.bar;
        __builtin_amdgcn_s_waitcnt(0);
        unsigned nloc = b.st[0], nx = b.st[1];
        if (nloc == 0u) { xcd_barrier_complete(bar, b.x, nloc, nx); b.st[0] = nloc; b.st[1] = nx; }
        const unsigned old = xb_add(&bar[XB_XSUB(b.x)], 1u);
        const unsigned gen = old / nloc;
        if (old + 1u == (gen + 1u) * nloc) {
            __builtin_amdgcn_fence(__ATOMIC_RELEASE, "agent");
            asm volatile("s_waitcnt vmcnt(0)" ::: "memory");
            const unsigned og = xb_add(&bar[XB_TOP], 1u);
            const unsigned tg = og / nx;
            if (og + 1u == (tg + 1u) * nx) xb_add(&bar[XB_TOPGEN], 1u);
            else XB_SPIN(xb_ld(&bar[XB_TOPGEN]) == tg, bar);
            __builtin_amdgcn_fence(__ATOMIC_ACQUIRE, "agent");
            xb_add(&bar[XB_XGEN(b.x)], 1u);
            asm volatile("s_waitcnt vmcnt(0)" ::: "memory");
        } else {
            XB_SPIN(xb_ld(&bar[XB_XGEN(b.x)]) == gen, bar);
            __builtin_amdgcn_fence(__ATOMIC_ACQUIRE, "agent");
            asm volatile("s_waitcnt vmcnt(0)" ::: "memory");
        }
    }
    __syncthreads();
}

__device__ __forceinline__ float shfl_xor_l(float v, int o, int lane) { return __builtin_bit_cast(float, __builtin_amdgcn_ds_bpermute((lane ^ o) << 2, __builtin_bit_cast(int, v))); }
__device__ __forceinline__ float wave_sum(float v, int lane) {
#pragma unroll
    for (int o = 1; o < 64; o <<= 1) v += shfl_xor_l(v, o, lane);
    return v;
}
__device__ __forceinline__ void tr_item(const float* W, int ldw, int k0, int n0, bf16* WT, int drow0, int Kd, int kd0, const float* ksc, LAS float* scr, int lane) {
    f32x4 v_[8]; float sc_[8];
#pragma unroll
    for (int i = 0; i < 8; ++i) { const int kk = 8 * i + (lane >> 3); v_[i] = *(const f32x4*)(W + (size_t)(k0 + kk) * ldw + n0 + 4 * (lane & 7)); sc_[i] = ksc ? ksc[k0 + kk] : 1.f; }
#pragma unroll
    for (int i = 0; i < 8; ++i) { const int kk = 8 * i + (lane >> 3); LAS float* d_ = scr + kk * 33 + 4 * (lane & 7);
        d_[0] = v_[i].x * sc_[i]; d_[1] = v_[i].y * sc_[i]; d_[2] = v_[i].z * sc_[i]; d_[3] = v_[i].w * sc_[i]; }
    LDS_WAIT(); asm volatile("" ::: "memory");
    const int c = lane & 7;
#pragma unroll
    for (int j = 0; j < 4; ++j) { const int n = (lane >> 3) + 8 * j; const LAS float* s = scr + (8 * c) * 33 + n;
        v4u o; o.x = pk2(s[0 * 33], s[1 * 33]); o.y = pk2(s[2 * 33], s[3 * 33]); o.z = pk2(s[4 * 33], s[5 * 33]); o.w = pk2(s[6 * 33], s[7 * 33]);
        *(v4u*)(WT + (size_t)(drow0 + n) * Kd + kd0 + k0 + 8 * c) = o; }
    LDS_WAIT(); asm volatile("" ::: "memory");
}
__device__ __forceinline__ void zero_item(bf16* WT, int drow0, int Kd, int k0, int lane) {
    const int c = lane & 7;
#pragma unroll
    for (int j = 0; j < 4; ++j) { const int n = (lane >> 3) + 8 * j; *(v4u*)(WT + (size_t)(drow0 + n) * Kd + k0 + 8 * c) = (v4u){0u, 0u, 0u, 0u}; }
}
__device__ __forceinline__ bool seg_item(int& r, const float* W, int ldw, int K, int n_src0, int n_count, bf16* WT, int drow0, int Kd, int kd0, const float* ksc, LAS float* scr, int lane) {
    const int nb = n_count / 32, cnt = (K / 64) * nb;
    if (r >= cnt) { r -= cnt; return false; }
    const int kb = r / nb, b = r % nb;
    tr_item(W, ldw, 64 * kb, n_src0 + 32 * b, WT, drow0 + 32 * b, Kd, kd0, ksc, scr, lane);
    return true;
}
struct LayerW { const float *w_in, *uq, *ukv, *wb, *wo, *wup, *wdn, *n_mix, *n_mlp; };
__device__ __forceinline__ void convert_weights(const LayerW& L, unsigned char* ws, LAS float* scr, int gw, int NGW, int lane) {
    bf16* W1T = (bf16*)(ws + WS_W1T); bf16* WGT = (bf16*)(ws + WS_WGT); bf16* WQKV = (bf16*)(ws + WS_WQKV);
    bf16* WBT = (bf16*)(ws + WS_WBT); bf16* WOT = (bf16*)(ws + WS_WOT); bf16* WUPT = (bf16*)(ws + WS_WUPT); bf16* WDNT = (bf16*)(ws + WS_WDNT);
    constexpr int N_TR = 16 * (16 * 6 + 13) + 16 * 96 + 4 * 24 + 2 * 32 + 3 * 8 * 32 + 16 * 32 + 16 * 128 + 64 * 32;
    constexpr int N_Z1 = 16 * 3, N_Z2 = 2 * 24, N_Z3 = 4 * 32;
    for (int it = gw; it < N_TR + N_Z1 + N_Z2 + N_Z3; it += NGW) {
        int r = it;
        if (seg_item(r, L.w_in, DIN, 1024, 0,    512, W1T, 0,    1024, 0, L.n_mix, scr, lane)) continue;
        if (seg_item(r, L.w_in, DIN, 1024, 1536, 512, W1T, 512,  1024, 0, L.n_mix, scr, lane)) continue;
        if (seg_item(r, L.w_in, DIN, 1024, 3072, 416, W1T, 1024, 1024, 0, L.n_mix, scr, lane)) continue;
        if (seg_item(r, L.w_in, DIN, 1024, 512,  512, W1T, 1536, 1024, 0, L.n_mix, scr, lane)) continue;
        if (seg_item(r, L.w_in, DIN, 1024, 1024, 512, W1T, 2048, 1024, 0, L.n_mix, scr, lane)) continue;
        if (seg_item(r, L.w_in, DIN, 1024, 2048, 512, W1T, 2560, 1024, 0, L.n_mix, scr, lane)) continue;
        if (seg_item(r, L.w_in, DIN, 1024, 2560, 512, W1T, 3072, 1024, 0, L.n_mix, scr, lane)) continue;
        if (seg_item(r, L.w_in, DIN, 1024, 3488, 3072, WGT, 0,   1024, 0, L.n_mix, scr, lane)) continue;
        if (seg_item(r, L.uq,  768,  256, 0, 768,  WQKV, 0,   384, 0,   nullptr, scr, lane)) continue;
        if (seg_item(r, L.ukv, 1024, 128, 0, 1024, WQKV, 768, 384, 256, nullptr, scr, lane)) continue;
        if (seg_item(r, L.wb,                     1024, 512, 0, 1024, WBT, 0,    512, 0, nullptr, scr, lane)) continue;
        if (seg_item(r, L.wb + (size_t)512 * 1024, 1024, 512, 0, 1024, WBT, 1024, 512, 0, nullptr, scr, lane)) continue;
        if (seg_item(r, L.wb + (size_t)1024 * 1024, 1024, 512, 0, 1024, WBT, 2048, 512, 0, nullptr, scr, lane)) continue;
        if (seg_item(r, L.wo,  1024, 1024, 0, 1024, WOT,  0, 1024, 0, nullptr, scr, lane)) continue;
        if (seg_item(r, L.wup, 4096, 1024, 0, 4096, WUPT, 0, 1024, 0, L.n_mlp, scr, lane)) continue;
        if (seg_item(r, L.wdn, 1024, 4096, 0, 1024, WDNT, 0, 4096, 0, nullptr, scr, lane)) continue;
        if (r < N_Z1) { zero_item(W1T, 1440 + 32 * (r % 3), 1024, 64 * (r / 3), lane); continue; } r -= N_Z1;
        if (r < N_Z2) { zero_item(WQKV, 32 * (r % 24), 384, 256 + 64 * (r / 24), lane); continue; } r -= N_Z2;
        { const int kb = r / 32; zero_item(WQKV, 768 + 32 * (r % 32), 384, 64 * kb, lane); }
    }
}
__device__ __forceinline__ void norm_row_bf16(const float* xrow, const float* w, bf16* orow, int lane) {
    const f32x4* xr = (const f32x4*)xrow + lane; const f32x4* wr = (const f32x4*)w + lane;
    f32x4 v[4]; float s = 0.f;
#pragma unroll
    for (int j = 0; j < 4; ++j) { v[j] = xr[64 * j]; s += (v[j].x * v[j].x + v[j].y * v[j].y) + (v[j].z * v[j].z + v[j].w * v[j].w); }
    const float rstd = 1.f / sqrtf(wave_sum(s, lane) * (1.f / 1024.f) + RMS_EPS);
    v2u* o8 = (v2u*)orow + lane;
#pragma unroll
    for (int j = 0; j < 4; ++j) { const f32x4 ww = wr[64 * j]; v2u o; o.x = pk2(v[j].x * rstd * ww.x, v[j].y * rstd * ww.y); o.y = pk2(v[j].z * rstd * ww.z, v[j].w * rstd * ww.w); o8[64 * j] = o; }
}
__device__ __forceinline__ void resid_row(const float* yrow, const float* xold, float* xout, const float* wpost, const float* wnext, bf16* hout, int lane) {
    const f32x4* yr = (const f32x4*)yrow + lane; const f32x4* xr = (const f32x4*)xold + lane; const f32x4* wp = (const f32x4*)wpost + lane;
    f32x4 y[4], x[4]; float s = 0.f;
#pragma unroll
    for (int j = 0; j < 4; ++j) { y[j] = yr[64 * j]; x[j] = xr[64 * j]; s += (y[j].x * y[j].x + y[j].y * y[j].y) + (y[j].z * y[j].z + y[j].w * y[j].w); }
    const float r1 = 1.f / sqrtf(wave_sum(s, lane) * (1.f / 1024.f) + RMS_EPS);
    float s2 = 0.f; f32x4* xo = (f32x4*)xout + lane;
#pragma unroll
    for (int j = 0; j < 4; ++j) { const f32x4 ww = wp[64 * j]; x[j] = x[j] + y[j] * r1 * ww; xo[64 * j] = x[j]; s2 += (x[j].x * x[j].x + x[j].y * x[j].y) + (x[j].z * x[j].z + x[j].w * x[j].w); }
    if (wnext) {
        const float r2 = 1.f / sqrtf(wave_sum(s2, lane) * (1.f / 1024.f) + RMS_EPS);
        const f32x4* wn = (const f32x4*)wnext + lane; v2u* o8 = (v2u*)hout + lane;
#pragma unroll
        for (int j = 0; j < 4; ++j) { const f32x4 ww = wn[64 * j]; v2u o; o.x = pk2(x[j].x * r2 * ww.x, x[j].y * r2 * ww.y); o.y = pk2(x[j].z * r2 * ww.z, x[j].w * r2 * ww.w); o8[64 * j] = o; }
    }
}
__device__ __forceinline__ void cast_row_rs(const float* xrow, bf16* orow, float* rs, int lane) {
    const f32x4* xr = (const f32x4*)xrow + lane; f32x4 v[4]; float s = 0.f;
#pragma unroll
    for (int j = 0; j < 4; ++j) { v[j] = xr[64 * j]; s += (v[j].x * v[j].x + v[j].y * v[j].y) + (v[j].z * v[j].z + v[j].w * v[j].w); }
    const float rstd = 1.f / sqrtf(wave_sum(s, lane) * (1.f / 1024.f) + RMS_EPS);
    v2u* o8 = (v2u*)orow + lane;
#pragma unroll
    for (int j = 0; j < 4; ++j) { v2u o; o.x = pk2(v[j].x, v[j].y); o.y = pk2(v[j].z, v[j].w); o8[64 * j] = o; }
    if (lane == 0) *rs = rstd;
}
template <int NR>
__device__ __forceinline__ void cast_rows_rs(const float* xrow0, bf16* orow0, float* rs0, int lane) {
    f32x4 v[NR][4]; float s[NR];
#pragma unroll
    for (int r = 0; r < NR; ++r)
#pragma unroll
        for (int j = 0; j < 4; ++j) v[r][j] = ((const f32x4*)(xrow0 + (size_t)r * DM) + lane)[64 * j];
#pragma unroll
    for (int r = 0; r < NR; ++r) { s[r] = 0.f;
#pragma unroll
        for (int j = 0; j < 4; ++j) s[r] += (v[r][j].x * v[r][j].x + v[r][j].y * v[r][j].y) + (v[r][j].z * v[r][j].z + v[r][j].w * v[r][j].w); }
#pragma unroll
    for (int o = 1; o < 64; o <<= 1) { float t[NR];
#pragma unroll
        for (int r = 0; r < NR; ++r) t[r] = shfl_xor_l(s[r], o, lane);
#pragma unroll
        for (int r = 0; r < NR; ++r) s[r] += t[r]; }
#pragma unroll
    for (int r = 0; r < NR; ++r) { v2u* o8 = (v2u*)(orow0 + (size_t)r * DM) + lane;
#pragma unroll
        for (int j = 0; j < 4; ++j) { v2u o; o.x = pk2(v[r][j].x, v[r][j].y); o.y = pk2(v[r][j].z, v[r][j].w); o8[64 * j] = o; }
        if (lane == 0) rs0[r] = 1.f / sqrtf(s[r] * (1.f / 1024.f) + RMS_EPS); }
}
template <bool XIN_F32, bool XOUT_F32>
__device__ __forceinline__ void resid_row2(const bf16* yrow, const void* xold_, void* xout_, const float* wpost, float* rsout, int lane) {
    const f32x4* wp = (const f32x4*)wpost + lane;
    f32x4 y[2][4], x[2][4]; float s[2] = {0.f, 0.f};
#pragma unroll
    for (int r = 0; r < 2; ++r) { const v2u* yr = (const v2u*)(yrow + r * DM) + lane;
#pragma unroll
        for (int j = 0; j < 4; ++j) { const v2u yw = yr[64 * j]; y[r][j] = (f32x4){bflo(yw.x), bfhi(yw.x), bflo(yw.y), bfhi(yw.y)};
            if constexpr (XIN_F32) x[r][j] = ((const f32x4*)((const float*)xold_ + r * DM) + lane)[64 * j];
            else { const v2u xw = ((const v2u*)((const bf16*)xold_ + r * DM) + lane)[64 * j]; x[r][j] = (f32x4){bflo(xw.x), bfhi(xw.x), bflo(xw.y), bfhi(xw.y)}; } } }
#pragma unroll
    for (int r = 0; r < 2; ++r)
#pragma unroll
        for (int j = 0; j < 4; ++j) s[r] += (y[r][j].x * y[r][j].x + y[r][j].y * y[r][j].y) + (y[r][j].z * y[r][j].z + y[r][j].w * y[r][j].w);
#pragma unroll
    for (int o = 1; o < 64; o <<= 1) { const float a = shfl_xor_l(s[0], o, lane), b = shfl_xor_l(s[1], o, lane); s[0] += a; s[1] += b; }
    float s2[2] = {0.f, 0.f};
#pragma unroll
    for (int r = 0; r < 2; ++r) { const float r1 = 1.f / sqrtf(s[r] * (1.f / 1024.f) + RMS_EPS);
#pragma unroll
        for (int j = 0; j < 4; ++j) { const f32x4 ww = wp[64 * j]; x[r][j] = x[r][j] + y[r][j] * r1 * ww;
            if constexpr (XOUT_F32) ((f32x4*)((float*)xout_ + r * DM) + lane)[64 * j] = x[r][j];
            else { v2u o; o.x = pk2(x[r][j].x, x[r][j].y); o.y = pk2(x[r][j].z, x[r][j].w); ((v2u*)((bf16*)xout_ + r * DM) + lane)[64 * j] = o;
                   x[r][j] = (f32x4){bflo(o.x), bfhi(o.x), bflo(o.y), bfhi(o.y)}; }     s2[r] += (x[r][j].x * x[r][j].x + x[r][j].y * x[r][j].y) + (x[r][j].z * x[r][j].z + x[r][j].w * x[r][j].w); } }
    if (rsout) {
#pragma unroll
        for (int o = 1; o < 64; o <<= 1) { const float a = shfl_xor_l(s2[0], o, lane), b = shfl_xor_l(s2[1], o, lane); s2[0] += a; s2[1] += b; }
        if (lane == 0) { rsout[0] = 1.f / sqrtf(s2[0] * (1.f / 1024.f) + RMS_EPS); rsout[1] = 1.f / sqrtf(s2[1] * (1.f / 1024.f) + RMS_EPS); }
    }
}
__device__ __forceinline__ void mla_prep_row(bf16* p3row, bf16* krrow, const float* qn, const float* kvn, const f32x2_t* rope16, int lane) {
    const v4u raw = *((const v4u*)p3row + lane);
    float x[8] = {bflo(raw.x), bfhi(raw.x), bflo(raw.y), bfhi(raw.y), bflo(raw.z), bfhi(raw.z), bflo(raw.w), bfhi(raw.w)};
    float ss = 0.f;
#pragma unroll
    for (int j = 0; j < 8; ++j) ss += x[j] * x[j];
    const float sq = wave_sum(lane < 32 ? ss : 0.f, lane), skv = wave_sum((lane >= 32 && lane < 48) ? ss : 0.f, lane);
    const float rq = 1.f / sqrtf(sq * (1.f / 256.f) + RMS_EPS), rkv = 1.f / sqrtf(skv * (1.f / 128.f) + RMS_EPS);
    if (lane < 48) {
        const float r = lane < 32 ? rq : rkv; const float* wv = lane < 32 ? qn + 8 * lane : kvn + 8 * (lane - 32);
        const f32x4 w0 = *(const f32x4*)wv, w1 = *(const f32x4*)(wv + 4);
        v4u o; o.x = pk2(x[0] * r * w0.x, x[1] * r * w0.y); o.y = pk2(x[2] * r * w0.z, x[3] * r * w0.w); o.z = pk2(x[4] * r * w1.x, x[5] * r * w1.y); o.w = pk2(x[6] * r * w1.z, x[7] * r * w1.w);
        *((v4u*)p3row + lane) = o;
    }
    float part[8];
#pragma unroll
    for (int j = 0; j < 8; ++j) part[j] = shfl_xor_l(x[j], 2, lane);
    if (lane >= 48 && lane < 52) {
        const bool first = lane < 50; float y[8];
#pragma unroll
        for (int j = 0; j < 8; ++j) { const f32x2_t r_ = rope16[8 * (lane & 1) + j]; const float cs = r_.x, sn = r_.y;
            y[j] = first ? (x[j] * cs - part[j] * sn) : (x[j] * cs + part[j] * sn); }
        v4u o; o.x = pk2(y[0], y[1]); o.y = pk2(y[2], y[3]); o.z = pk2(y[4], y[5]); o.w = pk2(y[6], y[7]);
        *((v4u*)krrow + (lane - 48)) = o;
    }
}
template <int NR>
__device__ __forceinline__ void mla_prep_rows(bf16* p3row0, bf16* krrow0, const float* qn, const float* kvn, const f32x2_t* rope0, int lane) {
    v4u raw[NR]; f32x2_t rc[NR][8];
#pragma unroll
    for (int r = 0; r < NR; ++r) raw[r] = *((const v4u*)(p3row0 + (size_t)r * 512) + lane);
    const bool rl = (lane >= 48 && lane < 52);
    if (rl) {
#pragma unroll
        for (int r = 0; r < NR; ++r)
#pragma unroll
            for (int j = 0; j < 8; ++j) rc[r][j] = rope0[(size_t)r * 16 + 8 * (lane & 1) + j];
    }
    float x[NR][8], sq[NR], skv[NR];
#pragma unroll
    for (int r = 0; r < NR; ++r) { x[r][0] = bflo(raw[r].x); x[r][1] = bfhi(raw[r].x); x[r][2] = bflo(raw[r].y); x[r][3] = bfhi(raw[r].y); x[r][4] = bflo(raw[r].z); x[r][5] = bfhi(raw[r].z); x[r][6] = bflo(raw[r].w); x[r][7] = bfhi(raw[r].w);
        float ss = 0.f;
#pragma unroll
        for (int j = 0; j < 8; ++j) ss += x[r][j] * x[r][j];
        sq[r] = lane < 32 ? ss : 0.f; skv[r] = (lane >= 32 && lane < 48) ? ss : 0.f; }
#pragma unroll
    for (int o = 1; o < 64; o <<= 1) {
        float a[NR], b[NR];
#pragma unroll
        for (int r = 0; r < NR; ++r) { a[r] = shfl_xor_l(sq[r], o, lane); b[r] = shfl_xor_l(skv[r], o, lane); }
#pragma unroll
        for (int r = 0; r < NR; ++r) { sq[r] += a[r]; skv[r] += b[r]; }
    }
    const float* wv = lane < 32 ? qn + 8 * lane : kvn + 8 * ((lane - 32) & 15);
    const f32x4 w0 = *(const f32x4*)wv, w1 = *(const f32x4*)(wv + 4);
#pragma unroll
    for (int r = 0; r < NR; ++r) {
        const float rq = 1.f / sqrtf(sq[r] * (1.f / 256.f) + RMS_EPS), rkv = 1.f / sqrtf(skv[r] * (1.f / 128.f) + RMS_EPS);
        float part[8];
#pragma unroll
        for (int j = 0; j < 8; ++j) part[j] = shfl_xor_l(x[r][j], 2, lane);
        if (lane < 48) {
            const float rr = lane < 32 ? rq : rkv;
            v4u o; o.x = pk2(x[r][0] * rr * w0.x, x[r][1] * rr * w0.y); o.y = pk2(x[r][2] * rr * w0.z, x[r][3] * rr * w0.w); o.z = pk2(x[r][4] * rr * w1.x, x[r][5] * rr * w1.y); o.w = pk2(x[r][6] * rr * w1.z, x[r][7] * rr * w1.w);
            *((v4u*)(p3row0 + (size_t)r * 512) + lane) = o;
        }
        if (rl) {
            const bool first = lane < 50; float y[8];
#pragma unroll
            for (int j = 0; j < 8; ++j) { const float cs = rc[r][j].x, sn = rc[r][j].y; y[j] = first ? (x[r][j] * cs - part[j] * sn) : (x[r][j] * cs + part[j] * sn); }
            v4u o; o.x = pk2(y[0], y[1]); o.y = pk2(y[2], y[3]); o.z = pk2(y[4], y[5]); o.w = pk2(y[6], y[7]);
            *((v4u*)(krrow0 + (size_t)r * 32) + (lane - 48)) = o;
        }
    }
}
__device__ __forceinline__ void kmean_task(const bf16* MK, float* kmean, int b, int n, int half, LAS float* scr, int tid) {
    const int wave = tid >> 6, lane = tid & 63, hw = lane >> 5, cl = lane & 31, strm = wave * 2 + hw;
    float acc[8] = {0.f, 0.f, 0.f, 0.f, 0.f, 0.f, 0.f, 0.f};
    const bf16* base = MK + ((size_t)b * SEQ + (size_t)n * 256 + strm * 16) * 512 + half * 256 + cl * 8;
#pragma unroll
    for (int r = 0; r < 16; ++r) { const v4u w = *(const v4u*)(base + (size_t)r * 512);
        acc[0] += bflo(w.x); acc[1] += bfhi(w.x); acc[2] += bflo(w.y); acc[3] += bfhi(w.y); acc[4] += bflo(w.z); acc[5] += bfhi(w.z); acc[6] += bflo(w.w); acc[7] += bfhi(w.w); }
#pragma unroll
    for (int j = 0; j < 8; ++j) scr[strm * 256 + cl * 8 + j] = acc[j];
    __syncthreads();
    if (tid < 256) { float s = 0.f;
#pragma unroll
        for (int w = 0; w < 16; ++w) s += scr[w * 256 + tid];
        const int col = half * 256 + tid, h = col >> 7, d = col & 127;
        kmean[(((size_t)b * 4 + h) * 32 + n) * 128 + d] = s * (1.f / 256.f); }
    __syncthreads();
}
__device__ __forceinline__ void diff_combine_row(const bf16* o12row, bf16* oarow, const float* subln, float lam, float oscale, int lane) {
    const int h = lane >> 4, dc = lane & 15;
    const v4u a = *(const v4u*)(o12row + h * 256 + dc * 8), b = *(const v4u*)(o12row + h * 256 + 128 + dc * 8);
    float d[8] = {bflo(a.x) - lam * bflo(b.x), bfhi(a.x) - lam * bfhi(b.x), bflo(a.y) - lam * bflo(b.y), bfhi(a.y) - lam * bfhi(b.y),
                  bflo(a.z) - lam * bflo(b.z), bfhi(a.z) - lam * bfhi(b.z), bflo(a.w) - lam * bflo(b.w), bfhi(a.w) - lam * bfhi(b.w)};
    float ss = 0.f;
#pragma unroll
    for (int j = 0; j < 8; ++j) ss += d[j] * d[j];
#pragma unroll
    for (int o = 1; o < 16; o <<= 1) ss += shfl_xor_l(ss, o, lane);
    const float r = oscale / sqrtf(ss * (1.f / 128.f) + RMS_EPS);
    const f32x4 w0 = *(const f32x4*)(subln + dc * 8), w1 = *(const f32x4*)(subln + dc * 8 + 4);
    v4u o; o.x = pk2(d[0] * r * w0.x, d[1] * r * w0.y); o.y = pk2(d[2] * r * w0.z, d[3] * r * w0.w); o.z = pk2(d[4] * r * w1.x, d[5] * r * w1.y); o.w = pk2(d[6] * r * w1.z, d[7] * r * w1.w);
    *(v4u*)(oarow + h * 128 + dc * 8) = o;
}

__device__ __forceinline__ int crow(int r, int hi) { return (r & 3) + 8 * (r >> 2) + 4 * hi; }
__device__ __forceinline__ int t5_bucket(int n) {
    if (n < 16) return n;
    return 16 + (n >= 21) + (n >= 27) + (n >= 35) + (n >= 46) + (n >= 59) + (n >= 77) + (n >= 99) + (n >= 128) + (n >= 166) + (n >= 216) + (n >= 280) + (n >= 363) + (n >= 470) + (n >= 609) + (n >= 790);
}
constexpr float LOG2E = 1.4426950408889634f;
constexpr float NEGBIG = -3.0e38f, M_INIT = -1.0e30f;
enum { MODE_MLA = 0, MODE_DIFF = 1, MODE_MOBA = 2 };
struct AttnArgs {
    const bf16* q; int ldq;
    const bf16* k; int ldk;
    const bf16* k2;
    const bf16* v; int ldv;
    bf16* o; int ldo;
    int qb;
    float C;
    const float* bias;
    const f32x2_t* rope;
    const float* kmean;
};
template <int MODE> struct AttnCfg {
    static constexpr int DQK = MODE == MODE_MLA ? 96 : (MODE == MODE_DIFF ? 64 : 128);
    static constexpr int DV = MODE == MODE_MLA ? 64 : 128;
    static constexpr int PK = DQK * 2 + 16, PV = DV * 2 + 64;
    static constexpr int KB = 64 * PK, VB = 64 * PV;
    static constexpr int KCH = DQK / 8, VCH = DV / 8;
    static constexpr int NKC = 64 * KCH, NVC = 64 * VCH;
    static constexpr int KPT = (NKC + 511) / 512, VPT = (NVC + 511) / 512;
    static constexpr int NS = DQK / 16, ND = DV / 32;
};

template <int MODE>
__device__ __forceinline__ void attn_unit(LAS unsigned char* lds, const AttnArgs& a, int wave_s) {
    using C_ = AttnCfg<MODE>;
    constexpr int PK = C_::PK, PV = C_::PV, KB = C_::KB, VB = C_::VB, KCH = C_::KCH, VCH = C_::VCH, NKC = C_::NKC, KPT = C_::KPT, VPT = C_::VPT, NS = C_::NS, ND = C_::ND;
    constexpr float THR = 10.f;
    const int tid = opaque_tid(wave_s), wid = __builtin_amdgcn_readfirstlane(tid >> 6), lane = tid & 63, r32 = lane & 31, hi = lane >> 5;
    const int q0w = a.qb * 256 + wid * 32, qrow = q0w + r32;
    const int NT = 4 * (a.qb + 1);
    LAS float* tab = (LAS float*)(lds + A_TAB);
    LAS float* wscr = (LAS float*)(lds + A_WSCR + wid * 256);
    LAS unsigned* slot = (LAS unsigned*)(lds + A_SLOT);
    bf16x8 qr[NS];
#pragma unroll
    for (int s = 0; s < NS; ++s) qr[s] = *(const bf16x8*)(a.q + (size_t)qrow * a.ldq + 16 * s + 8 * hi);
    if constexpr (MODE == MODE_MLA) {
        const f32x2_t* rp_ = a.rope + (size_t)qrow * 16 + 8 * hi;
#pragma unroll
        for (int j = 0; j < 8; ++j) { const f32x2_t r_ = rp_[j]; const float cs = r_.x, sn = r_.y; const float x1 = bf2f(qr[4][j]), x2 = bf2f(qr[5][j]);
            qr[4][j] = (short)f2bf((x1 * cs - x2 * sn) * a.C); qr[5][j] = (short)f2bf((x2 * cs + x1 * sn) * a.C); }
#pragma unroll
        for (int s = 0; s < 4; ++s)
#pragma unroll
            for (int j = 0; j < 8; ++j) qr[s][j] = (short)f2bf(bf2f(qr[s][j]) * a.C);
    } else {
#pragma unroll
        for (int s = 0; s < NS; ++s)
#pragma unroll
            for (int j = 0; j < 8; ++j) qr[s][j] = (short)f2bf(bf2f(qr[s][j]) * a.C);
    }
    if constexpr (MODE != MODE_MLA) {
        for (int i = tid; i < 1024; i += 512) tab[i] = a.bias[t5_bucket(i) * 8] * LOG2E;
    }
    unsigned mask = 0xffffffffu, umask = 0xffffffffu, wmask = 0xffffffffu;
    if constexpr (MODE == MODE_MOBA) {
        LAS float* km = (LAS float*)(lds + A_KMEAN);
        { const f32x4* src = (const f32x4*)a.kmean + tid * 2; *((LAS f32x4*)km + tid * 2) = src[0]; *((LAS f32x4*)km + tid * 2 + 1) = src[1]; }
        if (tid < 9) slot[8 + tid] = 0u;
        __syncthreads();
        const int own = a.qb;
        float v0 = NEGBIG, v1 = NEGBIG, v2 = NEGBIG; int i0 = 32, i1 = 32, i2 = 32;
        for (int n = 0; n < own; ++n) {
            float g = 0.f;
#pragma unroll
            for (int s = 0; s < NS; ++s) { const f32x4 ka = *(const LAS f32x4*)(km + n * 128 + 16 * s + 8 * hi), kb = *(const LAS f32x4*)(km + n * 128 + 16 * s + 8 * hi + 4);
                g += bf2f(qr[s][0]) * ka.x + bf2f(qr[s][1]) * ka.y + bf2f(qr[s][2]) * ka.z + bf2f(qr[s][3]) * ka.w + bf2f(qr[s][4]) * kb.x + bf2f(qr[s][5]) * kb.y + bf2f(qr[s][6]) * kb.z + bf2f(qr[s][7]) * kb.w; }
            { auto rr = __builtin_amdgcn_permlane32_swap(__float_as_uint(g), __float_as_uint(g), false, false); g = __uint_as_float(rr[0]) + __uint_as_float(rr[1]); }
            if (g > v0) { v2 = v1; i2 = i1; v1 = v0; i1 = i0; v0 = g; i0 = n; }
            else if (g > v1) { v2 = v1; i2 = i1; v1 = g; i1 = n; }
            else if (g > v2) { v2 = g; i2 = n; }
        }
        mask = (1u << own) | (i0 < 32 ? (1u << i0) : 0u) | (i1 < 32 ? (1u << i1) : 0u) | (i2 < 32 ? (1u << i2) : 0u);
        __hip_atomic_fetch_or(slot + 8 + wid, mask, __ATOMIC_RELAXED, __HIP_MEMORY_SCOPE_WORKGROUP);
        __hip_atomic_fetch_or(slot + 16, mask, __ATOMIC_RELAXED, __HIP_MEMORY_SCOPE_WORKGROUP);
        __syncthreads();
        umask = slot[16]; wmask = slot[8 + wid];
        umask = __builtin_amdgcn_readfirstlane(umask); wmask = __builtin_amdgcn_readfirstlane(wmask);
    }
    bf16x8 kst[KPT], vst[VPT];
    unsigned kofs[KPT], vofs[VPT]; [[maybe_unused]] unsigned kstr[KPT];
#pragma unroll
    for (int i = 0; i < KPT; ++i) { const int id = tid + 512 * i; const int row = id / KCH, ch = id % KCH;
        if (MODE == MODE_MLA && ch >= 8) { kofs[i] = (unsigned)((const char*)a.k2 - (const char*)a.k) + row * 64 + (ch - 8) * 16; kstr[i] = 64 * 64; }
        else { kofs[i] = (unsigned)(row * a.ldk * 2 + ch * 16); kstr[i] = (unsigned)(64 * a.ldk * 2); } }
#pragma unroll
    for (int i = 0; i < VPT; ++i) { const int id = tid + 512 * i; const int row = id / VCH, ch = id % VCH; vofs[i] = (unsigned)(row * a.ldv * 2 + ch * 16); }
    auto load_k = [&](int j) {
#pragma unroll
        for (int i = 0; i < KPT; ++i) { const int id = tid + 512 * i;
            if ((NKC % 512 == 0) || id < NKC) {
                if constexpr (MODE == MODE_MLA) kst[i] = *(const bf16x8*)((const char*)a.k + (kofs[i] + __umul24((unsigned)j, kstr[i])));
                else kst[i] = *(const bf16x8*)((const char*)a.k + (size_t)j * (size_t)(64 * a.ldk * 2) + kofs[i]); } }
    };
    auto load_v = [&](int j) {
#pragma unroll
        for (int i = 0; i < VPT; ++i) vst[i] = *(const bf16x8*)((const char*)a.v + (size_t)j * (size_t)(64 * a.ldv * 2) + vofs[i]);
    };
    auto write_k = [&](int kb_) {
#pragma unroll
        for (int i = 0; i < KPT; ++i) { const int id = tid + 512 * i;
            if ((NKC % 512 == 0) || id < NKC) { const int row = id / KCH, ch = id % KCH; *(LAS bf16x8*)(lds + A_KOFF + kb_ * KB + row * PK + ch * 16) = kst[i]; } }
    };
    auto write_v = [&](int vb_) {
#pragma unroll
        for (int i = 0; i < VPT; ++i) { const int id = tid + 512 * i; const int row = id / VCH, ch = id % VCH; *(LAS bf16x8*)(lds + A_VOFF + vb_ * VB + row * PV + ch * 16) = vst[i]; }
    };
    auto next_tile = [&](int j) -> int {
        int jn = j + 1;
        if constexpr (MODE == MODE_MOBA) { while (jn < NT && !((umask >> (jn >> 2)) & 1u)) jn = (jn & ~3) + 4; }
        return jn;
    };
    auto need_tile = [&](int j) -> bool {
        bool need = (64 * j <= q0w + 31);
        if constexpr (MODE == MODE_MOBA) need = need && ((wmask >> (j >> 2)) & 1u);
        return need;
    };
    f32x16 o[ND];
#pragma unroll
    for (int d = 0; d < ND; ++d) o[d] = (f32x16){};
    float m_run = M_INIT, l_run = 0.f;
    const int kbase = r32 * PK + 16 * hi;
    constexpr bool NOSWAP = (MODE == MODE_MLA);
    constexpr int VHI = NOSWAP ? 4 : 8, VH4 = NOSWAP ? 8 : 4;
    int vbase = (VHI * hi + ((lane >> 2) & 3)) * PV + (16 * ((lane >> 4) & 1) + 4 * (lane & 3)) * 2;
    auto partialSM = [&](f32x16& p0, f32x16& p1, int j, float& off, float& al) {
        const int k0 = 64 * j, relq = qrow - k0, relmin = q0w - k0 - 63;
        const bool fast = (MODE == MODE_MLA) ? (relmin >= 0) : (relmin >= 790);
        float cb = 0.f;
        if (fast) { if constexpr (MODE != MODE_MLA) cb = tab[1023]; }
        else if ((MODE != MODE_MLA) && relmin >= 0) {
            const LAS float* tb = tab + (relq - 4 * hi - 59);
#pragma unroll
            for (int r = 0; r < 16; ++r) { const int c_ = (r & 3) + 8 * (r >> 2); p0[r] += tb[59 - c_]; p1[r] += tb[27 - c_]; }
        } else {
#pragma unroll
            for (int r = 0; r < 16; ++r) { const int rel0 = relq - crow(r, hi), rel1 = rel0 - 32;
                float t0 = p0[r], t1 = p1[r];
                if constexpr (MODE != MODE_MLA) { t0 += tab[min(max(rel0, 0), 1023)]; t1 += tab[min(max(rel1, 0), 1023)]; }
                p0[r] = rel0 < 0 ? NEGBIG : t0; p1[r] = rel1 < 0 ? NEGBIG : t1;
                if ((r & 3) == 3) __builtin_amdgcn_sched_barrier(0); }
        }
        if constexpr (MODE == MODE_MOBA) {
            const bool allowed = (mask >> (j >> 2)) & 1u;
#pragma unroll
            for (int r = 0; r < 16; ++r) { p0[r] = allowed ? p0[r] : NEGBIG; p1[r] = allowed ? p1[r] : NEGBIG; }
        }
        float pm = fmaxf(p0[0], p1[0]);
#pragma unroll
        for (int r = 1; r < 16; ++r) pm = fmaxf(fmaxf(pm, p0[r]), p1[r]);
        { auto rr = __builtin_amdgcn_permlane32_swap(__float_as_uint(pm), __float_as_uint(pm), false, false); pm = fmaxf(__uint_as_float(rr[0]), __uint_as_float(rr[1])); }
        pm += cb;
        if (__all(pm - m_run <= THR)) al = 1.f;
        else { const float mn = fmaxf(m_run, pm); al = __builtin_amdgcn_exp2f(m_run - mn); m_run = mn; }
        off = cb - m_run;
#pragma unroll
        for (int r = 0; r < 16; ++r) p0[r] = __builtin_amdgcn_exp2f(p0[r] + off);
    };
    auto lane_now = [&]() -> int { int ln; asm volatile("v_mbcnt_lo_u32_b32 %0, -1, 0\n\tv_mbcnt_hi_u32_b32 %0, -1, %0" : "=v"(ln)); return ln; };
    constexpr bool LSUM = (MODE == MODE_MLA);
    f32x16 ol = (f32x16){};
    auto rescale = [&](float al) {
        if (!__all(al == 1.f)) {
            const int ln = lane_now();
            LAS float* ws_ = (LAS float*)(lds + A_WSCR + wid * 256);
            if (ln < 32) ws_[ln] = al;
            LDS_WAIT();
#pragma unroll
            for (int g = 0; g < 4; ++g) { const f32x4 a4 = *(const LAS f32x4*)(ws_ + 8 * g + 4 * (ln >> 5));
#pragma unroll
                for (int d = 0; d < ND; ++d) { o[d][4 * g + 0] *= a4.x; o[d][4 * g + 1] *= a4.y; o[d][4 * g + 2] *= a4.z; o[d][4 * g + 3] *= a4.w; }
                if constexpr (LSUM) { ol[4 * g + 0] *= a4.x; ol[4 * g + 1] *= a4.y; ol[4 * g + 2] *= a4.z; ol[4 * g + 3] *= a4.w; } }
        }
    };
    auto finishSM = [&](f32x16& p0, f32x16& p1, float off, float al, bf16x8 (&pa)[4]) {
        if constexpr (LSUM) {
#pragma unroll
            for (int r = 0; r < 16; ++r) p1[r] = __builtin_amdgcn_exp2f(p1[r] + off);
        } else {
        float ps = 0.f;
#pragma unroll
        for (int r = 0; r < 16; ++r) { p1[r] = __builtin_amdgcn_exp2f(p1[r] + off); ps += p0[r] + p1[r]; }
        { auto rr = __builtin_amdgcn_permlane32_swap(__float_as_uint(ps), __float_as_uint(ps), false, false); ps = __uint_as_float(rr[0]) + __uint_as_float(rr[1]); }
        l_run = l_run * al + ps; }
#define PK4(P, BASE, OUT) do { const unsigned a0_ = cvtpk_s(P[BASE + 0], P[BASE + 1]), a1_ = cvtpk_s(P[BASE + 2], P[BASE + 3]);   \
    const unsigned b0_ = cvtpk_s(P[BASE + 4], P[BASE + 5]), b1_ = cvtpk_s(P[BASE + 6], P[BASE + 7]);                              \
    auto r0_ = __builtin_amdgcn_permlane32_swap(a0_, b0_, false, false); auto r1_ = __builtin_amdgcn_permlane32_swap(a1_, b1_, false, false); \
    v4u w_ = {r0_[0], r1_[0], r0_[1], r1_[1]}; OUT = __builtin_bit_cast(bf16x8, w_); } while (0)
#define PK4N(P, BASE, OUT) do { v4u w_ = {cvtpk_s(P[BASE + 0], P[BASE + 1]), cvtpk_s(P[BASE + 2], P[BASE + 3]), cvtpk_s(P[BASE + 4], P[BASE + 5]), cvtpk_s(P[BASE + 6], P[BASE + 7])}; OUT = __builtin_bit_cast(bf16x8, w_); } while (0)
        if constexpr (NOSWAP) { PK4N(p0, 0, pa[0]); PK4N(p0, 8, pa[1]); PK4N(p1, 0, pa[2]); PK4N(p1, 8, pa[3]); }
        else { PK4(p0, 0, pa[0]); PK4(p0, 8, pa[1]); PK4(p1, 0, pa[2]); PK4(p1, 8, pa[3]); }
#undef PK4N
#undef PK4
    };
    constexpr int NQ = NS / 2, NG = NQ + ND;
    f32x16 p0, p1; bf16x8 pa[4];
    auto load_grp = [&](int g, bf16x8 (&f)[4], int kb_, int vb_) {
        if (g >= ND) { const LAS unsigned char* Ks = lds + A_KOFF + kb_ * KB + kbase + 64 * (g - ND);
            f[0] = *(const LAS bf16x8*)(Ks); f[1] = *(const LAS bf16x8*)(Ks + 32 * PK); f[2] = *(const LAS bf16x8*)(Ks + 32); f[3] = *(const LAS bf16x8*)(Ks + 32 * PK + 32); }
        else { const LAS unsigned char* Vs = lds + A_VOFF + vb_ * VB + vbase + g * 64;
#pragma unroll
            for (int ks = 0; ks < 4; ++ks) {
                const s16x4 lo = __builtin_bit_cast(s16x4, __builtin_amdgcn_ds_read_tr16_b64_v4i16((LAS v4i16_t*)(Vs + ks * 16 * PV)));
                const s16x4 h4 = __builtin_bit_cast(s16x4, __builtin_amdgcn_ds_read_tr16_b64_v4i16((LAS v4i16_t*)(Vs + ks * 16 * PV + VH4 * PV)));
                f[ks] = (bf16x8){lo[0], lo[1], lo[2], lo[3], h4[0], h4[1], h4[2], h4[3]}; } }
    };
    auto mfma_grp = [&](int g, const bf16x8 (&f)[4]) {
        if (g >= ND) { const int q_ = g - ND;
            if (q_ == 0) { p0 = __builtin_amdgcn_mfma_f32_32x32x16_bf16(f[0], qr[0], (f32x16){}, 0, 0, 0); p1 = __builtin_amdgcn_mfma_f32_32x32x16_bf16(f[1], qr[0], (f32x16){}, 0, 0, 0); }
            else { p0 = __builtin_amdgcn_mfma_f32_32x32x16_bf16(f[0], qr[2 * q_], p0, 0, 0, 0); p1 = __builtin_amdgcn_mfma_f32_32x32x16_bf16(f[1], qr[2 * q_], p1, 0, 0, 0); }
            p0 = __builtin_amdgcn_mfma_f32_32x32x16_bf16(f[2], qr[2 * q_ + 1], p0, 0, 0, 0); p1 = __builtin_amdgcn_mfma_f32_32x32x16_bf16(f[3], qr[2 * q_ + 1], p1, 0, 0, 0);
        } else {
#pragma unroll
            for (int ks = 0; ks < 4; ++ks) o[g] = __builtin_amdgcn_mfma_f32_32x32x16_bf16(pa[ks], f[ks], o[g], 0, 0, 0);
            if constexpr (LSUM) { if (g == ND - 1) { const bf16x8 ones = {(short)0x3f80, (short)0x3f80, (short)0x3f80, (short)0x3f80, (short)0x3f80, (short)0x3f80, (short)0x3f80, (short)0x3f80};
#pragma unroll
                for (int ks = 0; ks < 4; ++ks) ol = __builtin_amdgcn_mfma_f32_32x32x16_bf16(pa[ks], ones, ol, 0, 0, 0); } }
        }
    };
    auto half_grp = [&](int g, int h_, int kb_, int vb_) {
        if (g >= ND) { const int s_ = 2 * (g - ND) + h_; const LAS unsigned char* Ks = lds + A_KOFF + kb_ * KB + kbase + 32 * s_;
            const bf16x8 b0 = *(const LAS bf16x8*)(Ks), b1 = *(const LAS bf16x8*)(Ks + 32 * PK);
            if (s_ == 0) { p0 = __builtin_amdgcn_mfma_f32_32x32x16_bf16(b0, qr[0], (f32x16){}, 0, 0, 0); p1 = __builtin_amdgcn_mfma_f32_32x32x16_bf16(b1, qr[0], (f32x16){}, 0, 0, 0); }
            else { p0 = __builtin_amdgcn_mfma_f32_32x32x16_bf16(b0, qr[s_], p0, 0, 0, 0); p1 = __builtin_amdgcn_mfma_f32_32x32x16_bf16(b1, qr[s_], p1, 0, 0, 0); } }
        else { const LAS unsigned char* Vs = lds + A_VOFF + vb_ * VB + vbase + g * 64;
#pragma unroll
            for (int k2 = 0; k2 < 2; ++k2) { const int ks = 2 * h_ + k2;
                const s16x4 lo = __builtin_bit_cast(s16x4, __builtin_amdgcn_ds_read_tr16_b64_v4i16((LAS v4i16_t*)(Vs + ks * 16 * PV)));
                const s16x4 h4 = __builtin_bit_cast(s16x4, __builtin_amdgcn_ds_read_tr16_b64_v4i16((LAS v4i16_t*)(Vs + ks * 16 * PV + VH4 * PV)));
                const bf16x8 vb = {lo[0], lo[1], lo[2], lo[3], h4[0], h4[1], h4[2], h4[3]};
                o[g] = __builtin_amdgcn_mfma_f32_32x32x16_bf16(pa[ks], vb, o[g], 0, 0, 0); } }
    };
    auto load_half = [&](int g, int h_, bf16x8 (&f)[2], int kb_, int vb_) {
        if (g >= ND) { const int s_ = 2 * (g - ND) + h_; const LAS unsigned char* Ks = lds + A_KOFF + kb_ * KB + kbase + 32 * s_;
            f[0] = *(const LAS bf16x8*)(Ks); f[1] = *(const LAS bf16x8*)(Ks + 32 * PK); }
        else { const LAS unsigned char* Vs = lds + A_VOFF + vb_ * VB + vbase + g * 64;
#pragma unroll
            for (int k2 = 0; k2 < 2; ++k2) { const int ks = 2 * h_ + k2;
                const s16x4 lo = __builtin_bit_cast(s16x4, __builtin_amdgcn_ds_read_tr16_b64_v4i16((LAS v4i16_t*)(Vs + ks * 16 * PV)));
                const s16x4 h4 = __builtin_bit_cast(s16x4, __builtin_amdgcn_ds_read_tr16_b64_v4i16((LAS v4i16_t*)(Vs + ks * 16 * PV + VH4 * PV)));
                f[k2] = (bf16x8){lo[0], lo[1], lo[2], lo[3], h4[0], h4[1], h4[2], h4[3]}; } }
    };
    auto mfma_half = [&](int g, int h_, const bf16x8 (&f)[2]) {
        if (g >= ND) { const int s_ = 2 * (g - ND) + h_;
            if (s_ == 0) { p0 = __builtin_amdgcn_mfma_f32_32x32x16_bf16(f[0], qr[0], (f32x16){}, 0, 0, 0); p1 = __builtin_amdgcn_mfma_f32_32x32x16_bf16(f[1], qr[0], (f32x16){}, 0, 0, 0); }
            else { p0 = __builtin_amdgcn_mfma_f32_32x32x16_bf16(f[0], qr[s_], p0, 0, 0, 0); p1 = __builtin_amdgcn_mfma_f32_32x32x16_bf16(f[1], qr[s_], p1, 0, 0, 0); } }
        else {
#pragma unroll
            for (int k2 = 0; k2 < 2; ++k2) o[g] = __builtin_amdgcn_mfma_f32_32x32x16_bf16(pa[2 * h_ + k2], f[k2], o[g], 0, 0, 0); }
    };
    bf16x8 hA[2], hB[2];
    bf16x8 fA[4], fB[4];
    constexpr bool PIPE = (MODE != MODE_MOBA);
#define HOOK_NONE(I) do { } while (0)
#define RUN_GROUPS(GS, GE, KBUF, VBUF) RUN_GROUPS_H(GS, GE, KBUF, VBUF, HOOK_NONE)
#define RUN_GROUPS_H(GS, GE, KBUF, VBUF, HOOK) do { \
        if constexpr (PIPE) { \
        load_grp(GS, fA, KBUF, VBUF); __builtin_amdgcn_sched_barrier(0); \
        _Pragma("unroll") for (int g_ = (GS); g_ < (GE); ++g_) { \
            if (g_ + 1 < (GE)) { if ((g_ - (GS)) & 1) load_grp(g_ + 1, fA, KBUF, VBUF); else load_grp(g_ + 1, fB, KBUF, VBUF); } \
            __builtin_amdgcn_sched_barrier(0); \
            if ((g_ - (GS)) & 1) mfma_grp(g_, fB); else mfma_grp(g_, fA); \
            __builtin_amdgcn_sched_barrier(0); \
            HOOK(g_ - (GS)); __builtin_amdgcn_sched_barrier(0); } \
        } else { \
        load_half(GS, 0, hA, KBUF, VBUF); __builtin_amdgcn_sched_barrier(0); \
        _Pragma("unroll") for (int g_ = (GS); g_ < (GE); ++g_) { \
            load_half(g_, 1, hB, KBUF, VBUF); __builtin_amdgcn_sched_barrier(0); mfma_half(g_, 0, hA); __builtin_amdgcn_sched_barrier(0); \
            if (g_ + 1 < (GE)) load_half(g_ + 1, 0, hA, KBUF, VBUF); __builtin_amdgcn_sched_barrier(0); mfma_half(g_, 1, hB); __builtin_amdgcn_sched_barrier(0); \
            HOOK(g_ - (GS)); __builtin_amdgcn_sched_barrier(0); } \
        } } while (0)
#define ABAR() do { asm volatile("s_waitcnt lgkmcnt(0)" ::: "memory"); __builtin_amdgcn_s_barrier(); } while (0)
    const int half = 1 - (wid >> 2);
    float off = 0.f, al = 1.f;
    int j = next_tile(-1), it = 0;
    int jn = next_tile(j), jnn = jn < NT ? next_tile(jn) : NT;
    constexpr bool EARLY = (MODE != MODE_MOBA);
    load_k(j); write_k(0);
    if constexpr (EARLY) { load_v(j); if (jn < NT) load_k(jn); }
    ABAR();
#define STAGE_IN()  do { if constexpr (EARLY) { write_v(it & 1); if (jn < NT) write_k((it & 1) ^ 1); if (jn < NT) { load_v(jn); if (jnn < NT) load_k(jnn); } } else { load_v(j); if (jn < NT) load_k(jn); } } while (0)
#define STAGE_HOOK(I) do { if constexpr (!EARLY) { if ((I) == 0) { load_v(j); if (jn < NT) load_k(jn); } } else { if ((I) == 0) { write_v(it & 1); if (jn < NT) write_k((it & 1) ^ 1); } if ((I) == 1) { if (jn < NT) { load_v(jn); if (jnn < NT) load_k(jnn); } } } } while (0)
#define STAGE_IN_L() do { } while (0)
#define STAGE_OUT() do { if constexpr (EARLY) { } else { write_v(it & 1); if (jn < NT) write_k((it & 1) ^ 1); } } while (0)
#define SOFTMAX()   do { partialSM(p0, p1, j, off, al); rescale(al); finishSM(p0, p1, off, al, pa); } while (0)
    if (half == 0) {
        STAGE_IN(); RUN_GROUPS(ND, NG, 0, 0); STAGE_OUT(); SOFTMAX(); ABAR();
        while (jn < NT) {
            j = jn; jn = jnn; jnn = jn < NT ? next_tile(jn) : NT; ++it;
            STAGE_IN_L(); RUN_GROUPS_H(0, NG, it & 1, (it & 1) ^ 1, STAGE_HOOK); STAGE_OUT();
            SOFTMAX(); ABAR();
        }
    } else {
        STAGE_IN(); RUN_GROUPS(ND, NG, 0, 0); STAGE_OUT(); ABAR();
        while (jn < NT) {
            SOFTMAX();
            j = jn; jn = jnn; jnn = jn < NT ? next_tile(jn) : NT; ++it;
            STAGE_IN_L(); RUN_GROUPS_H(0, NG, it & 1, (it & 1) ^ 1, STAGE_HOOK); STAGE_OUT();
            ABAR();
        }
        SOFTMAX();
    }
    { const int l2 = lane_now(); vbase = (VHI * (l2 >> 5) + ((l2 >> 2) & 3)) * PV + (16 * ((l2 >> 4) & 1) + 4 * (l2 & 3)) * 2; RUN_GROUPS(0, ND, 0, it & 1); }
#undef STAGE_IN
#undef STAGE_OUT
#undef STAGE_HOOK
#undef STAGE_IN_L
#undef RUN_GROUPS_H
#undef HOOK_NONE
#undef SOFTMAX
#undef ABAR
#undef RUN_GROUPS
    {
        const int l3 = lane_now(), c = l3 & 31, h3 = l3 >> 5;
        LAS float* ws_ = (LAS float*)(lds + A_WSCR + wid * 256);
        if (h3 == 0) ws_[32 + c] = l_run;
        LDS_WAIT();
#pragma unroll
        for (int g = 0; g < 4; ++g) { const f32x4 l4 = *(const LAS f32x4*)(ws_ + 32 + 8 * g + 4 * h3);
#pragma unroll
            for (int i = 0; i < 4; ++i) { const float rl = 1.f / (LSUM ? ol[4 * g + i] : l4[i]); const int row = a.qb * 256 + wid * 32 + 8 * g + 4 * h3 + i; bf16* orow = a.o + (size_t)row * a.ldo + c;
#pragma unroll
                for (int d = 0; d < ND; ++d) orow[32 * d] = (bf16)f2bf(o[d][4 * g + i] * rl); } }
    }
}
__device__ __forceinline__ int pop_unit(gu32* head, LAS unsigned* slot, int wave_s) {
    if (opaque_tid(wave_s) == 0) slot[0] = __hip_atomic_fetch_add(head, 1u, RLX_AGENT);
    __syncthreads();
    const int u = (int)slot[0];
    __syncthreads();
    return __builtin_amdgcn_readfirstlane(u);
}

__device__ __forceinline__ int next_unit_idx(int k_, int N, int G, int bx, gu32* head, LAS unsigned* slot, int wave_s) {
    if (G == 256 && 256 * (k_ + 1) < N) { __syncthreads(); const int base = 256 * k_; return (k_ & 1) ? base + 255 - bx : base + bx; }
    const int u = pop_unit(head, slot, wave_s);
    return G == 256 ? (N - 256) + u : u;
}

struct Args { const void* in[18]; float* out; unsigned char* ws; int ph_lo, ph_hi; };
typedef const __attribute__((address_space(4))) Args* KArgs;
__device__ __forceinline__ KArgs kargs() { KArgs p = (KArgs)__builtin_amdgcn_kernarg_segment_ptr(); asm volatile("" : "+s"(p)); return p; }
#define INP(k, type) ((const type*)A->in[k])
#define WSP(off, type) ((type*)(A->ws + (off)))
#define PHASE_VARS KArgs A = kargs(); const int tid = opaque_tid(wave0), lane = tid & 63, wave = __builtin_amdgcn_readfirstlane(tid >> 6); const int G = opaque_s(gridDim.x), bx = opaque_s(blockIdx.x); const int gw = bx * NWAVES + wave, NGW = G * NWAVES; (void)tid; (void)lane; (void)G; (void)bx; (void)gw; (void)NGW
__global__ void __launch_bounds__(NWAVES * 64, 2) trunk_fwd(Args args) {
    extern __shared__ __attribute__((aligned(16))) unsigned char lds_raw[];
    LAS unsigned char* lds = (LAS unsigned char*)lds_raw;
    volatile LAS unsigned* MISC = (volatile LAS unsigned*)(lds + MISC_OFF);
    int wave0 = __builtin_amdgcn_readfirstlane((int)threadIdx.x >> 6); asm volatile("" : "+s"(wave0));
    for (int u = threadIdx.x; u < (LDS_BYTES - RING_BYTES) / 4; u += NWAVES * 64) ((LAS unsigned*)(lds + RING_BYTES))[u] = 0u;
    __syncthreads();
    KArgs A0 = kargs();
    (void)xcd_barrier_post((unsigned*)((gu32*)(A0->ws + WS_CTL) + CW_BAR), MISC + 8);
#define GRID_BAR() do { KArgs Ab_ = kargs(); XcdBarrier b_; b_.bar = (unsigned*)((gu32*)(Ab_->ws + WS_CTL) + CW_BAR); b_.x = xb_xcc_id(); b_.st = (volatile LAS unsigned*)(lds + MISC_OFF) + 8; xcd_barrier(b_, opaque_tid(wave0)); } while (0)
#define PH_IN(p) ((p) >= kargs()->ph_lo && (p) < kargs()->ph_hi)
#define SEAM(p) do { if (PH_IN(p) && PH_IN((p) + 1)) GRID_BAR(); } while (0)
    if (PH_IN(0)) {
        PHASE_VARS;
        LAS float* scrw = (LAS float*)(lds + RING_OFF + wave * 16384);
        LayerW L{INP(7, float), INP(11, float), INP(13, float), INP(14, float), INP(15, float), INP(16, float), INP(17, float), INP(3, float), INP(5, float)};
        convert_weights(L, A->ws, scrw, gw, NGW, lane);
        const float* x_in = INP(0, float); bf16* xb = (bf16*)A->out; float* RS = WSP(WS_RS, float);
        for (int m = 4 * gw; m < T; m += 4 * NGW) cast_rows_rs<4>(x_in + (size_t)m * DM, xb + (size_t)m * DM, RS + m, lane);
        { const int* positions = INP(1, int); f32x2_t* ROPE = WSP(WS_ROPE, f32x2_t);
          for (int m4 = gw; m4 < T / 4; m4 += NGW) { const int tg = 4 * m4 + (lane >> 4), i = lane & 15; const float ang = (float)positions[tg] * powf(10000.f, -(float)i * (1.f / 16.f));
              ROPE[(size_t)tg * 16 + i] = (f32x2_t){cosf(ang), sinf(ang)}; } }
    }
    SEAM(0);

    for (int l = 0; l < DEPTH; ++l) {
        const int pb = 1 + 11 * l;
        if (PH_IN(pb + 0)) {
            PHASE_VARS;
            pg8::Gemm g{(const bf16*)A->out, WSP(WS_W1T, bf16), T, 3584, 1024, 1024}; pg8::StaticOrder S; S.init(T, 3584, G, bx);
            pg8::EpiBf16<0> E{WSP(WS_OA, bf16), 512, 512, SLOT, 0, nullptr, 0, WSP(WS_RS, float)};
            pg8::gemm_phase<pg8::EpiBf16<0>, pg8::StaticOrder, true, true>(lds + RING_OFF, g, S, E, wave0);
        }
        SEAM(pb + 0);
        if (PH_IN(pb + 1)) {
            PHASE_VARS;
            const float* qn = INP(10, float) + l * 256; const float* kvn = INP(12, float) + l * 128; const f32x2_t* ROPE = WSP(WS_ROPE, f32x2_t);
            bf16* OC = WSP(WS_OC, bf16); bf16* KR = WSP(WS_KR, bf16);
            for (int m = 4 * gw; m < T; m += 4 * NGW) mla_prep_rows<4>(OC + (size_t)m * 512, KR + (size_t)m * 32, qn, kvn, ROPE + (size_t)m * 16, lane);
        }
        SEAM(pb + 1);
        if (PH_IN(pb + 2)) {
            PHASE_VARS;
#pragma nounroll
            for (int st = 0; st < 2; ++st) {
            if (((st ^ bx) & 1) == 0) {
                __syncthreads();
                for (int c_ = bx; c_ < NB * 64; c_ += G) kmean_task(WSP(WS_MK, bf16), WSP(WS_KMEAN, float), c_ >> 6, (c_ >> 1) & 31, c_ & 1, (LAS float*)(lds + RING_OFF), tid);
            } else {
            pg8::Gemm g{WSP(WS_OC, bf16), WSP(WS_WQKV, bf16), T, 1792, 384, 512, 3, 256, 4, 2}; pg8::StaticOrder S; S.init(T, 1792, G, bx);
            pg8::EpiBf16<0> E{WSP(WS_Q, bf16), 768, 0, 0, 3, WSP(WS_KV, bf16), 1024, nullptr};
            pg8::gemm_phase<pg8::EpiBf16<0>, pg8::StaticOrder, true, true>(lds + RING_OFF, g, S, E, wave0);
            } }
        }
        SEAM(pb + 2);
        if (PH_IN(pb + 3)) {
            LAS unsigned* slot = (LAS unsigned*)(lds + A_SLOT);
            if constexpr (ATM & 1) for (int k_ = 0;; ++k_) {
                PHASE_VARS;
                const int u = next_unit_idx(k_, 512, G, bx, (gu32*)(A->ws + WS_CTL) + CW_QUEUE + 64 * (3 * l), slot, wave0); if (u >= 512) break;
                const int qb = 31 - (u >> 4), r = u & 15, b = r >> 2, h = r & 3; const size_t t0 = (size_t)b * SEQ;
                bf16* OB = WSP(WS_OB, bf16);
                AttnArgs a; a.q = OB + t0 * 512 + h * 128; a.ldq = 512; a.k = WSP(WS_MK, bf16) + t0 * 512 + h * 128; a.ldk = 512; a.k2 = nullptr; a.v = WSP(WS_MV, bf16) + t0 * 512 + h * 128; a.ldv = 512;
                a.o = OB + t0 * 512 + h * 128; a.ldo = 512; a.qb = qb; a.C = 0.08838834764831845f * LOG2E; a.bias = INP(2, float) + 4 + h; a.rope = nullptr; a.kmean = WSP(WS_KMEAN, float) + ((size_t)b * 4 + h) * 32 * 128;
                attn_unit<MODE_MOBA>(lds, a, wave0);
            }
            if constexpr (ATM & 2) for (int k_ = 0;; ++k_) {
                PHASE_VARS;
                const int u = next_unit_idx(k_, 1024, G, bx, (gu32*)(A->ws + WS_CTL) + CW_QUEUE + 64 * (3 * l + 1), slot, wave0); if (u >= 1024) break;
                const int qb = 31 - (u >> 5), r = u & 31, b = r >> 3, h = (r >> 1) & 3, mp = r & 1; const size_t t0 = (size_t)b * SEQ;
                AttnArgs a; a.q = WSP(WS_OA, bf16) + t0 * 512 + h * 128 + mp * 64; a.ldq = 512; a.k = WSP(WS_DK, bf16) + t0 * 512 + h * 128 + mp * 64; a.ldk = 512; a.k2 = nullptr; a.v = WSP(WS_DV, bf16) + t0 * 512 + h * 128; a.ldv = 512;
                a.o = WSP(WS_O12, bf16) + t0 * 1024 + (h * 2 + mp) * 128; a.ldo = 1024; a.qb = qb; a.C = 0.125f * LOG2E; a.bias = INP(2, float) + h; a.rope = nullptr; a.kmean = nullptr;
                attn_unit<MODE_DIFF>(lds, a, wave0);
            }
            if constexpr (ATM & 4) for (int k_ = 0;; ++k_) {
                PHASE_VARS;
                const int u = next_unit_idx(k_, 1024, G, bx, (gu32*)(A->ws + WS_CTL) + CW_QUEUE + 64 * (3 * l + 2), slot, wave0); if (u >= 1024) break;
                const int qb = 31 - (u >> 5), r = u & 31, b = r >> 3, h = r & 7; const size_t t0 = (size_t)b * SEQ;
                bf16* KVB = WSP(WS_KV, bf16);
                AttnArgs a; a.q = WSP(WS_Q, bf16) + t0 * 768 + h * 96; a.ldq = 768; a.k = KVB + t0 * 1024 + h * 128; a.ldk = 1024; a.k2 = WSP(WS_KR, bf16) + t0 * 32; a.v = KVB + t0 * 1024 + h * 128 + 64; a.ldv = 1024;
                a.o = WSP(WS_OC, bf16) + t0 * 512 + h * 64; a.ldo = 512; a.qb = qb; a.C = 0.10206207261596577f * LOG2E; a.bias = nullptr; a.rope = WSP(WS_ROPE, f32x2_t) + t0 * 16; a.kmean = nullptr;
                attn_unit<MODE_MLA>(lds, a, wave0);
            }
        }
        SEAM(pb + 3);
        if (PH_IN(pb + 4)) {
            PHASE_VARS;
#pragma nounroll
            for (int st = 0; st < 2; ++st) {
            if (((st ^ bx) & 1) == 0) {
                const float lam_init = 0.8f - 0.6f * expf(-0.3f * (float)l);
                const float* dl = INP(8, float) + l * 256;
                const float lam = expf(wave_sum(dl[lane] * dl[64 + lane], lane)) - expf(wave_sum(dl[128 + lane] * dl[192 + lane], lane)) + lam_init;
                const bf16* O12 = WSP(WS_O12, bf16); bf16* OA = WSP(WS_OA, bf16); const float* subln = INP(9, float) + l * 128;
                for (int m = gw; m < T; m += NGW) diff_combine_row(O12 + (size_t)m * 1024, OA + (size_t)m * 512, subln, lam, 1.f - lam_init, lane);
            } else {
            pg8::Gemm g{(const bf16*)A->out, WSP(WS_WGT, bf16), T, 3072, 1024, 1024}; pg8::StaticOrder S; S.init(T, 3072, G, bx);
            pg8::EpiBf16<2> E{WSP(WS_S, bf16), 3072, 0, 0, 0, nullptr, 0, WSP(WS_RS, float)};
            pg8::gemm_phase<pg8::EpiBf16<2>, pg8::StaticOrder, true, true>(lds + RING_OFF, g, S, E, wave0);
            } }
        }
        SEAM(pb + 4);
        if (PH_IN(pb + 5)) {
            PHASE_VARS;
            pg8::Gemm g{WSP(WS_OA, bf16), WSP(WS_WBT, bf16), 3 * T, 3 * 1024, 512, 512}; pg8::BranchOrder S; S.init(T, G, bx);
            pg8::EpiBranch E{WSP(WS_S, bf16), WSP(WS_H, bf16)};
            pg8::gemm_phase<pg8::EpiBranch, pg8::BranchOrder, true, true>(lds + RING_OFF, g, S, E, wave0);
        }
        SEAM(pb + 5);
        if (PH_IN(pb + 6)) {
            PHASE_VARS;
            pg8::Gemm g{WSP(WS_H, bf16), WSP(WS_WOT, bf16), T, 1024, 1024, 1024}; pg8::StaticOrder S; S.init(T, 1024, G, bx);
            pg8::EpiBf16<0> E{WSP(WS_Y, bf16), 1024, 0, 0, 0, nullptr, 0, nullptr};
            pg8::gemm_phase<pg8::EpiBf16<0>, pg8::StaticOrder, true, true>(lds + RING_OFF, g, S, E, wave0);
        }
        SEAM(pb + 6);
        if (PH_IN(pb + 7)) {
            PHASE_VARS;
            bf16* xb = (bf16*)A->out; bf16* xdst = (l == DEPTH - 1) ? WSP(WS_O12, bf16) : xb;
            const bf16* YB = WSP(WS_Y, bf16); float* RS = WSP(WS_RS, float); const float* wpost = INP(4, float) + l * DM;
            if (l == 0) { const float* xin = INP(0, float); for (int m = 2 * gw; m < T; m += 2 * NGW) resid_row2<true, false>(YB + (size_t)m * DM, xin + (size_t)m * DM, xdst + (size_t)m * DM, wpost, RS + m, lane); }
            else { for (int m = 2 * gw; m < T; m += 2 * NGW) resid_row2<false, false>(YB + (size_t)m * DM, xb + (size_t)m * DM, xdst + (size_t)m * DM, wpost, RS + m, lane); }
        }
        SEAM(pb + 7);
        if (PH_IN(pb + 8)) {
            PHASE_VARS;
            pg8::Gemm g{(l == DEPTH - 1) ? (const bf16*)WSP(WS_O12, bf16) : (const bf16*)A->out, WSP(WS_WUPT, bf16), T, 4096, 1024, 1024}; pg8::StaticOrder S; S.init(T, 4096, G, bx);
            pg8::EpiBf16<3> E{WSP(WS_U, bf16), 4096, 0, 0, 0, nullptr, 0, WSP(WS_RS, float)};
            pg8::gemm_phase<pg8::EpiBf16<3>, pg8::StaticOrder, true, true>(lds + RING_OFF, g, S, E, wave0);
        }
        SEAM(pb + 8);
        if (PH_IN(pb + 9)) {
            PHASE_VARS;
            pg8::Gemm g{WSP(WS_U, bf16), WSP(WS_WDNT, bf16), T, 1024, 4096, 4096}; pg8::StaticOrder S; S.init(T, 1024, G, bx);
            pg8::EpiBf16<0> E{WSP(WS_D, bf16), 1024, 0, 0, 0, nullptr, 0, nullptr};
            pg8::gemm_phase<pg8::EpiBf16<0>, pg8::StaticOrder, true, true>(lds + RING_OFF, g, S, E, wave0);
        }
        SEAM(pb + 9);
        if (PH_IN(pb + 10)) {
            PHASE_VARS;
            const bool more = (l + 1 < DEPTH);
            if (more) {
                const size_t n = (size_t)(l + 1);
                LAS float* scrw = (LAS float*)(lds + RING_OFF + wave * 16384);
                LayerW L{INP(7, float) + n * 1024 * DIN, INP(11, float) + n * 256 * 768, INP(13, float) + n * 128 * 1024, INP(14, float) + n * 3 * 512 * 1024,
                         INP(15, float) + n * 1024 * 1024, INP(16, float) + n * 1024 * 4096, INP(17, float) + n * 4096 * 1024, INP(3, float) + n * DM, INP(5, float) + n * DM};
                convert_weights(L, A->ws, scrw, gw, NGW, lane);
            }
            const bf16* DB = WSP(WS_D, bf16); float* RS = WSP(WS_RS, float);
            const float* wpost = INP(6, float) + l * DM;
            if (more) { bf16* xb = (bf16*)A->out; for (int m = 2 * gw; m < T; m += 2 * NGW) resid_row2<false, false>(DB + (size_t)m * DM, xb + (size_t)m * DM, xb + (size_t)m * DM, wpost, RS + m, lane); }
            else { const bf16* xsrc = WSP(WS_O12, bf16); float* xo = A->out; for (int m = 2 * gw; m < T; m += 2 * NGW) resid_row2<false, true>(DB + (size_t)m * DM, xsrc + (size_t)m * DM, xo + (size_t)m * DM, wpost, (float*)nullptr, lane); }
        }
        if (l + 1 < DEPTH) SEAM(pb + 10);
    }
}

extern "C" void kernel_launch(void* const* d_in, const int* in_sizes, int n_in, void* d_out, int out_size, void* d_ws, size_t ws_size, hipStream_t stream) {
    static int grid = 0;
    if (grid == 0) {
        if (n_in != 18 || in_sizes[0] != T * DM || out_size != T * DM || ws_size < WS_END) { fprintf(stderr, "kernel_launch: unexpected shapes (n_in %d, in0 %d, out %d, ws %zu, need %zu); nothing launched\n", n_in, n_in > 0 ? in_sizes[0] : -1, out_size, ws_size, (size_t)WS_END); grid = -1; return; }
        int dev = 0, cus = 0, per_cu = 0;
        if (hipGetDevice(&dev) != hipSuccess || hipDeviceGetAttribute(&cus, hipDeviceAttributeMultiprocessorCount, dev) != hipSuccess) { grid = -1; return; }
        if (hipFuncSetAttribute((const void*)trunk_fwd, hipFuncAttributeMaxDynamicSharedMemorySize, LDS_BYTES) != hipSuccess) { fprintf(stderr, "kernel_launch: hipFuncSetAttribute failed\n"); grid = -1; return; }
        if (hipOccupancyMaxActiveBlocksPerMultiprocessor(&per_cu, (const void*)trunk_fwd, NWAVES * 64, LDS_BYTES) != hipSuccess || per_cu < 1) { fprintf(stderr, "kernel_launch: occupancy query says %d blocks per CU\n", per_cu); }
        (void)hipGetLastError();
        grid = cus;
    }
    if (grid < 0) return;
    if (hipMemsetAsync((char*)d_ws + WS_CTL, 0, CTL_ZERO_BYTES, stream) != hipSuccess) return;
    Args a{};
    for (int i = 0; i < 18; ++i) a.in[i] = d_in[i];
    a.out = (float*)d_out; a.ws = (unsigned char*)d_ws;
    constexpr int NPH = 1 + 11 * DEPTH;
#ifndef N_LAUNCH
#define N_LAUNCH 1
#endif
    for (int li = 0; li < N_LAUNCH; ++li) {
        a.ph_lo = (N_LAUNCH == 1) ? 0 : li; a.ph_hi = (N_LAUNCH == 1) ? NPH : li + 1;
        hipLaunchKernelGGL(trunk_fwd, dim3(grid), dim3(NWAVES * 64), LDS_BYTES, stream, a);
        const hipError_t le = hipPeekAtLastError();
        if (le != hipSuccess) { fprintf(stderr, "kernel_launch: launch failed: %s\n", hipGetErrorName(le)); break; }
    }
}
```

```cpp
#include <hip/hip_runtime.h>
#include <cstdio>
#include <cstdint>
__device__ __forceinline__ int opaque_tid(int wave_s) { int l; asm volatile("v_mbcnt_lo_u32_b32 %0, -1, 0\n\tv_mbcnt_hi_u32_b32 %0, -1, %0" : "=v"(l)); return wave_s * 64 + l; }
__device__ __forceinline__ int opaque_s(int v) { asm volatile("" : "+s"(v)); return v; }
namespace pg8 {
#define PG8_LAS __attribute__((address_space(3)))
typedef unsigned short bf16_t;
typedef short bf16x8 __attribute__((ext_vector_type(8)));
typedef float f32x4 __attribute__((ext_vector_type(4)));
typedef unsigned u32x4 __attribute__((ext_vector_type(4)));
constexpr int BM = 256, BK = 64, HALF = 128, HTB = HALF * BK * 2  , STAGE_BYTES = 8 * HTB, NXCD = 8, WGM = 8;

__host__ __device__ __forceinline__ int lds_byte(int r, int c) { const int st = (r >> 4) * 2 + (c >> 5), rr = r & 15, cc = c & 31, ob = rr * 64 + cc * 2; return st * 1024 + (ob ^ (((ob >> 9) & 1) << 5)); }
__host__ __device__ __forceinline__ void stage_rc(int b, int& R, int& C) { const int st = b / 1024, sb = b % 1024, swz = sb ^ (((sb >> 9) & 1) << 5); R = (st >> 1) * 16 + swz / 64; C = (st & 1) * 32 + (swz % 64) / 2; }
__host__ __device__ __forceinline__ int perm32(int rho) { const int n = rho >> 4, i = rho & 15; return 8 * (i >> 2) + 4 * n + (i & 3); }

struct Unit { int pm, pn; };
struct Gemm { const bf16_t* A; const bf16_t* Bt; int M, N, K, lda; int split_pn = 0, k_hi = 0, nt_lo = 0, nt_hi = 0; };

struct StaticOrder {
    int nM, nN, nwg, G, c;
    __host__ __device__ void init(int M, int N, int G_, int c_) { nM = M / BM; nN = N / BM; nwg = nM * nN; G = G_; c = c_; }
    __host__ __device__ bool next(int i, Unit& u) const {
        const long L = (long)i * G + c; if (L >= nwg) return false;
        int wgid = (int)L; { const int q = nwg / NXCD, r = nwg % NXCD, xcd = wgid % NXCD, off = wgid / NXCD; wgid = (xcd < r ? xcd * (q + 1) : r * (q + 1) + (xcd - r) * q) + off; }
        const int nig = WGM * nN, gid = wgid / nig, fm = gid * WGM, gsz = (nM - fm) < WGM ? (nM - fm) : WGM;
        u.pm = fm + ((wgid % nig) % gsz); u.pn = (wgid % nig) / gsz; return true;
    }
    __device__ __forceinline__ void a_ready(const Unit&) const {}
    __device__ __forceinline__ void done(const Unit&) const {}
};

typedef float f32x2c __attribute__((ext_vector_type(2))); typedef __bf16 bf16x2c __attribute__((ext_vector_type(2)));
__device__ __forceinline__ unsigned cvt_pk_bf16(float lo, float hi) { f32x2c v = {lo, hi}; bf16x2c b = __builtin_convertvector(v, bf16x2c); return __builtin_bit_cast(unsigned, b); }
__device__ __forceinline__ float bf_lo(unsigned w) { return __builtin_bit_cast(float, w << 16); }
__device__ __forceinline__ float bf_hi(unsigned w) { return __builtin_bit_cast(float, w & 0xffff0000u); }
__device__ __forceinline__ float act_sigmoid(float v) { return __builtin_amdgcn_rcpf(1.f + __builtin_amdgcn_exp2f(-1.4426950408889634f * v)); }
__device__ __forceinline__ float act_relu2(float v) { const float r = fmaxf(v, 0.f); return r * r; }

template <int ACT  > struct EpiBf16 {
    static constexpr bool PERM = true, AFTER_DRAIN = false;
    bf16_t* O; int ldc; int split_cols; size_t split_stride; int pn2; bf16_t* O2; int ldc2; const float* rs;
    __device__ __forceinline__ void operator()(const f32x4 (&acc)[2][2][4][2], const Unit& u, int wr, int wc, int fr, int fq) const {
        const int row0 = u.pm * BM + wr * 64 + fr; int colt = u.pn * BM; bf16_t* base = O; int ldc = this->ldc;
        if (pn2 && u.pn >= pn2) { base = O2; ldc = ldc2; colt = (u.pn - pn2) * BM; }
        if (split_cols) { const int t = colt / split_cols; base += (size_t)t * split_stride; colt -= t * split_cols; }
        const int col0 = colt + wc * 32 + 8 * fq;
#pragma unroll
        for (int ai = 0; ai < 2; ++ai)
#pragma unroll
            for (int m = 0; m < 4; ++m) { bf16_t* rowp = base + (size_t)(row0 + ai * HALF + m * 16) * ldc + col0; const float rsc = rs ? rs[row0 + ai * HALF + m * 16] : 1.f;
#pragma unroll
                for (int bj = 0; bj < 2; ++bj) { f32x4 v0 = acc[ai][bj][m][0] * rsc, v1 = acc[ai][bj][m][1] * rsc;
                    if (ACT == 2) { v0 = (f32x4){act_sigmoid(v0[0]), act_sigmoid(v0[1]), act_sigmoid(v0[2]), act_sigmoid(v0[3])}; v1 = (f32x4){act_sigmoid(v1[0]), act_sigmoid(v1[1]), act_sigmoid(v1[2]), act_sigmoid(v1[3])}; }
                    if (ACT == 3) { v0 = (f32x4){act_relu2(v0[0]), act_relu2(v0[1]), act_relu2(v0[2]), act_relu2(v0[3])}; v1 = (f32x4){act_relu2(v1[0]), act_relu2(v1[1]), act_relu2(v1[2]), act_relu2(v1[3])}; }
                    u32x4 w; w.x = cvt_pk_bf16(v0[0], v0[1]); w.y = cvt_pk_bf16(v0[2], v0[3]); w.z = cvt_pk_bf16(v1[0], v1[1]); w.w = cvt_pk_bf16(v1[2], v1[3]);
                    *(u32x4*)(rowp + bj * HALF) = w; } }
    }
};

struct EpiGateU8 {
    static constexpr bool PERM = true, AFTER_DRAIN = false;
    unsigned char* O; int ldc; const float* rs;
    __device__ __forceinline__ void operator()(const f32x4 (&acc)[2][2][4][2], const Unit& u, int wr, int wc, int fr, int fq) const {
        const int row0 = u.pm * BM + wr * 64 + fr; const int col0 = u.pn * BM + wc * 32 + 8 * fq;
#pragma unroll
        for (int ai = 0; ai < 2; ++ai)
#pragma unroll
            for (int m = 0; m < 4; ++m) { unsigned char* rowp = O + (size_t)(row0 + ai * HALF + m * 16) * ldc + col0; const float rsc = rs[row0 + ai * HALF + m * 16];
#pragma unroll
                for (int bj = 0; bj < 2; ++bj) { const f32x4 v0 = acc[ai][bj][m][0] * rsc, v1 = acc[ai][bj][m][1] * rsc;
                    unsigned lo = 0u, hi = 0u;
                    lo = __builtin_amdgcn_cvt_pk_u8_f32(act_sigmoid(v0[0]) * 255.f, 0, lo); lo = __builtin_amdgcn_cvt_pk_u8_f32(act_sigmoid(v0[1]) * 255.f, 1, lo);
                    lo = __builtin_amdgcn_cvt_pk_u8_f32(act_sigmoid(v0[2]) * 255.f, 2, lo); lo = __builtin_amdgcn_cvt_pk_u8_f32(act_sigmoid(v0[3]) * 255.f, 3, lo);
                    hi = __builtin_amdgcn_cvt_pk_u8_f32(act_sigmoid(v1[0]) * 255.f, 0, hi); hi = __builtin_amdgcn_cvt_pk_u8_f32(act_sigmoid(v1[1]) * 255.f, 1, hi);
                    hi = __builtin_amdgcn_cvt_pk_u8_f32(act_sigmoid(v1[2]) * 255.f, 2, hi); hi = __builtin_amdgcn_cvt_pk_u8_f32(act_sigmoid(v1[3]) * 255.f, 3, hi);
                    typedef unsigned u32x2 __attribute__((ext_vector_type(2)));
                    *(u32x2*)(rowp + bj * HALF) = (u32x2){lo, hi}; } }
    }
};

struct EpiF32 {
    static constexpr bool PERM = true, AFTER_DRAIN = false;
    float* O; int ldc;
    __device__ __forceinline__ void operator()(const f32x4 (&acc)[2][2][4][2], const Unit& u, int wr, int wc, int fr, int fq) const {
        const int row0 = u.pm * BM + wr * 64 + fr; const int col0 = u.pn * BM + wc * 32 + 8 * fq;
#pragma unroll
        for (int ai = 0; ai < 2; ++ai)
#pragma unroll
            for (int m = 0; m < 4; ++m) { float* rowp = O + (size_t)(row0 + ai * HALF + m * 16) * ldc + col0;
#pragma unroll
                for (int bj = 0; bj < 2; ++bj) { *(f32x4*)(rowp + bj * HALF) = acc[ai][bj][m][0]; *(f32x4*)(rowp + bj * HALF + 4) = acc[ai][bj][m][1]; } }
    }
};

struct EpiBranch {
    static constexpr bool PERM = true, AFTER_DRAIN = false;
    const unsigned char* S; bf16_t* Mo;
    __device__ __forceinline__ void operator()(const f32x4 (&acc)[2][2][4][2], const Unit& u, int wr, int wc, int fr, int fq) const {
        const int g = u.pm >> 7, pm = u.pm & 127, pn = u.pn & 3;
        const int row0 = pm * BM + wr * 64 + fr; const int col0 = pn * BM + wc * 32 + 8 * fq;
#pragma unroll
        for (int ai = 0; ai < 2; ++ai)
#pragma unroll
            for (int m = 0; m < 4; ++m) { const size_t row = (size_t)(row0 + ai * HALF + m * 16);
#pragma unroll
                for (int bj = 0; bj < 2; ++bj) { const int col = col0 + bj * HALF;
                    typedef unsigned u32x2 __attribute__((ext_vector_type(2)));
                    const u32x2 sv = *(const u32x2*)(S + row * 3072 + g * 1024 + col);
                    const f32x4 v0 = acc[ai][bj][m][0] * (1.f / 255.f), v1 = acc[ai][bj][m][1] * (1.f / 255.f);
                    float r0 = (float)(sv.x & 0xffu) * v0[0], r1 = (float)((sv.x >> 8) & 0xffu) * v0[1], r2 = (float)((sv.x >> 16) & 0xffu) * v0[2], r3 = (float)(sv.x >> 24) * v0[3];
                    float r4 = (float)(sv.y & 0xffu) * v1[0], r5 = (float)((sv.y >> 8) & 0xffu) * v1[1], r6 = (float)((sv.y >> 16) & 0xffu) * v1[2], r7 = (float)(sv.y >> 24) * v1[3];
                    u32x4* dst = (u32x4*)(Mo + row * 1024 + col);
                    if (g > 0) { const u32x4 pv = *dst; r0 += bf_lo(pv.x); r1 += bf_hi(pv.x); r2 += bf_lo(pv.y); r3 += bf_hi(pv.y); r4 += bf_lo(pv.z); r5 += bf_hi(pv.z); r6 += bf_lo(pv.w); r7 += bf_hi(pv.w); }
                    u32x4 w; w.x = cvt_pk_bf16(r0, r1); w.y = cvt_pk_bf16(r2, r3); w.z = cvt_pk_bf16(r4, r5); w.w = cvt_pk_bf16(r6, r7);
                    *dst = w; } }
    }
};
struct BranchOrder {
    StaticOrder S0;
    __device__ void init(int M, int G_, int c_) { S0.init(M, 1024, G_, c_); }
    __device__ bool next(int i, Unit& u) const { Unit t; if (!S0.next(i / 3, t)) return false; const int g = i % 3; u.pm = g * 128 + t.pm; u.pn = g * 4 + t.pn; return true; }
    __device__ __forceinline__ void a_ready(const Unit&) const {}
    __device__ __forceinline__ void done(const Unit&) const {}
};

template <class Epi, class Sched, bool ALIGN_EPI = false, bool SP2 = false>
__device__ __forceinline__ void gemm_phase(PG8_LAS unsigned char* lds, const Gemm g, const Sched& S, const Epi& E, int wave_s) {
    const int tid = opaque_tid(wave_s), wid = __builtin_amdgcn_readfirstlane(tid >> 6), lane = tid & 63, wr = wid >> 2, wc = wid & 3, fr = lane & 15, fq = lane >> 4;
    const int K = g.K; int nt = g.split_pn ? 0 : K / BK;
    unsigned voffA[2], voffB[2];
#pragma unroll
    for (int i = 0; i < 2; ++i) { int R, C; stage_rc(tid * 16 + i * 8192, R, C); const int Rb = Epi::PERM ? ((R & ~31) + perm32(R & 31)) : R;
        voffA[i] = (unsigned)(R * g.lda + C) * 2u; voffB[i] = (unsigned)(Rb * K + C) * 2u; }
    const size_t kstep = (size_t)(BK * 2);
    const size_t hstep = (size_t)HALF * K * 2;
    const size_t tstep = 2 * hstep; const size_t hstepA = (size_t)HALF * g.lda * 2, tstepA = 2 * hstepA;
    const unsigned ldsw = (unsigned)wid * 1024u;
    const int aoff = lds_byte(wr * 64 + fr, fq * 8), boff = lds_byte(wc * 32 + fr, fq * 8);
#define PG8_SA(b, h) (((b) * 2 + (h)) * HTB)
#define PG8_SB(b, h) ((4 + (b) * 2 + (h)) * HTB)
#define PG8_STAGE(bufoff, gbase, voff) do { _Pragma("unroll") for (int _i = 0; _i < 2; ++_i) \
        __builtin_amdgcn_global_load_lds((const unsigned*)((const char*)(gbase) + (voff)[_i]), (PG8_LAS unsigned*)(lds + (bufoff) + ldsw + _i * 8192), 16, 0, 0); } while (0)
#define PG8_LDA(dst, b, h) do { _Pragma("unroll") for (int m = 0; m < 4; ++m) _Pragma("unroll") for (int k = 0; k < 2; ++k) dst[m][k] = *(const PG8_LAS bf16x8*)(lds + PG8_SA(b, h) + aoff + m * 2048 + k * 1024); } while (0)
#define PG8_LDB(dst, b, h) do { _Pragma("unroll") for (int n = 0; n < 2; ++n) _Pragma("unroll") for (int k = 0; k < 2; ++k) dst[n][k] = *(const PG8_LAS bf16x8*)(lds + PG8_SB(b, h) + boff + n * 2048 + k * 1024); } while (0)
#define PG8_MMA(ai, bj, At, Bt) do { __builtin_amdgcn_s_setprio(1); _Pragma("unroll") for (int m = 0; m < 4; ++m) _Pragma("unroll") for (int n = 0; n < 2; ++n) _Pragma("unroll") for (int k = 0; k < 2; ++k) \
        acc[ai][bj][m][n] = __builtin_amdgcn_mfma_f32_16x16x32_bf16(Bt[n][k], At[m][k], acc[ai][bj][m][n], 0, 0, 0); __builtin_amdgcn_s_setprio(0); } while (0)
#define PG8_WAIT_V(n) asm volatile("s_waitcnt vmcnt(" #n ")" ::: "memory")
#define PG8_WAIT_L(n) asm volatile("s_waitcnt lgkmcnt(" #n ")" ::: "memory")
#define PG8_BAR __builtin_amdgcn_s_barrier()
#define PG8_SCHED __builtin_amdgcn_sched_barrier(0)
    Unit cur, nxt; int ui = 0;
    if (!S.next(0, cur)) return;
    f32x4 acc[2][2][4][2];
#pragma unroll
    for (int a = 0; a < 2; ++a)
#pragma unroll
        for (int b = 0; b < 2; ++b)
#pragma unroll
            for (int m = 0; m < 4; ++m)
#pragma unroll
                for (int n = 0; n < 2; ++n) acc[a][b][m][n] = (f32x4){0.f, 0.f, 0.f, 0.f};
    bf16x8 At[4][2], B0[2][2], B1[2][2];
    const char* cA = (const char*)g.A + (size_t)cur.pm * tstepA; const char* cB = (const char*)g.Bt + (size_t)cur.pn * tstep;
    if (g.split_pn) { const bool hi_ = cur.pn >= g.split_pn; nt = hi_ ? g.nt_hi : g.nt_lo; if (hi_) { cA += (size_t)g.k_hi * 2; cB += (size_t)g.k_hi * 2; } }
    S.a_ready(cur);
    if constexpr (SP2) {
        PG8_STAGE(PG8_SB(0, 0), cB, voffB); PG8_STAGE(PG8_SB(0, 1), cB + hstep, voffB); PG8_STAGE(PG8_SA(0, 0), cA, voffA); PG8_STAGE(PG8_SA(0, 1), cA + hstepA, voffA);
        if (wr == 1) PG8_BAR;
        PG8_WAIT_V(2); PG8_BAR;
        PG8_STAGE(PG8_SB(1, 0), cB + kstep, voffB); PG8_STAGE(PG8_SA(1, 0), cA + kstep, voffA); PG8_STAGE(PG8_SB(1, 1), cB + hstep + kstep, voffB);
        PG8_WAIT_V(6); PG8_BAR;
    } else {
        PG8_STAGE(PG8_SB(0, 0), cB, voffB); PG8_STAGE(PG8_SA(0, 0), cA, voffA); PG8_STAGE(PG8_SB(0, 1), cB + hstep, voffB); PG8_STAGE(PG8_SA(0, 1), cA + hstepA, voffA);
        if (wr == 1) PG8_BAR;
        PG8_WAIT_V(4); PG8_BAR;
        PG8_STAGE(PG8_SB(1, 0), cB + kstep, voffB); PG8_STAGE(PG8_SA(1, 0), cA + kstep, voffA); PG8_STAGE(PG8_SB(1, 1), cB + hstep + kstep, voffB);
        PG8_WAIT_V(6); PG8_BAR;
    }
    for (;;) {
        const bool has_next = S.next(ui + 1, nxt);
        const char* nA = has_next ? (const char*)g.A + (size_t)nxt.pm * tstepA : cA; const char* nB = has_next ? (const char*)g.Bt + (size_t)nxt.pn * tstep : cB;
        int nt_nxt = nt;
        if (g.split_pn && has_next) { const bool hi_ = nxt.pn >= g.split_pn; nt_nxt = hi_ ? g.nt_hi : g.nt_lo; if (hi_) { nA += (size_t)g.k_hi * 2; nB += (size_t)g.k_hi * 2; } }
        for (int t = 0; t < nt; t += 2) {
            const bool last = (t == nt - 2);
            const char* a1 = cA + (size_t)(t + 1) * kstep;
            const char* a2 = last ? nA : cA + (size_t)(t + 2) * kstep; const char* b2 = last ? nB : cB + (size_t)(t + 2) * kstep;
            const char* a3 = a2 + kstep; const char* b3 = b2 + kstep;
            if (last && has_next) S.a_ready(nxt);
            if constexpr (SP2) {
            PG8_LDB(B0, 0, 0); PG8_LDB(B1, 0, 1); PG8_SCHED; PG8_LDA(At, 0, 0); PG8_STAGE(PG8_SA(1, 1), a1 + hstepA, voffA);
            PG8_WAIT_V(8); PG8_WAIT_L(0); PG8_BAR; PG8_MMA(0, 0, At, B0); PG8_MMA(0, 1, At, B1); PG8_BAR; PG8_SCHED;
            PG8_LDA(At, 0, 1); PG8_STAGE(PG8_SB(0, 0), b2, voffB); PG8_STAGE(PG8_SB(0, 1), b2 + hstep, voffB); PG8_STAGE(PG8_SA(0, 0), a2, voffA);
            PG8_WAIT_V(8); PG8_WAIT_L(0); PG8_BAR; PG8_MMA(1, 0, At, B0); PG8_MMA(1, 1, At, B1); PG8_BAR; PG8_SCHED;
            PG8_LDB(B0, 1, 0); PG8_LDB(B1, 1, 1); PG8_SCHED; PG8_LDA(At, 1, 0); PG8_STAGE(PG8_SA(0, 1), a2 + hstepA, voffA);
            PG8_WAIT_V(8); PG8_WAIT_L(0); PG8_BAR; PG8_MMA(0, 0, At, B0); PG8_MMA(0, 1, At, B1); PG8_BAR; PG8_SCHED;
            PG8_LDA(At, 1, 1); PG8_STAGE(PG8_SB(1, 0), b3, voffB); PG8_STAGE(PG8_SB(1, 1), b3 + hstep, voffB); PG8_STAGE(PG8_SA(1, 0), a3, voffA);
            PG8_WAIT_V(8); PG8_WAIT_L(0); PG8_BAR; PG8_MMA(1, 0, At, B0); PG8_MMA(1, 1, At, B1); PG8_BAR; PG8_SCHED;
            } else {
            PG8_LDB(B0, 0, 0); PG8_SCHED; PG8_LDA(At, 0, 0); PG8_STAGE(PG8_SA(1, 1), a1 + hstepA, voffA);
            PG8_WAIT_L(8); PG8_BAR; PG8_WAIT_L(0); PG8_MMA(0, 0, At, B0); PG8_BAR; PG8_SCHED;
            PG8_LDB(B1, 0, 1); PG8_STAGE(PG8_SB(0, 0), b2, voffB);
            PG8_BAR; PG8_WAIT_L(0); PG8_MMA(0, 1, At, B1); PG8_BAR;
            PG8_LDA(At, 0, 1); PG8_STAGE(PG8_SA(0, 0), a2, voffA);
            PG8_BAR; PG8_WAIT_L(0); PG8_MMA(1, 0, At, B0); PG8_BAR; PG8_SCHED;
            PG8_STAGE(PG8_SB(0, 1), b2 + hstep, voffB);
            PG8_WAIT_V(6); PG8_BAR; PG8_MMA(1, 1, At, B1); PG8_BAR;
            PG8_LDB(B0, 1, 0); PG8_SCHED; PG8_LDA(At, 1, 0); PG8_STAGE(PG8_SA(0, 1), a2 + hstepA, voffA);
            PG8_WAIT_L(8); PG8_BAR; PG8_WAIT_L(0); PG8_MMA(0, 0, At, B0); PG8_BAR; PG8_SCHED;
            PG8_LDB(B1, 1, 1); PG8_STAGE(PG8_SB(1, 0), b3, voffB);
            PG8_BAR; PG8_WAIT_L(0); PG8_MMA(0, 1, At, B1); PG8_BAR;
            PG8_LDA(At, 1, 1); PG8_STAGE(PG8_SA(1, 0), a3, voffA);
            PG8_BAR; PG8_WAIT_L(0); PG8_MMA(1, 0, At, B0); PG8_BAR; PG8_SCHED;
            PG8_STAGE(PG8_SB(1, 1), b3 + hstep, voffB);
            PG8_WAIT_V(6); PG8_BAR; PG8_MMA(1, 1, At, B1); PG8_BAR;
            }
        }
        if constexpr (ALIGN_EPI) { if (wr == 0) PG8_BAR; }
        if constexpr (!Epi::AFTER_DRAIN) { E(acc, cur, wr, wc, fr, fq); S.done(cur); }
        if (!has_next) break;
#pragma unroll
        for (int a = 0; a < 2; ++a)
#pragma unroll
            for (int b = 0; b < 2; ++b)
#pragma unroll
                for (int m = 0; m < 4; ++m)
#pragma unroll
                    for (int n = 0; n < 2; ++n) acc[a][b][m][n] = (f32x4){0.f, 0.f, 0.f, 0.f};
        cur = nxt; cA = nA; cB = nB; nt = nt_nxt; ++ui;
        if constexpr (ALIGN_EPI) { if (wr == 1) PG8_BAR; }
    }
    PG8_WAIT_V(0);
    if constexpr (!ALIGN_EPI) { if (wr == 0) PG8_BAR; }
    PG8_BAR;
    if constexpr (Epi::AFTER_DRAIN) { E.fused(acc, cur, wr, wc, fr, fq, lds, wid, lane); S.done(cur); }
#undef PG8_SA
#undef PG8_SB
#undef PG8_STAGE
#undef PG8_LDA
#undef PG8_LDB
#undef PG8_MMA
#undef PG8_WAIT_V
#undef PG8_WAIT_L
#undef PG8_BAR
#undef PG8_SCHED
}
}

constexpr int NB = 4, SEQ = 8192, DM = 1024, T = NB * SEQ, DEPTH = 4, DIN = 6560, DFF = 4096;
constexpr float RMS_EPS = 1e-6f;
#define N_LAUNCH 1
constexpr int NWAVES = 8;
#ifndef ATM
#define ATM 7
#endif
constexpr size_t MiB = 1u << 20;
constexpr size_t WS_CTL = 0, CTL_ZERO_BYTES = 65536;
constexpr size_t WS_RS = 768 * 1024;
constexpr size_t WS_KMEAN = 512 * 1024;
constexpr size_t WS_W1T = 1 * MiB, WS_WGT = 8 * MiB, WS_WQKV = 14 * MiB  , WS_WBT = 16 * MiB, WS_WOT = 19 * MiB, WS_WUPT = 21 * MiB, WS_WDNT = 29 * MiB;
constexpr size_t WS_H = 37 * MiB;
constexpr size_t WS_OA = 101 * MiB, WS_OB = 133 * MiB, WS_OC = 165 * MiB, WS_DK = 197 * MiB, WS_DV = 229 * MiB, WS_MK = 261 * MiB, WS_MV = 293 * MiB;
constexpr size_t WS_Q = 325 * MiB, WS_KV = 373 * MiB, WS_KR = 437 * MiB, WS_O12 = 439 * MiB;
constexpr size_t WS_ROPE = 503 * MiB, WS_END = 507 * MiB;
constexpr size_t WS_S = 197 * MiB;
constexpr size_t WS_Y = 197 * MiB;
constexpr size_t WS_U = 101 * MiB;
constexpr size_t WS_D = 373 * MiB;
constexpr size_t SLOT = (size_t)T * 512;
constexpr int CW_BAR = 4096;
constexpr int CW_QUEUE = 8192;

constexpr int RING_OFF = 0, RING_BYTES = 131072;
constexpr int MISC_OFF = RING_BYTES + 320;
constexpr int LDS_BYTES = 147456;
constexpr int A_KOFF = 0, A_VOFF = 34816, A_TAB = 96256, A_WSCR = 100352, A_KMEAN = 102400, A_SLOT = 118784;

#define GAS __attribute__((address_space(1)))
#define LAS __attribute__((address_space(3)))
typedef unsigned short bf16;
typedef unsigned v4u __attribute__((ext_vector_type(4)));
typedef unsigned v2u __attribute__((ext_vector_type(2)));
typedef float f32x4 __attribute__((ext_vector_type(4)));
typedef float f32x2_t __attribute__((ext_vector_type(2)));
typedef float f32x16 __attribute__((ext_vector_type(16)));
typedef short bf16x8 __attribute__((ext_vector_type(8)));
typedef short s16x4 __attribute__((ext_vector_type(4)));
typedef short v4i16_t __attribute__((ext_vector_type(4)));
typedef __bf16 bf16x2_t __attribute__((ext_vector_type(2)));
typedef GAS unsigned gu32;
#define RLX_AGENT __ATOMIC_RELAXED, __HIP_MEMORY_SCOPE_AGENT
#define LDS_WAIT() asm volatile("s_waitcnt lgkmcnt(0)" ::: "memory")
#define VM_WAIT() asm volatile("s_waitcnt vmcnt(0)" ::: "memory")
__device__ __forceinline__ unsigned f2bf(float f) { unsigned u = __builtin_bit_cast(unsigned, f); return (u + 0x7fffu + ((u >> 16) & 1u)) >> 16; }
__device__ __forceinline__ unsigned pk2(float lo, float hi) { return f2bf(lo) | (f2bf(hi) << 16); }
__device__ __forceinline__ unsigned cvtpk_s(float lo, float hi) { f32x2_t v = {lo, hi}; bf16x2_t b = __builtin_convertvector(v, bf16x2_t); return __builtin_bit_cast(unsigned, b); }
__device__ __forceinline__ float bflo(unsigned w) { return __builtin_bit_cast(float, w << 16); }
__device__ __forceinline__ float bfhi(unsigned w) { return __builtin_bit_cast(float, w & 0xffff0000u); }
__device__ __forceinline__ float bf2f(short s) { return __builtin_bit_cast(float, ((unsigned)(unsigned short)s) << 16); }

#define XB_TMO      128
#define XB_XCNT(j)  (256  + 64 * (j))
#define XB_XSUB(j)  (1280 + 64 * (j))
#define XB_XGEN(j)  (2304 + 64 * (j))
#define XB_TOP      3328
#define XB_TOPGEN   3392
#define XCD_BAR_WORDS 3456
#define XB_SPIN_CAP (1u << 20)

__device__ __forceinline__ unsigned xb_ld(unsigned* p)              { return __hip_atomic_load(p, __ATOMIC_RELAXED, __HIP_MEMORY_SCOPE_AGENT); }
__device__ __forceinline__ unsigned xb_add(unsigned* p, unsigned v) { return __hip_atomic_fetch_add(p, v, __ATOMIC_RELAXED, __HIP_MEMORY_SCOPE_AGENT); }
__device__ __forceinline__ unsigned xb_xcc_id() { return (unsigned)__builtin_amdgcn_s_getreg((3 << 11) | 20) & 0xFu; }
#define XB_SPIN(cond, bar) do { unsigned _sp = 0; while (cond) { __builtin_amdgcn_s_sleep(1); \
    if ((++_sp & 255u) == 0u) { if (xb_ld(&(bar)[XB_TMO])) break; if (_sp > XB_SPIN_CAP) { atomicAdd(&(bar)[XB_TMO], 1u); break; } } } } while (0)

struct XcdBarrier {
    unsigned* bar; unsigned x;
    volatile LAS unsigned* st;
};
__device__ __forceinline__ XcdBarrier xcd_barrier_post(unsigned* bar, volatile LAS unsigned* st) {
    XcdBarrier b; b.bar = bar; b.x = xb_xcc_id(); b.st = st;
    if (threadIdx.x == 0) (void)xb_add(&bar[XB_XCNT(b.x)], 1u);
    return b;
}
__device__ __forceinline__ void xcd_barrier_complete(unsigned* bar, unsigned x, unsigned& nloc, unsigned& nx) {
    const unsigned G = gridDim.x * gridDim.y * gridDim.z;
    unsigned sum, cnt, mine, sp = 0u;
    for (;;) {
        sum = 0u; cnt = 0u; mine = 0u;
#pragma unroll
        for (unsigned j = 0; j < 16; ++j) { const unsigned c = xb_ld(&bar[XB_XCNT(j)]); sum += c; cnt += (c > 0u) ? 1u : 0u; mine = (j == x) ? c : mine; }
        if (sum == G) break;
        __builtin_amdgcn_s_sleep(1);
        if ((++sp & 255u) == 0u) { if (xb_ld(&bar[XB_TMO])) break; if (sp > XB_SPIN_CAP) { atomicAdd(&bar[XB_TMO], 1u); break; } }
    }
    nloc = mine > 0u ? mine : 1u; nx = cnt > 0u ? cnt : 1u;
}
__device__ __forceinline__ void xcd_barrier(const XcdBarrier& b, int tid_) {
    asm volatile("s_waitcnt vmcnt(0)" ::: "memory");
    __syncthreads();
    if (tid_ == 0) {
        unsigned* bar = b.bar;
        __builtin_amdgcn_s_waitcnt(0);
        unsigned nloc = b.st[0], nx = b.st[1];
        if (nloc == 0u) { xcd_barrier_complete(bar, b.x, nloc, nx); b.st[0] = nloc; b.st[1] = nx; }
        const unsigned old = xb_add(&bar[XB_XSUB(b.x)], 1u);
        const unsigned gen = old / nloc;
        if (old + 1u == (gen + 1u) * nloc) {
            __builtin_amdgcn_fence(__ATOMIC_RELEASE, "agent");
            asm volatile("s_waitcnt vmcnt(0)" ::: "memory");
            const unsigned og = xb_add(&bar[XB_TOP], 1u);
            const unsigned tg = og / nx;
            if (og + 1u == (tg + 1u) * nx) xb_add(&bar[XB_TOPGEN], 1u);
            else XB_SPIN(xb_ld(&bar[XB_TOPGEN]) == tg, bar);
            __builtin_amdgcn_fence(__ATOMIC_ACQUIRE, "agent");
            xb_add(&bar[XB_XGEN(b.x)], 1u);
            asm volatile("s_waitcnt vmcnt(0)" ::: "memory");
        } else {
            XB_SPIN(xb_ld(&bar[XB_XGEN(b.x)]) == gen, bar);
            __builtin_amdgcn_fence(__ATOMIC_ACQUIRE, "agent");
            asm volatile("s_waitcnt vmcnt(0)" ::: "memory");
        }
    }
    __syncthreads();
}

__device__ __forceinline__ float shfl_xor_l(float v, int o, int lane) { return __builtin_bit_cast(float, __builtin_amdgcn_ds_bpermute((lane ^ o) << 2, __builtin_bit_cast(int, v))); }
__device__ __forceinline__ float wave_sum(float v, int lane) {
#pragma unroll
    for (int o = 1; o < 64; o <<= 1) v += shfl_xor_l(v, o, lane);
    return v;
}
__device__ __forceinline__ void tr_item(const float* W, int ldw, int k0, int n0, bf16* WT, int drow0, int Kd, int kd0, const float* ksc, LAS float* scr, int lane) {
    f32x4 v_[8]; float sc_[8];
#pragma unroll
    for (int i = 0; i < 8; ++i) { const int kk = 8 * i + (lane >> 3); v_[i] = *(const f32x4*)(W + (size_t)(k0 + kk) * ldw + n0 + 4 * (lane & 7)); sc_[i] = ksc ? ksc[k0 + kk] : 1.f; }
#pragma unroll
    for (int i = 0; i < 8; ++i) { const int kk = 8 * i + (lane >> 3); LAS float* d_ = scr + kk * 33 + 4 * (lane & 7);
        d_[0] = v_[i].x * sc_[i]; d_[1] = v_[i].y * sc_[i]; d_[2] = v_[i].z * sc_[i]; d_[3] = v_[i].w * sc_[i]; }
    LDS_WAIT(); asm volatile("" ::: "memory");
    const int c = lane & 7;
#pragma unroll
    for (int j = 0; j < 4; ++j) { const int n = (lane >> 3) + 8 * j; const LAS float* s = scr + (8 * c) * 33 + n;
        v4u o; o.x = pk2(s[0 * 33], s[1 * 33]); o.y = pk2(s[2 * 33], s[3 * 33]); o.z = pk2(s[4 * 33], s[5 * 33]); o.w = pk2(s[6 * 33], s[7 * 33]);
        *(v4u*)(WT + (size_t)(drow0 + n) * Kd + kd0 + k0 + 8 * c) = o; }
    LDS_WAIT(); asm volatile("" ::: "memory");
}
__device__ __forceinline__ void zero_item(bf16* WT, int drow0, int Kd, int k0, int lane) {
    const int c = lane & 7;
#pragma unroll
    for (int j = 0; j < 4; ++j) { const int n = (lane >> 3) + 8 * j; *(v4u*)(WT + (size_t)(drow0 + n) * Kd + k0 + 8 * c) = (v4u){0u, 0u, 0u, 0u}; }
}
__device__ __forceinline__ bool seg_item(int& r, const float* W, int ldw, int K, int n_src0, int n_count, bf16* WT, int drow0, int Kd, int kd0, const float* ksc, LAS float* scr, int lane) {
    const int nb = n_count / 32, cnt = (K / 64) * nb;
    if (r >= cnt) { r -= cnt; return false; }
    const int kb = r / nb, b = r % nb;
    tr_item(W, ldw, 64 * kb, n_src0 + 32 * b, WT, drow0 + 32 * b, Kd, kd0, ksc, scr, lane);
    return true;
}
struct LayerW { const float *w_in, *uq, *ukv, *wb, *wo, *wup, *wdn, *n_mix, *n_mlp; };
__device__ __forceinline__ void convert_weights(const LayerW& L, unsigned char* ws, LAS float* scr, int gw, int NGW, int lane) {
    bf16* W1T = (bf16*)(ws + WS_W1T); bf16* WGT = (bf16*)(ws + WS_WGT); bf16* WQKV = (bf16*)(ws + WS_WQKV);
    bf16* WBT = (bf16*)(ws + WS_WBT); bf16* WOT = (bf16*)(ws + WS_WOT); bf16* WUPT = (bf16*)(ws + WS_WUPT); bf16* WDNT = (bf16*)(ws + WS_WDNT);
    constexpr int N_TR = 16 * (16 * 6 + 13) + 16 * 96 + 4 * 24 + 2 * 32 + 3 * 8 * 32 + 16 * 32 + 16 * 128 + 64 * 32;
    constexpr int N_Z1 = 16 * 3, N_Z2 = 2 * 24, N_Z3 = 4 * 32;
    for (int it = gw; it < N_TR + N_Z1 + N_Z2 + N_Z3; it += NGW) {
        int r = it;
        if (seg_item(r, L.w_in, DIN, 1024, 0,    512, W1T, 0,    1024, 0, L.n_mix, scr, lane)) continue;
        if (seg_item(r, L.w_in, DIN, 1024, 1536, 512, W1T, 512,  1024, 0, L.n_mix, scr, lane)) continue;
        if (seg_item(r, L.w_in, DIN, 1024, 3072, 416, W1T, 1024, 1024, 0, L.n_mix, scr, lane)) continue;
        if (seg_item(r, L.w_in, DIN, 1024, 512,  512, W1T, 1536, 1024, 0, L.n_mix, scr, lane)) continue;
        if (seg_item(r, L.w_in, DIN, 1024, 1024, 512, W1T, 2048, 1024, 0, L.n_mix, scr, lane)) continue;
        if (seg_item(r, L.w_in, DIN, 1024, 2048, 512, W1T, 2560, 1024, 0, L.n_mix, scr, lane)) continue;
        if (seg_item(r, L.w_in, DIN, 1024, 2560, 512, W1T, 3072, 1024, 0, L.n_mix, scr, lane)) continue;
        if (seg_item(r, L.w_in, DIN, 1024, 3488, 3072, WGT, 0,   1024, 0, L.n_mix, scr, lane)) continue;
        if (seg_item(r, L.uq,  768,  256, 0, 768,  WQKV, 0,   384, 0,   nullptr, scr, lane)) continue;
        if (seg_item(r, L.ukv, 1024, 128, 0, 1024, WQKV, 768, 384, 256, nullptr, scr, lane)) continue;
        if (seg_item(r, L.wb,                     1024, 512, 0, 1024, WBT, 0,    512, 0, nullptr, scr, lane)) continue;
        if (seg_item(r, L.wb + (size_t)512 * 1024, 1024, 512, 0, 1024, WBT, 1024, 512, 0, nullptr, scr, lane)) continue;
        if (seg_item(r, L.wb + (size_t)1024 * 1024, 1024, 512, 0, 1024, WBT, 2048, 512, 0, nullptr, scr, lane)) continue;
        if (seg_item(r, L.wo,  1024, 1024, 0, 1024, WOT,  0, 1024, 0, nullptr, scr, lane)) continue;
        if (seg_item(r, L.wup, 4096, 1024, 0, 4096, WUPT, 0, 1024, 0, L.n_mlp, scr, lane)) continue;
        if (seg_item(r, L.wdn, 1024, 4096, 0, 1024, WDNT, 0, 4096, 0, nullptr, scr, lane)) continue;
        if (r < N_Z1) { zero_item(W1T, 1440 + 32 * (r % 3), 1024, 64 * (r / 3), lane); continue; } r -= N_Z1;
        if (r < N_Z2) { zero_item(WQKV, 32 * (r % 24), 384, 256 + 64 * (r / 24), lane); continue; } r -= N_Z2;
        { const int kb = r / 32; zero_item(WQKV, 768 + 32 * (r % 32), 384, 64 * kb, lane); }
    }
}
__device__ __forceinline__ void norm_row_bf16(const float* xrow, const float* w, bf16* orow, int lane) {
    const f32x4* xr = (const f32x4*)xrow + lane; const f32x4* wr = (const f32x4*)w + lane;
    f32x4 v[4]; float s = 0.f;
#pragma unroll
    for (int j = 0; j < 4; ++j) { v[j] = xr[64 * j]; s += (v[j].x * v[j].x + v[j].y * v[j].y) + (v[j].z * v[j].z + v[j].w * v[j].w); }
    const float rstd = 1.f / sqrtf(wave_sum(s, lane) * (1.f / 1024.f) + RMS_EPS);
    v2u* o8 = (v2u*)orow + lane;
#pragma unroll
    for (int j = 0; j < 4; ++j) { const f32x4 ww = wr[64 * j]; v2u o; o.x = pk2(v[j].x * rstd * ww.x, v[j].y * rstd * ww.y); o.y = pk2(v[j].z * rstd * ww.z, v[j].w * rstd * ww.w); o8[64 * j] = o; }
}
__device__ __forceinline__ void resid_row(const float* yrow, const float* xold, float* xout, const float* wpost, const float* wnext, bf16* hout, int lane) {
    const f32x4* yr = (const f32x4*)yrow + lane; const f32x4* xr = (const f32x4*)xold + lane; const f32x4* wp = (const f32x4*)wpost + lane;
    f32x4 y[4], x[4]; float s = 0.f;
#pragma unroll
    for (int j = 0; j < 4; ++j) { y[j] = yr[64 * j]; x[j] = xr[64 * j]; s += (y[j].x * y[j].x + y[j].y * y[j].y) + (y[j].z * y[j].z + y[j].w * y[j].w); }
    const float r1 = 1.f / sqrtf(wave_sum(s, lane) * (1.f / 1024.f) + RMS_EPS);
    float s2 = 0.f; f32x4* xo = (f32x4*)xout + lane;
#pragma unroll
    for (int j = 0; j < 4; ++j) { const f32x4 ww = wp[64 * j]; x[j] = x[j] + y[j] * r1 * ww; xo[64 * j] = x[j]; s2 += (x[j].x * x[j].x + x[j].y * x[j].y) + (x[j].z * x[j].z + x[j].w * x[j].w); }
    if (wnext) {
        const float r2 = 1.f / sqrtf(wave_sum(s2, lane) * (1.f / 1024.f) + RMS_EPS);
        const f32x4* wn = (const f32x4*)wnext + lane; v2u* o8 = (v2u*)hout + lane;
#pragma unroll
        for (int j = 0; j < 4; ++j) { const f32x4 ww = wn[64 * j]; v2u o; o.x = pk2(x[j].x * r2 * ww.x, x[j].y * r2 * ww.y); o.y = pk2(x[j].z * r2 * ww.z, x[j].w * r2 * ww.w); o8[64 * j] = o; }
    }
}
__device__ __forceinline__ void cast_row_rs(const float* xrow, bf16* orow, float* rs, int lane) {
    const f32x4* xr = (const f32x4*)xrow + lane; f32x4 v[4]; float s = 0.f;
#pragma unroll
    for (int j = 0; j < 4; ++j) { v[j] = xr[64 * j]; s += (v[j].x * v[j].x + v[j].y * v[j].y) + (v[j].z * v[j].z + v[j].w * v[j].w); }
    const float rstd = 1.f / sqrtf(wave_sum(s, lane) * (1.f / 1024.f) + RMS_EPS);
    v2u* o8 = (v2u*)orow + lane;
#pragma unroll
    for (int j = 0; j < 4; ++j) { v2u o; o.x = pk2(v[j].x, v[j].y); o.y = pk2(v[j].z, v[j].w); o8[64 * j] = o; }
    if (lane == 0) *rs = rstd;
}
template <int NR>
__device__ __forceinline__ void cast_rows_rs(const float* xrow0, bf16* orow0, float* rs0, int lane) {
    f32x4 v[NR][4]; float s[NR];
#pragma unroll
    for (int r = 0; r < NR; ++r)
#pragma unroll
        for (int j = 0; j < 4; ++j) v[r][j] = ((const f32x4*)(xrow0 + (size_t)r * DM) + lane)[64 * j];
#pragma unroll
    for (int r = 0; r < NR; ++r) { s[r] = 0.f;
#pragma unroll
        for (int j = 0; j < 4; ++j) s[r] += (v[r][j].x * v[r][j].x + v[r][j].y * v[r][j].y) + (v[r][j].z * v[r][j].z + v[r][j].w * v[r][j].w); }
#pragma unroll
    for (int o = 1; o < 64; o <<= 1) { float t[NR];
#pragma unroll
        for (int r = 0; r < NR; ++r) t[r] = shfl_xor_l(s[r], o, lane);
#pragma unroll
        for (int r = 0; r < NR; ++r) s[r] += t[r]; }
#pragma unroll
    for (int r = 0; r < NR; ++r) { v2u* o8 = (v2u*)(orow0 + (size_t)r * DM) + lane;
#pragma unroll
        for (int j = 0; j < 4; ++j) { v2u o; o.x = pk2(v[r][j].x, v[r][j].y); o.y = pk2(v[r][j].z, v[r][j].w); o8[64 * j] = o; }
        if (lane == 0) rs0[r] = 1.f / sqrtf(s[r] * (1.f / 1024.f) + RMS_EPS); }
}
template <bool XIN_F32, bool XOUT_F32>
__device__ __forceinline__ void resid_row2(const bf16* yrow, const void* xold_, void* xout_, const float* wpost, float* rsout, int lane) {
    const f32x4* wp = (const f32x4*)wpost + lane;
    f32x4 y[2][4], x[2][4]; float s[2] = {0.f, 0.f};
#pragma unroll
    for (int r = 0; r < 2; ++r) { const v2u* yr = (const v2u*)(yrow + r * DM) + lane;
#pragma unroll
        for (int j = 0; j < 4; ++j) { const v2u yw = yr[64 * j]; y[r][j] = (f32x4){bflo(yw.x), bfhi(yw.x), bflo(yw.y), bfhi(yw.y)};
            if constexpr (XIN_F32) x[r][j] = ((const f32x4*)((const float*)xold_ + r * DM) + lane)[64 * j];
            else { const v2u xw = ((const v2u*)((const bf16*)xold_ + r * DM) + lane)[64 * j]; x[r][j] = (f32x4){bflo(xw.x), bfhi(xw.x), bflo(xw.y), bfhi(xw.y)}; } } }
#pragma unroll
    for (int r = 0; r < 2; ++r)
#pragma unroll
        for (int j = 0; j < 4; ++j) s[r] += (y[r][j].x * y[r][j].x + y[r][j].y * y[r][j].y) + (y[r][j].z * y[r][j].z + y[r][j].w * y[r][j].w);
#pragma unroll
    for (int o = 1; o < 64; o <<= 1) { const float a = shfl_xor_l(s[0], o, lane), b = shfl_xor_l(s[1], o, lane); s[0] += a; s[1] += b; }
    float s2[2] = {0.f, 0.f};
#pragma unroll
    for (int r = 0; r < 2; ++r) { const float r1 = 1.f / sqrtf(s[r] * (1.f / 1024.f) + RMS_EPS);
#pragma unroll
        for (int j = 0; j < 4; ++j) { const f32x4 ww = wp[64 * j]; x[r][j] = x[r][j] + y[r][j] * r1 * ww;
            if constexpr (XOUT_F32) __builtin_nontemporal_store(x[r][j], (f32x4*)((float*)xout_ + r * DM) + lane + 64 * j);
            else { v2u o; o.x = pk2(x[r][j].x, x[r][j].y); o.y = pk2(x[r][j].z, x[r][j].w); ((v2u*)((bf16*)xout_ + r * DM) + lane)[64 * j] = o;
                   x[r][j] = (f32x4){bflo(o.x), bfhi(o.x), bflo(o.y), bfhi(o.y)}; }     s2[r] += (x[r][j].x * x[r][j].x + x[r][j].y * x[r][j].y) + (x[r][j].z * x[r][j].z + x[r][j].w * x[r][j].w); } }
    if (rsout) {
#pragma unroll
        for (int o = 1; o < 64; o <<= 1) { const float a = shfl_xor_l(s2[0], o, lane), b = shfl_xor_l(s2[1], o, lane); s2[0] += a; s2[1] += b; }
        if (lane == 0) { rsout[0] = 1.f / sqrtf(s2[0] * (1.f / 1024.f) + RMS_EPS); rsout[1] = 1.f / sqrtf(s2[1] * (1.f / 1024.f) + RMS_EPS); }
    }
}
__device__ __forceinline__ void mla_prep_row(bf16* p3row, bf16* krrow, const float* qn, const float* kvn, const f32x2_t* rope16, int lane) {
    const v4u raw = *((const v4u*)p3row + lane);
    float x[8] = {bflo(raw.x), bfhi(raw.x), bflo(raw.y), bfhi(raw.y), bflo(raw.z), bfhi(raw.z), bflo(raw.w), bfhi(raw.w)};
    float ss = 0.f;
#pragma unroll
    for (int j = 0; j < 8; ++j) ss += x[j] * x[j];
    const float sq = wave_sum(lane < 32 ? ss : 0.f, lane), skv = wave_sum((lane >= 32 && lane < 48) ? ss : 0.f, lane);
    const float rq = 1.f / sqrtf(sq * (1.f / 256.f) + RMS_EPS), rkv = 1.f / sqrtf(skv * (1.f / 128.f) + RMS_EPS);
    if (lane < 48) {
        const float r = lane < 32 ? rq : rkv; const float* wv = lane < 32 ? qn + 8 * lane : kvn + 8 * (lane - 32);
        const f32x4 w0 = *(const f32x4*)wv, w1 = *(const f32x4*)(wv + 4);
        v4u o; o.x = pk2(x[0] * r * w0.x, x[1] * r * w0.y); o.y = pk2(x[2] * r * w0.z, x[3] * r * w0.w); o.z = pk2(x[4] * r * w1.x, x[5] * r * w1.y); o.w = pk2(x[6] * r * w1.z, x[7] * r * w1.w);
        *((v4u*)p3row + lane) = o;
    }
    float part[8];
#pragma unroll
    for (int j = 0; j < 8; ++j) part[j] = shfl_xor_l(x[j], 2, lane);
    if (lane >= 48 && lane < 52) {
        const bool first = lane < 50; float y[8];
#pragma unroll
        for (int j = 0; j < 8; ++j) { const f32x2_t r_ = rope16[8 * (lane & 1) + j]; const float cs = r_.x, sn = r_.y;
            y[j] = first ? (x[j] * cs - part[j] * sn) : (x[j] * cs + part[j] * sn); }
        v4u o; o.x = pk2(y[0], y[1]); o.y = pk2(y[2], y[3]); o.z = pk2(y[4], y[5]); o.w = pk2(y[6], y[7]);
        *((v4u*)krrow + (lane - 48)) = o;
    }
}
template <int NR>
__device__ __forceinline__ void mla_prep_rows(bf16* p3row0, bf16* krrow0, const float* qn, const float* kvn, const f32x2_t* rope0, int lane) {
    v4u raw[NR]; f32x2_t rc[NR][8];
#pragma unroll
    for (int r = 0; r < NR; ++r) raw[r] = *((const v4u*)(p3row0 + (size_t)r * 512) + lane);
    const bool rl = (lane >= 48 && lane < 52);
    if (rl) {
#pragma unroll
        for (int r = 0; r < NR; ++r)
#pragma unroll
            for (int j = 0; j < 8; ++j) rc[r][j] = rope0[(size_t)r * 16 + 8 * (lane & 1) + j];
    }
    float x[NR][8], sq[NR], skv[NR];
#pragma unroll
    for (int r = 0; r < NR; ++r) { x[r][0] = bflo(raw[r].x); x[r][1] = bfhi(raw[r].x); x[r][2] = bflo(raw[r].y); x[r][3] = bfhi(raw[r].y); x[r][4] = bflo(raw[r].z); x[r][5] = bfhi(raw[r].z); x[r][6] = bflo(raw[r].w); x[r][7] = bfhi(raw[r].w);
        float ss = 0.f;
#pragma unroll
        for (int j = 0; j < 8; ++j) ss += x[r][j] * x[r][j];
        sq[r] = lane < 32 ? ss : 0.f; skv[r] = (lane >= 32 && lane < 48) ? ss : 0.f; }
#pragma unroll
    for (int o = 1; o < 64; o <<= 1) {
        float a[NR], b[NR];
#pragma unroll
        for (int r = 0; r < NR; ++r) { a[r] = shfl_xor_l(sq[r], o, lane); b[r] = shfl_xor_l(skv[r], o, lane); }
#pragma unroll
        for (int r = 0; r < NR; ++r) { sq[r] += a[r]; skv[r] += b[r]; }
    }
    const float* wv = lane < 32 ? qn + 8 * lane : kvn + 8 * ((lane - 32) & 15);
    const f32x4 w0 = *(const f32x4*)wv, w1 = *(const f32x4*)(wv + 4);
#pragma unroll
    for (int r = 0; r < NR; ++r) {
        const float rq = 1.f / sqrtf(sq[r] * (1.f / 256.f) + RMS_EPS), rkv = 1.f / sqrtf(skv[r] * (1.f / 128.f) + RMS_EPS);
        float part[8];
#pragma unroll
        for (int j = 0; j < 8; ++j) part[j] = shfl_xor_l(x[r][j], 2, lane);
        if (lane < 48) {
            const float rr = lane < 32 ? rq : rkv;
            v4u o; o.x = pk2(x[r][0] * rr * w0.x, x[r][1] * rr * w0.y); o.y = pk2(x[r][2] * rr * w0.z, x[r][3] * rr * w0.w); o.z = pk2(x[r][4] * rr * w1.x, x[r][5] * rr * w1.y); o.w = pk2(x[r][6] * rr * w1.z, x[r][7] * rr * w1.w);
            *((v4u*)(p3row0 + (size_t)r * 512) + lane) = o;
        }
        if (rl) {
            const bool first = lane < 50; float y[8];
#pragma unroll
            for (int j = 0; j < 8; ++j) { const float cs = rc[r][j].x, sn = rc[r][j].y; y[j] = first ? (x[r][j] * cs - part[j] * sn) : (x[r][j] * cs + part[j] * sn); }
            v4u o; o.x = pk2(y[0], y[1]); o.y = pk2(y[2], y[3]); o.z = pk2(y[4], y[5]); o.w = pk2(y[6], y[7]);
            *((v4u*)(krrow0 + (size_t)r * 32) + (lane - 48)) = o;
        }
    }
}
__device__ __forceinline__ void kmean_task(const bf16* MK, float* kmean, int b, int n, int half, LAS float* scr, int tid) {
    const int wave = tid >> 6, lane = tid & 63, hw = lane >> 5, cl = lane & 31, strm = wave * 2 + hw;
    float acc[8] = {0.f, 0.f, 0.f, 0.f, 0.f, 0.f, 0.f, 0.f};
    const bf16* base = MK + ((size_t)b * SEQ + (size_t)n * 256 + strm * 16) * 512 + half * 256 + cl * 8;
#pragma unroll
    for (int r = 0; r < 16; ++r) { const v4u w = *(const v4u*)(base + (size_t)r * 512);
        acc[0] += bflo(w.x); acc[1] += bfhi(w.x); acc[2] += bflo(w.y); acc[3] += bfhi(w.y); acc[4] += bflo(w.z); acc[5] += bfhi(w.z); acc[6] += bflo(w.w); acc[7] += bfhi(w.w); }
#pragma unroll
    for (int j = 0; j < 8; ++j) scr[strm * 256 + cl * 8 + j] = acc[j];
    __syncthreads();
    if (tid < 256) { float s = 0.f;
#pragma unroll
        for (int w = 0; w < 16; ++w) s += scr[w * 256 + tid];
        const int col = half * 256 + tid, h = col >> 7, d = col & 127;
        kmean[(((size_t)b * 4 + h) * 32 + n) * 128 + d] = s * (1.f / 256.f); }
    __syncthreads();
}
__device__ __forceinline__ void diff_combine_row(const bf16* o12row, bf16* oarow, const float* subln, float lam, float oscale, int lane) {
    const int h = lane >> 4, dc = lane & 15;
    const v4u a = *(const v4u*)(o12row + h * 256 + dc * 8), b = *(const v4u*)(o12row + h * 256 + 128 + dc * 8);
    float d[8] = {bflo(a.x) - lam * bflo(b.x), bfhi(a.x) - lam * bfhi(b.x), bflo(a.y) - lam * bflo(b.y), bfhi(a.y) - lam * bfhi(b.y),
                  bflo(a.z) - lam * bflo(b.z), bfhi(a.z) - lam * bfhi(b.z), bflo(a.w) - lam * bflo(b.w), bfhi(a.w) - lam * bfhi(b.w)};
    float ss = 0.f;
#pragma unroll
    for (int j = 0; j < 8; ++j) ss += d[j] * d[j];
#pragma unroll
    for (int o = 1; o < 16; o <<= 1) ss += shfl_xor_l(ss, o, lane);
    const float r = oscale / sqrtf(ss * (1.f / 128.f) + RMS_EPS);
    const f32x4 w0 = *(const f32x4*)(subln + dc * 8), w1 = *(const f32x4*)(subln + dc * 8 + 4);
    v4u o; o.x = pk2(d[0] * r * w0.x, d[1] * r * w0.y); o.y = pk2(d[2] * r * w0.z, d[3] * r * w0.w); o.z = pk2(d[4] * r * w1.x, d[5] * r * w1.y); o.w = pk2(d[6] * r * w1.z, d[7] * r * w1.w);
    *(v4u*)(oarow + h * 128 + dc * 8) = o;
}

__device__ __forceinline__ int crow(int r, int hi) { return (r & 3) + 8 * (r >> 2) + 4 * hi; }
__device__ __forceinline__ int t5_bucket(int n) {
    if (n < 16) return n;
    return 16 + (n >= 21) + (n >= 27) + (n >= 35) + (n >= 46) + (n >= 59) + (n >= 77) + (n >= 99) + (n >= 128) + (n >= 166) + (n >= 216) + (n >= 280) + (n >= 363) + (n >= 470) + (n >= 609) + (n >= 790);
}
constexpr float LOG2E = 1.4426950408889634f;
constexpr float NEGBIG = -3.0e38f, M_INIT = -1.0e30f;
enum { MODE_MLA = 0, MODE_DIFF = 1, MODE_MOBA = 2 };
struct AttnArgs {
    const bf16* q; int ldq;
    const bf16* k; int ldk;
    const bf16* k2;
    const bf16* v; int ldv;
    bf16* o; int ldo;
    int qb;
    float C;
    const float* bias;
    const f32x2_t* rope;
    const float* kmean;
};
template <int MODE> struct AttnCfg {
    static constexpr int DQK = MODE == MODE_MLA ? 96 : (MODE == MODE_DIFF ? 64 : 128);
    static constexpr int DV = MODE == MODE_MLA ? 64 : 128;
    static constexpr int PK = DQK * 2 + 16, PV = DV * 2 + 64;
    static constexpr int KB = 64 * PK, VB = 64 * PV;
    static constexpr int KCH = DQK / 8, VCH = DV / 8;
    static constexpr int NKC = 64 * KCH, NVC = 64 * VCH;
    static constexpr int KPT = (NKC + 511) / 512, VPT = (NVC + 511) / 512;
    static constexpr int NS = DQK / 16, ND = DV / 32;
};

template <int MODE>
__device__ __forceinline__ void attn_unit(LAS unsigned char* lds, const AttnArgs& a, int wave_s) {
    using C_ = AttnCfg<MODE>;
    constexpr int PK = C_::PK, PV = C_::PV, KB = C_::KB, VB = C_::VB, KCH = C_::KCH, VCH = C_::VCH, NKC = C_::NKC, KPT = C_::KPT, VPT = C_::VPT, NS = C_::NS, ND = C_::ND;
    constexpr float THR = 10.f;
    const int tid = opaque_tid(wave_s), wid = __builtin_amdgcn_readfirstlane(tid >> 6), lane = tid & 63, r32 = lane & 31, hi = lane >> 5;
    const int q0w = a.qb * 256 + wid * 32, qrow = q0w + r32;
    const int NT = 4 * (a.qb + 1);
    LAS float* tab = (LAS float*)(lds + A_TAB);
    LAS float* wscr = (LAS float*)(lds + A_WSCR + wid * 256);
    LAS unsigned* slot = (LAS unsigned*)(lds + A_SLOT);
    bf16x8 qr[NS];
#pragma unroll
    for (int s = 0; s < NS; ++s) qr[s] = *(const bf16x8*)(a.q + (size_t)qrow * a.ldq + 16 * s + 8 * hi);
    if constexpr (MODE == MODE_MLA) {
        const f32x2_t* rp_ = a.rope + (size_t)qrow * 16 + 8 * hi;
#pragma unroll
        for (int j = 0; j < 8; ++j) { const f32x2_t r_ = rp_[j]; const float cs = r_.x, sn = r_.y; const float x1 = bf2f(qr[4][j]), x2 = bf2f(qr[5][j]);
            qr[4][j] = (short)f2bf((x1 * cs - x2 * sn) * a.C); qr[5][j] = (short)f2bf((x2 * cs + x1 * sn) * a.C); }
#pragma unroll
        for (int s = 0; s < 4; ++s)
#pragma unroll
            for (int j = 0; j < 8; ++j) qr[s][j] = (short)f2bf(bf2f(qr[s][j]) * a.C);
    } else {
#pragma unroll
        for (int s = 0; s < NS; ++s)
#pragma unroll
            for (int j = 0; j < 8; ++j) qr[s][j] = (short)f2bf(bf2f(qr[s][j]) * a.C);
    }
    if constexpr (MODE != MODE_MLA) {
        for (int i = tid; i < 1024; i += 512) tab[i] = a.bias[t5_bucket(i) * 8] * LOG2E;
    }
    unsigned mask = 0xffffffffu, umask = 0xffffffffu, wmask = 0xffffffffu;
    if constexpr (MODE == MODE_MOBA) {
        LAS float* km = (LAS float*)(lds + A_KMEAN);
        { const f32x4* src = (const f32x4*)a.kmean + tid * 2; *((LAS f32x4*)km + tid * 2) = src[0]; *((LAS f32x4*)km + tid * 2 + 1) = src[1]; }
        if (tid < 9) slot[8 + tid] = 0u;
        __syncthreads();
        const int own = a.qb;
        float v0 = NEGBIG, v1 = NEGBIG, v2 = NEGBIG; int i0 = 32, i1 = 32, i2 = 32;
        for (int n = 0; n < own; ++n) {
            float g = 0.f;
#pragma unroll
            for (int s = 0; s < NS; ++s) { const f32x4 ka = *(const LAS f32x4*)(km + n * 128 + 16 * s + 8 * hi), kb = *(const LAS f32x4*)(km + n * 128 + 16 * s + 8 * hi + 4);
                g += bf2f(qr[s][0]) * ka.x + bf2f(qr[s][1]) * ka.y + bf2f(qr[s][2]) * ka.z + bf2f(qr[s][3]) * ka.w + bf2f(qr[s][4]) * kb.x + bf2f(qr[s][5]) * kb.y + bf2f(qr[s][6]) * kb.z + bf2f(qr[s][7]) * kb.w; }
            { auto rr = __builtin_amdgcn_permlane32_swap(__float_as_uint(g), __float_as_uint(g), false, false); g = __uint_as_float(rr[0]) + __uint_as_float(rr[1]); }
            if (g > v0) { v2 = v1; i2 = i1; v1 = v0; i1 = i0; v0 = g; i0 = n; }
            else if (g > v1) { v2 = v1; i2 = i1; v1 = g; i1 = n; }
            else if (g > v2) { v2 = g; i2 = n; }
        }
        mask = (1u << own) | (i0 < 32 ? (1u << i0) : 0u) | (i1 < 32 ? (1u << i1) : 0u) | (i2 < 32 ? (1u << i2) : 0u);
        __hip_atomic_fetch_or(slot + 8 + wid, mask, __ATOMIC_RELAXED, __HIP_MEMORY_SCOPE_WORKGROUP);
        __hip_atomic_fetch_or(slot + 16, mask, __ATOMIC_RELAXED, __HIP_MEMORY_SCOPE_WORKGROUP);
        __syncthreads();
        umask = slot[16]; wmask = slot[8 + wid];
        umask = __builtin_amdgcn_readfirstlane(umask); wmask = __builtin_amdgcn_readfirstlane(wmask);
    }
    bf16x8 kst[KPT], vst[VPT];
    unsigned kofs[KPT], vofs[VPT]; [[maybe_unused]] unsigned kstr[KPT];
#pragma unroll
    for (int i = 0; i < KPT; ++i) { const int id = tid + 512 * i; const int row = id / KCH, ch = id % KCH;
        if (MODE == MODE_MLA && ch >= 8) { kofs[i] = (unsigned)((const char*)a.k2 - (const char*)a.k) + row * 64 + (ch - 8) * 16; kstr[i] = 64 * 64; }
        else { kofs[i] = (unsigned)(row * a.ldk * 2 + ch * 16); kstr[i] = (unsigned)(64 * a.ldk * 2); } }
#pragma unroll
    for (int i = 0; i < VPT; ++i) { const int id = tid + 512 * i; const int row = id / VCH, ch = id % VCH; vofs[i] = (unsigned)(row * a.ldv * 2 + ch * 16); }
    auto load_k = [&](int j) {
#pragma unroll
        for (int i = 0; i < KPT; ++i) { const int id = tid + 512 * i;
            if ((NKC % 512 == 0) || id < NKC) {
                if constexpr (MODE == MODE_MLA) kst[i] = *(const bf16x8*)((const char*)a.k + (kofs[i] + __umul24((unsigned)j, kstr[i])));
                else kst[i] = *(const bf16x8*)((const char*)a.k + (size_t)j * (size_t)(64 * a.ldk * 2) + kofs[i]); } }
    };
    auto load_v = [&](int j) {
#pragma unroll
        for (int i = 0; i < VPT; ++i) vst[i] = *(const bf16x8*)((const char*)a.v + (size_t)j * (size_t)(64 * a.ldv * 2) + vofs[i]);
    };
    auto write_k = [&](int kb_) {
#pragma unroll
        for (int i = 0; i < KPT; ++i) { const int id = tid + 512 * i;
            if ((NKC % 512 == 0) || id < NKC) { const int row = id / KCH, ch = id % KCH; *(LAS bf16x8*)(lds + A_KOFF + kb_ * KB + row * PK + ch * 16) = kst[i]; } }
    };
    auto write_v = [&](int vb_) {
#pragma unroll
        for (int i = 0; i < VPT; ++i) { const int id = tid + 512 * i; const int row = id / VCH, ch = id % VCH; *(LAS bf16x8*)(lds + A_VOFF + vb_ * VB + row * PV + ch * 16) = vst[i]; }
    };
    auto next_tile = [&](int j) -> int {
        int jn = j + 1;
        if constexpr (MODE == MODE_MOBA) { while (jn < NT && !((umask >> (jn >> 2)) & 1u)) jn = (jn & ~3) + 4; }
        return jn;
    };
    auto need_tile = [&](int j) -> bool {
        bool need = (64 * j <= q0w + 31);
        if constexpr (MODE == MODE_MOBA) need = need && ((wmask >> (j >> 2)) & 1u);
        return need;
    };
    f32x16 o[ND];
#pragma unroll
    for (int d = 0; d < ND; ++d) o[d] = (f32x16){};
    float m_run = M_INIT, l_run = 0.f;
    const int kbase = r32 * PK + 16 * hi;
    constexpr bool NOSWAP = (MODE == MODE_MLA);
    constexpr int VHI = NOSWAP ? 4 : 8, VH4 = NOSWAP ? 8 : 4;
    int vbase = (VHI * hi + ((lane >> 2) & 3)) * PV + (16 * ((lane >> 4) & 1) + 4 * (lane & 3)) * 2;
    auto partialSM = [&](f32x16& p0, f32x16& p1, int j, float& off, float& al) {
        const int k0 = 64 * j, relq = qrow - k0, relmin = q0w - k0 - 63;
        const bool fast = (MODE == MODE_MLA) ? (relmin >= 0) : (relmin >= 790);
        float cb = 0.f;
        if (fast) { if constexpr (MODE != MODE_MLA) cb = tab[1023]; }
        else if ((MODE != MODE_MLA) && relmin >= 0) {
            const LAS float* tb = tab + (relq - 4 * hi - 59);
#pragma unroll
            for (int r = 0; r < 16; ++r) { const int c_ = (r & 3) + 8 * (r >> 2); p0[r] += tb[59 - c_]; p1[r] += tb[27 - c_]; }
        } else {
#pragma unroll
            for (int r = 0; r < 16; ++r) { const int rel0 = relq - crow(r, hi), rel1 = rel0 - 32;
                float t0 = p0[r], t1 = p1[r];
                if constexpr (MODE != MODE_MLA) { t0 += tab[min(max(rel0, 0), 1023)]; t1 += tab[min(max(rel1, 0), 1023)]; }
                p0[r] = rel0 < 0 ? NEGBIG : t0; p1[r] = rel1 < 0 ? NEGBIG : t1;
                if ((r & 3) == 3) __builtin_amdgcn_sched_barrier(0); }
        }
        if constexpr (MODE == MODE_MOBA) {
            const bool allowed = (mask >> (j >> 2)) & 1u;
#pragma unroll
            for (int r = 0; r < 16; ++r) { p0[r] = allowed ? p0[r] : NEGBIG; p1[r] = allowed ? p1[r] : NEGBIG; }
        }
        float pm = fmaxf(p0[0], p1[0]);
#pragma unroll
        for (int r = 1; r < 16; ++r) pm = fmaxf(fmaxf(pm, p0[r]), p1[r]);
        { auto rr = __builtin_amdgcn_permlane32_swap(__float_as_uint(pm), __float_as_uint(pm), false, false); pm = fmaxf(__uint_as_float(rr[0]), __uint_as_float(rr[1])); }
        pm += cb;
        if (__all(pm - m_run <= THR)) al = 1.f;
        else { const float mn = fmaxf(m_run, pm); al = __builtin_amdgcn_exp2f(m_run - mn); m_run = mn; }
        off = cb - m_run;
#pragma unroll
        for (int r = 0; r < 16; ++r) p0[r] = __builtin_amdgcn_exp2f(p0[r] + off);
    };
    auto lane_now = [&]() -> int { int ln; asm volatile("v_mbcnt_lo_u32_b32 %0, -1, 0\n\tv_mbcnt_hi_u32_b32 %0, -1, %0" : "=v"(ln)); return ln; };
    constexpr bool LSUM = (MODE == MODE_MLA);
    f32x16 ol = (f32x16){};
    auto rescale = [&](float al) {
        if (!__all(al == 1.f)) {
            const int ln = lane_now();
            LAS float* ws_ = (LAS float*)(lds + A_WSCR + wid * 256);
            if (ln < 32) ws_[ln] = al;
            LDS_WAIT();
#pragma unroll
            for (int g = 0; g < 4; ++g) { const f32x4 a4 = *(const LAS f32x4*)(ws_ + 8 * g + 4 * (ln >> 5));
#pragma unroll
                for (int d = 0; d < ND; ++d) { o[d][4 * g + 0] *= a4.x; o[d][4 * g + 1] *= a4.y; o[d][4 * g + 2] *= a4.z; o[d][4 * g + 3] *= a4.w; }
                if constexpr (LSUM) { ol[4 * g + 0] *= a4.x; ol[4 * g + 1] *= a4.y; ol[4 * g + 2] *= a4.z; ol[4 * g + 3] *= a4.w; } }
        }
    };
    auto finishSM = [&](f32x16& p0, f32x16& p1, float off, float al, bf16x8 (&pa)[4]) {
        if constexpr (LSUM) {
#pragma unroll
            for (int r = 0; r < 16; ++r) p1[r] = __builtin_amdgcn_exp2f(p1[r] + off);
        } else {
        float ps = 0.f;
#pragma unroll
        for (int r = 0; r < 16; ++r) { p1[r] = __builtin_amdgcn_exp2f(p1[r] + off); ps += p0[r] + p1[r]; }
        { auto rr = __builtin_amdgcn_permlane32_swap(__float_as_uint(ps), __float_as_uint(ps), false, false); ps = __uint_as_float(rr[0]) + __uint_as_float(rr[1]); }
        l_run = l_run * al + ps; }
#define PK4(P, BASE, OUT) do { const unsigned a0_ = cvtpk_s(P[BASE + 0], P[BASE + 1]), a1_ = cvtpk_s(P[BASE + 2], P[BASE + 3]);   \
    const unsigned b0_ = cvtpk_s(P[BASE + 4], P[BASE + 5]), b1_ = cvtpk_s(P[BASE + 6], P[BASE + 7]);                              \
    auto r0_ = __builtin_amdgcn_permlane32_swap(a0_, b0_, false, false); auto r1_ = __builtin_amdgcn_permlane32_swap(a1_, b1_, false, false); \
    v4u w_ = {r0_[0], r1_[0], r0_[1], r1_[1]}; OUT = __builtin_bit_cast(bf16x8, w_); } while (0)
#define PK4N(P, BASE, OUT) do { v4u w_ = {cvtpk_s(P[BASE + 0], P[BASE + 1]), cvtpk_s(P[BASE + 2], P[BASE + 3]), cvtpk_s(P[BASE + 4], P[BASE + 5]), cvtpk_s(P[BASE + 6], P[BASE + 7])}; OUT = __builtin_bit_cast(bf16x8, w_); } while (0)
        if constexpr (NOSWAP) { PK4N(p0, 0, pa[0]); PK4N(p0, 8, pa[1]); PK4N(p1, 0, pa[2]); PK4N(p1, 8, pa[3]); }
        else { PK4(p0, 0, pa[0]); PK4(p0, 8, pa[1]); PK4(p1, 0, pa[2]); PK4(p1, 8, pa[3]); }
#undef PK4N
#undef PK4
    };
    constexpr int NQ = NS / 2, NG = NQ + ND;
    f32x16 p0, p1; bf16x8 pa[4];
    auto load_grp = [&](int g, bf16x8 (&f)[4], int kb_, int vb_) {
        if (g >= ND) { const LAS unsigned char* Ks = lds + A_KOFF + kb_ * KB + kbase + 64 * (g - ND);
            f[0] = *(const LAS bf16x8*)(Ks); f[1] = *(const LAS bf16x8*)(Ks + 32 * PK); f[2] = *(const LAS bf16x8*)(Ks + 32); f[3] = *(const LAS bf16x8*)(Ks + 32 * PK + 32); }
        else { const LAS unsigned char* Vs = lds + A_VOFF + vb_ * VB + vbase + g * 64;
#pragma unroll
            for (int ks = 0; ks < 4; ++ks) {
                const s16x4 lo = __builtin_bit_cast(s16x4, __builtin_amdgcn_ds_read_tr16_b64_v4i16((LAS v4i16_t*)(Vs + ks * 16 * PV)));
                const s16x4 h4 = __builtin_bit_cast(s16x4, __builtin_amdgcn_ds_read_tr16_b64_v4i16((LAS v4i16_t*)(Vs + ks * 16 * PV + VH4 * PV)));
                f[ks] = (bf16x8){lo[0], lo[1], lo[2], lo[3], h4[0], h4[1], h4[2], h4[3]}; } }
    };
    auto mfma_grp = [&](int g, const bf16x8 (&f)[4]) {
        if (g >= ND) { const int q_ = g - ND;
            if (q_ == 0) { p0 = __builtin_amdgcn_mfma_f32_32x32x16_bf16(f[0], qr[0], (f32x16){}, 0, 0, 0); p1 = __builtin_amdgcn_mfma_f32_32x32x16_bf16(f[1], qr[0], (f32x16){}, 0, 0, 0); }
            else { p0 = __builtin_amdgcn_mfma_f32_32x32x16_bf16(f[0], qr[2 * q_], p0, 0, 0, 0); p1 = __builtin_amdgcn_mfma_f32_32x32x16_bf16(f[1], qr[2 * q_], p1, 0, 0, 0); }
            p0 = __builtin_amdgcn_mfma_f32_32x32x16_bf16(f[2], qr[2 * q_ + 1], p0, 0, 0, 0); p1 = __builtin_amdgcn_mfma_f32_32x32x16_bf16(f[3], qr[2 * q_ + 1], p1, 0, 0, 0);
        } else {
#pragma unroll
            for (int ks = 0; ks < 4; ++ks) o[g] = __builtin_amdgcn_mfma_f32_32x32x16_bf16(pa[ks], f[ks], o[g], 0, 0, 0);
            if constexpr (LSUM) { if (g == ND - 1) { const bf16x8 ones = {(short)0x3f80, (short)0x3f80, (short)0x3f80, (short)0x3f80, (short)0x3f80, (short)0x3f80, (short)0x3f80, (short)0x3f80};
#pragma unroll
                for (int ks = 0; ks < 4; ++ks) ol = __builtin_amdgcn_mfma_f32_32x32x16_bf16(pa[ks], ones, ol, 0, 0, 0); } }
        }
    };
    auto half_grp = [&](int g, int h_, int kb_, int vb_) {
        if (g >= ND) { const int s_ = 2 * (g - ND) + h_; const LAS unsigned char* Ks = lds + A_KOFF + kb_ * KB + kbase + 32 * s_;
            const bf16x8 b0 = *(const LAS bf16x8*)(Ks), b1 = *(const LAS bf16x8*)(Ks + 32 * PK);
            if (s_ == 0) { p0 = __builtin_amdgcn_mfma_f32_32x32x16_bf16(b0, qr[0], (f32x16){}, 0, 0, 0); p1 = __builtin_amdgcn_mfma_f32_32x32x16_bf16(b1, qr[0], (f32x16){}, 0, 0, 0); }
            else { p0 = __builtin_amdgcn_mfma_f32_32x32x16_bf16(b0, qr[s_], p0, 0, 0, 0); p1 = __builtin_amdgcn_mfma_f32_32x32x16_bf16(b1, qr[s_], p1, 0, 0, 0); } }
        else { const LAS unsigned char* Vs = lds + A_VOFF + vb_ * VB + vbase + g * 64;
#pragma unroll
            for (int k2 = 0; k2 < 2; ++k2) { const int ks = 2 * h_ + k2;
                const s16x4 lo = __builtin_bit_cast(s16x4, __builtin_amdgcn_ds_read_tr16_b64_v4i16((LAS v4i16_t*)(Vs + ks * 16 * PV)));
                const s16x4 h4 = __builtin_bit_cast(s16x4, __builtin_amdgcn_ds_read_tr16_b64_v4i16((LAS v4i16_t*)(Vs + ks * 16 * PV + VH4 * PV)));
                const bf16x8 vb = {lo[0], lo[1], lo[2], lo[3], h4[0], h4[1], h4[2], h4[3]};
                o[g] = __builtin_amdgcn_mfma_f32_32x32x16_bf16(pa[ks], vb, o[g], 0, 0, 0); } }
    };
    auto load_half = [&](int g, int h_, bf16x8 (&f)[2], int kb_, int vb_) {
        if (g >= ND) { const int s_ = 2 * (g - ND) + h_; const LAS unsigned char* Ks = lds + A_KOFF + kb_ * KB + kbase + 32 * s_;
            f[0] = *(const LAS bf16x8*)(Ks); f[1] = *(const LAS bf16x8*)(Ks + 32 * PK); }
        else { const LAS unsigned char* Vs = lds + A_VOFF + vb_ * VB + vbase + g * 64;
#pragma unroll
            for (int k2 = 0; k2 < 2; ++k2) { const int ks = 2 * h_ + k2;
                const s16x4 lo = __builtin_bit_cast(s16x4, __builtin_amdgcn_ds_read_tr16_b64_v4i16((LAS v4i16_t*)(Vs + ks * 16 * PV)));
                const s16x4 h4 = __builtin_bit_cast(s16x4, __builtin_amdgcn_ds_read_tr16_b64_v4i16((LAS v4i16_t*)(Vs + ks * 16 * PV + VH4 * PV)));
                f[k2] = (bf16x8){lo[0], lo[1], lo[2], lo[3], h4[0], h4[1], h4[2], h4[3]}; } }
    };
    auto mfma_half = [&](int g, int h_, const bf16x8 (&f)[2]) {
        if (g >= ND) { const int s_ = 2 * (g - ND) + h_;
            if (s_ == 0) { p0 = __builtin_amdgcn_mfma_f32_32x32x16_bf16(f[0], qr[0], (f32x16){}, 0, 0, 0); p1 = __builtin_amdgcn_mfma_f32_32x32x16_bf16(f[1], qr[0], (f32x16){}, 0, 0, 0); }
            else { p0 = __builtin_amdgcn_mfma_f32_32x32x16_bf16(f[0], qr[s_], p0, 0, 0, 0); p1 = __builtin_amdgcn_mfma_f32_32x32x16_bf16(f[1], qr[s_], p1, 0, 0, 0); } }
        else {
#pragma unroll
            for (int k2 = 0; k2 < 2; ++k2) o[g] = __builtin_amdgcn_mfma_f32_32x32x16_bf16(pa[2 * h_ + k2], f[k2], o[g], 0, 0, 0); }
    };
    bf16x8 hA[2], hB[2];
    bf16x8 fA[4], fB[4];
    constexpr bool PIPE = (MODE != MODE_MOBA);
#define HOOK_NONE(I) do { } while (0)
#define RUN_GROUPS(GS, GE, KBUF, VBUF) RUN_GROUPS_H(GS, GE, KBUF, VBUF, HOOK_NONE)
#define RUN_GROUPS_H(GS, GE, KBUF, VBUF, HOOK) do { \
        if constexpr (PIPE) { \
        load_grp(GS, fA, KBUF, VBUF); __builtin_amdgcn_sched_barrier(0); \
        _Pragma("unroll") for (int g_ = (GS); g_ < (GE); ++g_) { \
            if (g_ + 1 < (GE)) { if ((g_ - (GS)) & 1) load_grp(g_ + 1, fA, KBUF, VBUF); else load_grp(g_ + 1, fB, KBUF, VBUF); } \
            __builtin_amdgcn_sched_barrier(0); \
            if ((g_ - (GS)) & 1) mfma_grp(g_, fB); else mfma_grp(g_, fA); \
            __builtin_amdgcn_sched_barrier(0); \
            HOOK(g_ - (GS)); __builtin_amdgcn_sched_barrier(0); } \
        } else { \
        load_half(GS, 0, hA, KBUF, VBUF); __builtin_amdgcn_sched_barrier(0); \
        _Pragma("unroll") for (int g_ = (GS); g_ < (GE); ++g_) { \
            load_half(g_, 1, hB, KBUF, VBUF); __builtin_amdgcn_sched_barrier(0); mfma_half(g_, 0, hA); __builtin_amdgcn_sched_barrier(0); \
            if (g_ + 1 < (GE)) load_half(g_ + 1, 0, hA, KBUF, VBUF); __builtin_amdgcn_sched_barrier(0); mfma_half(g_, 1, hB); __builtin_amdgcn_sched_barrier(0); \
            HOOK(g_ - (GS)); __builtin_amdgcn_sched_barrier(0); } \
        } } while (0)
#define ABAR() do { asm volatile("s_waitcnt lgkmcnt(0)" ::: "memory"); __builtin_amdgcn_s_barrier(); } while (0)
    const int half = 1 - (wid >> 2);
    float off = 0.f, al = 1.f;
    int j = next_tile(-1), it = 0;
    int jn = next_tile(j), jnn = jn < NT ? next_tile(jn) : NT;
    constexpr bool EARLY = (MODE != MODE_MOBA);
    load_k(j); write_k(0);
    if constexpr (EARLY) { load_v(j); if (jn < NT) load_k(jn); }
    ABAR();
#define STAGE_IN()  do { if constexpr (EARLY) { write_v(it & 1); if (jn < NT) write_k((it & 1) ^ 1); if (jn < NT) { load_v(jn); if (jnn < NT) load_k(jnn); } } else { load_v(j); if (jn < NT) load_k(jn); } } while (0)
#define STAGE_HOOK(I) do { if constexpr (!EARLY) { if ((I) == 0) { load_v(j); if (jn < NT) load_k(jn); } } else { if ((I) == 0) { write_v(it & 1); if (jn < NT) write_k((it & 1) ^ 1); } if ((I) == 1) { if (jn < NT) { load_v(jn); if (jnn < NT) load_k(jnn); } } } } while (0)
#define STAGE_IN_L() do { } while (0)
#define STAGE_OUT() do { if constexpr (EARLY) { } else { write_v(it & 1); if (jn < NT) write_k((it & 1) ^ 1); } } while (0)
#define SOFTMAX()   do { partialSM(p0, p1, j, off, al); rescale(al); finishSM(p0, p1, off, al, pa); } while (0)
    if (half == 0) {
        STAGE_IN(); RUN_GROUPS(ND, NG, 0, 0); STAGE_OUT(); SOFTMAX(); ABAR();
        while (jn < NT) {
            j = jn; jn = jnn; jnn = jn < NT ? next_tile(jn) : NT; ++it;
            STAGE_IN_L(); RUN_GROUPS_H(0, NG, it & 1, (it & 1) ^ 1, STAGE_HOOK); STAGE_OUT();
            SOFTMAX(); ABAR();
        }
    } else {
        STAGE_IN(); RUN_GROUPS(ND, NG, 0, 0); STAGE_OUT(); ABAR();
        while (jn < NT) {
            SOFTMAX();
            j = jn; jn = jnn; jnn = jn < NT ? next_tile(jn) : NT; ++it;
            STAGE_IN_L(); RUN_GROUPS_H(0, NG, it & 1, (it & 1) ^ 1, STAGE_HOOK); STAGE_OUT();
            ABAR();
        }
        SOFTMAX();
    }
    { const int l2 = lane_now(); vbase = (VHI * (l2 >> 5) + ((l2 >> 2) & 3)) * PV + (16 * ((l2 >> 4) & 1) + 4 * (l2 & 3)) * 2; RUN_GROUPS(0, ND, 0, it & 1); }
#undef STAGE_IN
#undef STAGE_OUT
#undef STAGE_HOOK
#undef STAGE_IN_L
#undef RUN_GROUPS_H
#undef HOOK_NONE
#undef SOFTMAX
#undef ABAR
#undef RUN_GROUPS
    {
        const int l3 = lane_now(), c = l3 & 31, h3 = l3 >> 5;
        LAS float* ws_ = (LAS float*)(lds + A_WSCR + wid * 256);
        if (h3 == 0) ws_[32 + c] = l_run;
        LDS_WAIT();
#pragma unroll
        for (int g = 0; g < 4; ++g) { const f32x4 l4 = *(const LAS f32x4*)(ws_ + 32 + 8 * g + 4 * h3);
#pragma unroll
            for (int i = 0; i < 4; ++i) { const float rl = 1.f / (LSUM ? ol[4 * g + i] : l4[i]); const int row = a.qb * 256 + wid * 32 + 8 * g + 4 * h3 + i; bf16* orow = a.o + (size_t)row * a.ldo + c;
#pragma unroll
                for (int d = 0; d < ND; ++d) orow[32 * d] = (bf16)f2bf(o[d][4 * g + i] * rl); } }
    }
}
__device__ __forceinline__ int pop_unit(gu32* head, LAS unsigned* slot, int wave_s) {
    if (opaque_tid(wave_s) == 0) slot[0] = __hip_atomic_fetch_add(head, 1u, RLX_AGENT);
    __syncthreads();
    const int u = (int)slot[0];
    __syncthreads();
    return __builtin_amdgcn_readfirstlane(u);
}

__device__ __forceinline__ int next_unit_idx(int k_, int N, int G, int bx, gu32* head, LAS unsigned* slot, int wave_s) {
    if (G == 256 && 256 * (k_ + 1) < N) { __syncthreads(); const int base = 256 * k_; return (k_ & 1) ? base + 255 - bx : base + bx; }
    const int u = pop_unit(head, slot, wave_s);
    return G == 256 ? (N - 256) + u : u;
}

struct Args { const void* in[18]; float* out; unsigned char* ws; int ph_lo, ph_hi; };
typedef const __attribute__((address_space(4))) Args* KArgs;
__device__ __forceinline__ KArgs kargs() { KArgs p = (KArgs)__builtin_amdgcn_kernarg_segment_ptr(); asm volatile("" : "+s"(p)); return p; }
#define INP(k, type) ((const type*)A->in[k])
#define WSP(off, type) ((type*)(A->ws + (off)))
#define PHASE_VARS KArgs A = kargs(); const int tid = opaque_tid(wave0), lane = tid & 63, wave = __builtin_amdgcn_readfirstlane(tid >> 6); const int G = opaque_s(gridDim.x), bx = opaque_s(blockIdx.x); const int gw = bx * NWAVES + wave, NGW = G * NWAVES; (void)tid; (void)lane; (void)G; (void)bx; (void)gw; (void)NGW
__global__ void __launch_bounds__(NWAVES * 64, 2) trunk_fwd(Args args) {
    extern __shared__ __attribute__((aligned(16))) unsigned char lds_raw[];
    LAS unsigned char* lds = (LAS unsigned char*)lds_raw;
    volatile LAS unsigned* MISC = (volatile LAS unsigned*)(lds + MISC_OFF);
    int wave0 = __builtin_amdgcn_readfirstlane((int)threadIdx.x >> 6); asm volatile("" : "+s"(wave0));
    for (int u = threadIdx.x; u < (LDS_BYTES - RING_BYTES) / 4; u += NWAVES * 64) ((LAS unsigned*)(lds + RING_BYTES))[u] = 0u;
    __syncthreads();
    KArgs A0 = kargs();
    (void)xcd_barrier_post((unsigned*)((gu32*)(A0->ws + WS_CTL) + CW_BAR), MISC + 8);
#define GRID_BAR() do { KArgs Ab_ = kargs(); XcdBarrier b_; b_.bar = (unsigned*)((gu32*)(Ab_->ws + WS_CTL) + CW_BAR); b_.x = xb_xcc_id(); b_.st = (volatile LAS unsigned*)(lds + MISC_OFF) + 8; xcd_barrier(b_, opaque_tid(wave0)); } while (0)
#define PH_IN(p) ((p) >= kargs()->ph_lo && (p) < kargs()->ph_hi)
#define SEAM(p) do { if (PH_IN(p) && PH_IN((p) + 1)) GRID_BAR(); } while (0)
    if (PH_IN(0)) {
        PHASE_VARS;
        LAS float* scrw = (LAS float*)(lds + RING_OFF + wave * 16384);
        LayerW L{INP(7, float), INP(11, float), INP(13, float), INP(14, float), INP(15, float), INP(16, float), INP(17, float), INP(3, float), INP(5, float)};
        convert_weights(L, A->ws, scrw, gw, NGW, lane);
        const float* x_in = INP(0, float); bf16* xb = (bf16*)A->out; float* RS = WSP(WS_RS, float);
        for (int m = 4 * gw; m < T; m += 4 * NGW) cast_rows_rs<4>(x_in + (size_t)m * DM, xb + (size_t)m * DM, RS + m, lane);
        { const int* positions = INP(1, int); f32x2_t* ROPE = WSP(WS_ROPE, f32x2_t);
          for (int m4 = gw; m4 < T / 4; m4 += NGW) { const int tg = 4 * m4 + (lane >> 4), i = lane & 15; const float ang = (float)positions[tg] * powf(10000.f, -(float)i * (1.f / 16.f));
              ROPE[(size_t)tg * 16 + i] = (f32x2_t){cosf(ang), sinf(ang)}; } }
    }
    SEAM(0);

    for (int l = 0; l < DEPTH; ++l) {
        const int pb = 1 + 11 * l;
        if (PH_IN(pb + 0)) {
            PHASE_VARS;
            pg8::Gemm g{(const bf16*)A->out, WSP(WS_W1T, bf16), T, 3584, 1024, 1024}; pg8::StaticOrder S; S.init(T, 3584, G, bx);
            pg8::EpiBf16<0> E{WSP(WS_OA, bf16), 512, 512, SLOT, 0, nullptr, 0, WSP(WS_RS, float)};
            pg8::gemm_phase<pg8::EpiBf16<0>, pg8::StaticOrder, true, true>(lds + RING_OFF, g, S, E, wave0);
        }
        SEAM(pb + 0);
        if (PH_IN(pb + 1)) {
            PHASE_VARS;
            const float* qn = INP(10, float) + l * 256; const float* kvn = INP(12, float) + l * 128; const f32x2_t* ROPE = WSP(WS_ROPE, f32x2_t);
            bf16* OC = WSP(WS_OC, bf16); bf16* KR = WSP(WS_KR, bf16);
            for (int m = 4 * gw; m < T; m += 4 * NGW) mla_prep_rows<4>(OC + (size_t)m * 512, KR + (size_t)m * 32, qn, kvn, ROPE + (size_t)m * 16, lane);
        }
        SEAM(pb + 1);
        if (PH_IN(pb + 2)) {
            PHASE_VARS;
#pragma nounroll
            for (int st = 0; st < 2; ++st) {
            if (((st ^ bx) & 1) == 0) {
                __syncthreads();
                for (int c_ = bx; c_ < NB * 64; c_ += G) kmean_task(WSP(WS_MK, bf16), WSP(WS_KMEAN, float), c_ >> 6, (c_ >> 1) & 31, c_ & 1, (LAS float*)(lds + RING_OFF), tid);
            } else {
            pg8::Gemm g{WSP(WS_OC, bf16), WSP(WS_WQKV, bf16), T, 1792, 384, 512, 3, 256, 4, 2}; pg8::StaticOrder S; S.init(T, 1792, G, bx);
            pg8::EpiBf16<0> E{WSP(WS_Q, bf16), 768, 0, 0, 3, WSP(WS_KV, bf16), 1024, nullptr};
            pg8::gemm_phase<pg8::EpiBf16<0>, pg8::StaticOrder, true, true>(lds + RING_OFF, g, S, E, wave0);
            } }
        }
        SEAM(pb + 2);
        if (PH_IN(pb + 3)) {
            LAS unsigned* slot = (LAS unsigned*)(lds + A_SLOT);
            if constexpr (ATM & 1) for (int k_ = 0;; ++k_) {
                PHASE_VARS;
                const int u = next_unit_idx(k_, 512, G, bx, (gu32*)(A->ws + WS_CTL) + CW_QUEUE + 64 * (3 * l), slot, wave0); if (u >= 512) break;
                const int qb = 31 - (u >> 4), r = u & 15, b = r >> 2, h = r & 3; const size_t t0 = (size_t)b * SEQ;
                bf16* OB = WSP(WS_OB, bf16);
                AttnArgs a; a.q = OB + t0 * 512 + h * 128; a.ldq = 512; a.k = WSP(WS_MK, bf16) + t0 * 512 + h * 128; a.ldk = 512; a.k2 = nullptr; a.v = WSP(WS_MV, bf16) + t0 * 512 + h * 128; a.ldv = 512;
                a.o = OB + t0 * 512 + h * 128; a.ldo = 512; a.qb = qb; a.C = 0.08838834764831845f * LOG2E; a.bias = INP(2, float) + 4 + h; a.rope = nullptr; a.kmean = WSP(WS_KMEAN, float) + ((size_t)b * 4 + h) * 32 * 128;
                attn_unit<MODE_MOBA>(lds, a, wave0);
            }
            if constexpr (ATM & 2) for (int k_ = 0;; ++k_) {
                PHASE_VARS;
                const int u = next_unit_idx(k_, 1024, G, bx, (gu32*)(A->ws + WS_CTL) + CW_QUEUE + 64 * (3 * l + 1), slot, wave0); if (u >= 1024) break;
                const int qb = 31 - (u >> 5), r = u & 31, b = r >> 3, h = (r >> 1) & 3, mp = r & 1; const size_t t0 = (size_t)b * SEQ;
                AttnArgs a; a.q = WSP(WS_OA, bf16) + t0 * 512 + h * 128 + mp * 64; a.ldq = 512; a.k = WSP(WS_DK, bf16) + t0 * 512 + h * 128 + mp * 64; a.ldk = 512; a.k2 = nullptr; a.v = WSP(WS_DV, bf16) + t0 * 512 + h * 128; a.ldv = 512;
                a.o = WSP(WS_O12, bf16) + t0 * 1024 + (h * 2 + mp) * 128; a.ldo = 1024; a.qb = qb; a.C = 0.125f * LOG2E; a.bias = INP(2, float) + h; a.rope = nullptr; a.kmean = nullptr;
                attn_unit<MODE_DIFF>(lds, a, wave0);
            }
            if constexpr (ATM & 4) for (int k_ = 0;; ++k_) {
                PHASE_VARS;
                const int u = next_unit_idx(k_, 1024, G, bx, (gu32*)(A->ws + WS_CTL) + CW_QUEUE + 64 * (3 * l + 2), slot, wave0); if (u >= 1024) break;
                const int qb = 31 - (u >> 5), r = u & 31, b = r >> 3, h = r & 7; const size_t t0 = (size_t)b * SEQ;
                bf16* KVB = WSP(WS_KV, bf16);
                AttnArgs a; a.q = WSP(WS_Q, bf16) + t0 * 768 + h * 96; a.ldq = 768; a.k = KVB + t0 * 1024 + h * 128; a.ldk = 1024; a.k2 = WSP(WS_KR, bf16) + t0 * 32; a.v = KVB + t0 * 1024 + h * 128 + 64; a.ldv = 1024;
                a.o = WSP(WS_OC, bf16) + t0 * 512 + h * 64; a.ldo = 512; a.qb = qb; a.C = 0.10206207261596577f * LOG2E; a.bias = nullptr; a.rope = WSP(WS_ROPE, f32x2_t) + t0 * 16; a.kmean = nullptr;
                attn_unit<MODE_MLA>(lds, a, wave0);
            }
        }
        SEAM(pb + 3);
        if (PH_IN(pb + 4)) {
            PHASE_VARS;
#pragma nounroll
            for (int st = 0; st < 2; ++st) {
            if (((st ^ bx) & 1) == 0) {
                const float lam_init = 0.8f - 0.6f * expf(-0.3f * (float)l);
                const float* dl = INP(8, float) + l * 256;
                const float lam = expf(wave_sum(dl[lane] * dl[64 + lane], lane)) - expf(wave_sum(dl[128 + lane] * dl[192 + lane], lane)) + lam_init;
                const bf16* O12 = WSP(WS_O12, bf16); bf16* OA = WSP(WS_OA, bf16); const float* subln = INP(9, float) + l * 128;
                for (int m = gw; m < T; m += NGW) diff_combine_row(O12 + (size_t)m * 1024, OA + (size_t)m * 512, subln, lam, 1.f - lam_init, lane);
            } else {
            pg8::Gemm g{(const bf16*)A->out, WSP(WS_WGT, bf16), T, 3072, 1024, 1024}; pg8::StaticOrder S; S.init(T, 3072, G, bx);
            pg8::EpiGateU8 E{WSP(WS_S, unsigned char), 3072, WSP(WS_RS, float)};
            pg8::gemm_phase<pg8::EpiGateU8, pg8::StaticOrder, true, true>(lds + RING_OFF, g, S, E, wave0);
            } }
        }
        SEAM(pb + 4);
        if (PH_IN(pb + 5)) {
            PHASE_VARS;
            pg8::Gemm g{WSP(WS_OA, bf16), WSP(WS_WBT, bf16), 3 * T, 3 * 1024, 512, 512}; pg8::BranchOrder S; S.init(T, G, bx);
            pg8::EpiBranch E{WSP(WS_S, unsigned char), WSP(WS_H, bf16)};
            pg8::gemm_phase<pg8::EpiBranch, pg8::BranchOrder, true, true>(lds + RING_OFF, g, S, E, wave0);
        }
        SEAM(pb + 5);
        if (PH_IN(pb + 6)) {
            PHASE_VARS;
            pg8::Gemm g{WSP(WS_H, bf16), WSP(WS_WOT, bf16), T, 1024, 1024, 1024}; pg8::StaticOrder S; S.init(T, 1024, G, bx);
            pg8::EpiBf16<0> E{WSP(WS_Y, bf16), 1024, 0, 0, 0, nullptr, 0, nullptr};
            pg8::gemm_phase<pg8::EpiBf16<0>, pg8::StaticOrder, true, true>(lds + RING_OFF, g, S, E, wave0);
        }
        SEAM(pb + 6);
        if (PH_IN(pb + 7)) {
            PHASE_VARS;
            bf16* xb = (bf16*)A->out; bf16* xdst = (l == DEPTH - 1) ? WSP(WS_O12, bf16) : xb;
            const bf16* YB = WSP(WS_Y, bf16); float* RS = WSP(WS_RS, float); const float* wpost = INP(4, float) + l * DM;
            if (l == 0) { const float* xin = INP(0, float); for (int m = 2 * gw; m < T; m += 2 * NGW) resid_row2<true, false>(YB + (size_t)m * DM, xin + (size_t)m * DM, xdst + (size_t)m * DM, wpost, RS + m, lane); }
            else { for (int m = 2 * gw; m < T; m += 2 * NGW) resid_row2<false, false>(YB + (size_t)m * DM, xb + (size_t)m * DM, xdst + (size_t)m * DM, wpost, RS + m, lane); }
        }
        SEAM(pb + 7);
        if (PH_IN(pb + 8)) {
            PHASE_VARS;
            pg8::Gemm g{(l == DEPTH - 1) ? (const bf16*)WSP(WS_O12, bf16) : (const bf16*)A->out, WSP(WS_WUPT, bf16), T, 4096, 1024, 1024}; pg8::StaticOrder S; S.init(T, 4096, G, bx);
            pg8::EpiBf16<3> E{WSP(WS_U, bf16), 4096, 0, 0, 0, nullptr, 0, WSP(WS_RS, float)};
            pg8::gemm_phase<pg8::EpiBf16<3>, pg8::StaticOrder, true, true>(lds + RING_OFF, g, S, E, wave0);
        }
        SEAM(pb + 8);
        if (PH_IN(pb + 9)) {
            PHASE_VARS;
            pg8::Gemm g{WSP(WS_U, bf16), WSP(WS_WDNT, bf16), T, 1024, 4096, 4096}; pg8::StaticOrder S; S.init(T, 1024, G, bx);
            pg8::EpiBf16<0> E{WSP(WS_D, bf16), 1024, 0, 0, 0, nullptr, 0, nullptr};
            pg8::gemm_phase<pg8::EpiBf16<0>, pg8::StaticOrder, true, true>(lds + RING_OFF, g, S, E, wave0);
        }
        SEAM(pb + 9);
        if (PH_IN(pb + 10)) {
            PHASE_VARS;
            const bool more = (l + 1 < DEPTH);
            if (more) {
                const size_t n = (size_t)(l + 1);
                LAS float* scrw = (LAS float*)(lds + RING_OFF + wave * 16384);
                LayerW L{INP(7, float) + n * 1024 * DIN, INP(11, float) + n * 256 * 768, INP(13, float) + n * 128 * 1024, INP(14, float) + n * 3 * 512 * 1024,
                         INP(15, float) + n * 1024 * 1024, INP(16, float) + n * 1024 * 4096, INP(17, float) + n * 4096 * 1024, INP(3, float) + n * DM, INP(5, float) + n * DM};
                convert_weights(L, A->ws, scrw, gw, NGW, lane);
            }
            const bf16* DB = WSP(WS_D, bf16); float* RS = WSP(WS_RS, float);
            const float* wpost = INP(6, float) + l * DM;
            if (more) { bf16* xb = (bf16*)A->out; for (int m = 2 * gw; m < T; m += 2 * NGW) resid_row2<false, false>(DB + (size_t)m * DM, xb + (size_t)m * DM, xb + (size_t)m * DM, wpost, RS + m, lane); }
            else { const bf16* xsrc = WSP(WS_O12, bf16); float* xo = A->out; for (int m = 2 * gw; m < T; m += 2 * NGW) resid_row2<false, true>(DB + (size_t)m * DM, xsrc + (size_t)m * DM, xo + (size_t)m * DM, wpost, (float*)nullptr, lane); }
        }
        if (l + 1 < DEPTH) SEAM(pb + 10);
    }
}

extern "C" void kernel_launch(void* const* d_in, const int* in_sizes, int n_in, void* d_out, int out_size, void* d_ws, size_t ws_size, hipStream_t stream) {
    static int grid = 0;
    if (grid == 0) {
        if (n_in != 18 || in_sizes[0] != T * DM || out_size != T * DM || ws_size < WS_END) { fprintf(stderr, "kernel_launch: unexpected shapes (n_in %d, in0 %d, out %d, ws %zu, need %zu); nothing launched\n", n_in, n_in > 0 ? in_sizes[0] : -1, out_size, ws_size, (size_t)WS_END); grid = -1; return; }
        int dev = 0, cus = 0, per_cu = 0;
        if (hipGetDevice(&dev) != hipSuccess || hipDeviceGetAttribute(&cus, hipDeviceAttributeMultiprocessorCount, dev) != hipSuccess) { grid = -1; return; }
        if (hipFuncSetAttribute((const void*)trunk_fwd, hipFuncAttributeMaxDynamicSharedMemorySize, LDS_BYTES) != hipSuccess) { fprintf(stderr, "kernel_launch: hipFuncSetAttribute failed\n"); grid = -1; return; }
        if (hipOccupancyMaxActiveBlocksPerMultiprocessor(&per_cu, (const void*)trunk_fwd, NWAVES * 64, LDS_BYTES) != hipSuccess || per_cu < 1) { fprintf(stderr, "kernel_launch: occupancy query says %d blocks per CU\n", per_cu); }
        (void)hipGetLastError();
        grid = cus;
    }
    if (grid < 0) return;
    if (hipMemsetAsync((char*)d_ws + WS_CTL, 0, CTL_ZERO_BYTES, stream) != hipSuccess) return;
    Args a{};
    for (int i = 0; i < 18; ++i) a.in[i] = d_in[i];
    a.out = (float*)d_out; a.ws = (unsigned char*)d_ws;
    constexpr int NPH = 1 + 11 * DEPTH;
#ifndef N_LAUNCH
#define N_LAUNCH 1
#endif
    for (int li = 0; li < N_LAUNCH; ++li) {
        a.ph_lo = (N_LAUNCH == 1) ? 0 : li; a.ph_hi = (N_LAUNCH == 1) ? NPH : li + 1;
        hipLaunchKernelGGL(trunk_fwd, dim3(grid), dim3(NWAVES * 64), LDS_BYTES, stream, a);
        const hipError_t le = hipPeekAtLastError();
        if (le != hipSuccess) { fprintf(stderr, "kernel_launch: launch failed: %s\n", hipGetErrorName(le)); break; }
    }
}
```
